# Optimizing an MI355X kernel written in HIP

```python
import jax, jax.numpy as jnp
from jax import lax
import numpy as np

D_MODEL = 2048
BATCH = 2
SEQ = 4096
DEPTH = 1

N_HEADS = 16
HEAD_DIM = 64
D_ATTN = N_HEADS * HEAD_DIM
Q_BLOCK = 128
D_CONV = D_MODEL // 2
CONV_WIDTH = 3
N_BRANCH = 2
N_EXPERTS = 32
TOP_K = 4
D_EXPERT = D_MODEL
SWIGLU_LIMIT = 7.0
SWIGLU_ALPHA = 1.702
EXPERT_BLOCK = 128
RMS_EPS = 1e-6
N_MOD = 6
N_IN = 3 * D_CONV + 3 * D_ATTN + N_HEADS + N_BRANCH * D_MODEL

kernel_name = "hybrid_conv_fox_moe_adaln_block"


def _rmsnorm(x, g):
    xf = x.astype(jnp.float32)
    r = lax.rsqrt(jnp.mean(xf * xf, axis=-1, keepdims=True) + RMS_EPS)
    return (xf * r).astype(x.dtype) * g


def _short_conv(u, w):
    return lax.conv_general_dilated(
        u, w[:, None, :], window_strides=(1,), padding=[(CONV_WIDTH - 1, 0)],
        dimension_numbers=("NWC", "WIO", "NWC"), feature_group_count=u.shape[-1])


def _forgetting_attention(q, k, v, log_f):
    b, h, s, dh = q.shape
    F = jnp.cumsum(log_f, axis=-1)
    key_pos = jnp.arange(s)
    scale = HEAD_DIM ** -0.5

    def block(i):
        start = i * Q_BLOCK
        qb = lax.dynamic_slice_in_dim(q, start, Q_BLOCK, axis=2)
        Fq = lax.dynamic_slice_in_dim(F, start, Q_BLOCK, axis=2)
        q_pos = start + jnp.arange(Q_BLOCK)
        logits = jnp.einsum("bhqd,bhkd->bhqk", qb, k).astype(jnp.float32) * scale
        logits = logits + (Fq[..., :, None] - F[..., None, :])
        logits = jnp.where(key_pos[None, :] <= q_pos[:, None], logits, -jnp.inf)
        p = jax.nn.softmax(logits, axis=-1)
        return jnp.einsum("bhqk,bhkd->bhqd", p.astype(v.dtype), v)

    out = lax.map(block, jnp.arange(s // Q_BLOCK))
    return out.transpose(1, 2, 0, 3, 4).reshape(b, h, s, dh)


def _moe(h, router_w, router_b, w_gate, b_gate, w_up, b_up, w_down, b_down):
    bsz, s, d = h.shape
    n = bsz * s
    hf = h.reshape(n, d)
    logits = (hf @ router_w + router_b).astype(jnp.float32)
    top_vals, top_idx = lax.top_k(logits, TOP_K)
    probs = jax.nn.softmax(top_vals, axis=-1)
    expert_ids = top_idx.reshape(-1)
    token_ids = jnp.repeat(jnp.arange(n, dtype=jnp.int32), TOP_K)
    gates = probs.reshape(-1)
    order = jnp.argsort(expert_ids)
    s_exp, s_tok, s_gate = expert_ids[order], token_ids[order], gates[order]
    counts = jnp.zeros((N_EXPERTS,), jnp.int32).at[expert_ids].add(1)
    padded = ((counts + EXPERT_BLOCK - 1) // EXPERT_BLOCK) * EXPERT_BLOCK
    pad_end = jnp.cumsum(padded)
    pad_start = pad_end - padded
    grp_start = jnp.cumsum(counts) - counts
    rank = jnp.arange(n * TOP_K, dtype=jnp.int32) - grp_start[s_exp]
    dest = pad_start[s_exp] + rank
    n_rows = n * TOP_K + N_EXPERTS * EXPERT_BLOCK
    n_blocks = n_rows // EXPERT_BLOCK
    row_tok = jnp.full((n_rows,), n, jnp.int32).at[dest].set(s_tok)
    row_gate = jnp.zeros((n_rows,), jnp.float32).at[dest].set(s_gate)
    block_exp = jnp.minimum(
        jnp.searchsorted(pad_end, jnp.arange(n_blocks, dtype=jnp.int32) * EXPERT_BLOCK, side="right"),
        N_EXPERTS - 1)
    xin = jnp.take(hf, jnp.minimum(row_tok, n - 1), axis=0).reshape(n_blocks, EXPERT_BLOCK, d)

    def expert_block(args):
        xb, e = args
        g = xb @ w_gate[e] + b_gate[e]
        u = xb @ w_up[e] + b_up[e]
        g = jnp.minimum(g, SWIGLU_LIMIT)
        u = jnp.clip(u, -SWIGLU_LIMIT, SWIGLU_LIMIT)
        act = (u + 1.0) * g * jax.nn.sigmoid(SWIGLU_ALPHA * g)
        return act @ w_down[e] + b_down[e]

    yb = lax.map(expert_block, (xin, block_exp)).reshape(n_rows, d)
    out = jnp.zeros((n, d), h.dtype).at[row_tok].add(
        (yb * row_gate[:, None]).astype(h.dtype), mode="drop")
    return out.reshape(bsz, s, d)


def setup_inputs(seed: int = 0) -> dict:
    key = jax.random.key(seed)
    ks = jax.random.split(key, 24)
    L = DEPTH

    def nrm(k, shape, scale):
        return scale * jax.random.normal(k, shape, jnp.float32)

    return {
        "x": nrm(ks[0], (BATCH, SEQ, D_MODEL), 1.0),
        "c": nrm(ks[1], (BATCH, D_MODEL), 1.0),
        "ada_w": nrm(ks[2], (L, D_MODEL, N_MOD * D_MODEL), 0.3 * D_MODEL ** -0.5),
        "ada_b": nrm(ks[3], (L, N_MOD * D_MODEL), 0.02),
        "norm_mix_g": 1.0 + nrm(ks[4], (L, D_MODEL), 0.02),
        "w_in": nrm(ks[5], (L, D_MODEL, N_IN), D_MODEL ** -0.5),
        "b_forget": 3.0 + nrm(ks[6], (L, N_HEADS), 0.5),
        "conv_w": nrm(ks[7], (L, CONV_WIDTH, D_CONV), CONV_WIDTH ** -0.5),
        "w_conv_out": nrm(ks[8], (L, D_CONV, D_MODEL), D_CONV ** -0.5),
        "w_attn_out": nrm(ks[9], (L, D_ATTN, D_MODEL), D_ATTN ** -0.5),
        "w_out": nrm(ks[10], (L, D_MODEL, D_MODEL), D_MODEL ** -0.5),
        "norm_ffn_g": 1.0 + nrm(ks[11], (L, D_MODEL), 0.02),
        "router_w": nrm(ks[12], (L, D_MODEL, N_EXPERTS), D_MODEL ** -0.5),
        "router_b": nrm(ks[13], (L, N_EXPERTS), 0.01),
        "exp_w_gate": nrm(ks[14], (L, N_EXPERTS, D_MODEL, D_EXPERT), D_MODEL ** -0.5),
        "exp_b_gate": nrm(ks[15], (L, N_EXPERTS, D_EXPERT), 0.02),
        "exp_w_up": nrm(ks[16], (L, N_EXPERTS, D_MODEL, D_EXPERT), D_MODEL ** -0.5),
        "exp_b_up": nrm(ks[17], (L, N_EXPERTS, D_EXPERT), 0.02),
        "exp_w_down": nrm(ks[18], (L, N_EXPERTS, D_EXPERT, D_MODEL), D_EXPERT ** -0.5),
        "exp_b_down": nrm(ks[19], (L, N_EXPERTS, D_MODEL), 0.02),
        "final_norm_g": 1.0 + nrm(ks[20], (D_MODEL,), 0.02),
    }


def reference(x, c, ada_w, ada_b, norm_mix_g, w_in, b_forget, conv_w, w_conv_out, w_attn_out,
              w_out, norm_ffn_g, router_w, router_b, exp_w_gate, exp_b_gate, exp_w_up, exp_b_up,
              exp_w_down, exp_b_down, final_norm_g):
    bsz, s, _ = x.shape
    split_at = [D_CONV, 2 * D_CONV, 3 * D_CONV,
                3 * D_CONV + D_ATTN, 3 * D_CONV + 2 * D_ATTN, 3 * D_CONV + 3 * D_ATTN,
                3 * D_CONV + 3 * D_ATTN + N_HEADS,
                3 * D_CONV + 3 * D_ATTN + N_HEADS + D_MODEL]
    c_act = jax.nn.silu(c)
    for l in range(DEPTH):
        mod = c_act @ ada_w[l] + ada_b[l]
        shift_m, scale_m, gate_m, shift_f, scale_f, gate_f = [
            m[:, None, :] for m in jnp.split(mod, N_MOD, axis=-1)]

        h = _rmsnorm(x, norm_mix_g[l]) * (1.0 + scale_m) + shift_m
        proj = h @ w_in[l]
        xc, cb, cc, q, k, v, f_logit, g_conv, g_attn = jnp.split(proj, split_at, axis=-1)

        y_conv = (cb * _short_conv(cc * xc, conv_w[l])) @ w_conv_out[l]

        to_heads = lambda t: t.reshape(bsz, s, N_HEADS, HEAD_DIM).transpose(0, 2, 1, 3)
        log_f = jax.nn.log_sigmoid((f_logit + b_forget[l]).astype(jnp.float32)).transpose(0, 2, 1)
        att = _forgetting_attention(to_heads(q), to_heads(k), to_heads(v), log_f)
        y_attn = att.transpose(0, 2, 1, 3).reshape(bsz, s, D_ATTN) @ w_attn_out[l]

        merged = jax.nn.sigmoid(g_conv) * y_conv + jax.nn.sigmoid(g_attn) * y_attn
        x = x + gate_m * (merged @ w_out[l])

        h2 = _rmsnorm(x, norm_ffn_g[l]) * (1.0 + scale_f) + shift_f
        y_ffn = _moe(h2, router_w[l], router_b[l], exp_w_gate[l], exp_b_gate[l],
                     exp_w_up[l], exp_b_up[l], exp_w_down[l], exp_b_down[l])
        x = x + gate_f * y_ffn
    return _rmsnorm(x, final_norm_g)
```

```cpp
#include <hip/hip_runtime.h>
#include <stdint.h>

typedef unsigned short bf16_t;
typedef float f32x4 __attribute__((ext_vector_type(4)));
typedef unsigned u32x4 __attribute__((ext_vector_type(4)));
typedef unsigned u32x2 __attribute__((ext_vector_type(2)));

namespace cfg {
constexpr int B = 2, S = 4096, D = 2048, NTOK = B * S, H = 16, DH = 64, DA = 1024, DC = 1024;
constexpr int NIN = 10256, NMOD = 6 * D, E = 32, TOPK = 4, NASG = NTOK * TOPK;
constexpr int PLD = 10240;
constexpr int C_XC = 0, C_CB = 1024, C_CC = 2048, C_Q = 3072, C_K = 4096, C_V = 5120, C_GC = 6144, C_GA = 8192;
constexpr int W_F = 6144, W_GC = 6160, W_GA = 8208;
constexpr float EPS = 1e-6f, LOG2E = 1.4426950408889634f;
constexpr float QSCALE = 0.125f * LOG2E;
constexpr int ACT_ROWS = NASG + E * 256;
constexpr size_t al(size_t x) { return (x + 255) & ~(size_t)255; }
constexpr size_t OFF_CTRL = 0;
constexpr size_t OFF_MOD = 65536;
constexpr size_t OFF_LOGF = OFF_MOD + al((size_t)B * NMOD * 4);
constexpr size_t OFF_FCUM = OFF_LOGF + al((size_t)B * H * S * 4);
constexpr size_t OFF_HA = OFF_FCUM + al((size_t)B * H * S * 4);
constexpr size_t OFF_PROJ = OFF_HA + al((size_t)NTOK * D * 2);
constexpr size_t OFF_UA = OFF_PROJ + al((size_t)NTOK * PLD * 2);
constexpr size_t OFF_MRG = OFF_UA + al((size_t)NTOK * 2048 * 2);
constexpr size_t OFF_X1 = OFF_MRG + al((size_t)NTOK * D * 2);
constexpr size_t OFF_TMP = OFF_X1 + al((size_t)NTOK * D * 4);
constexpr size_t OFF_GATE = OFF_TMP + al((size_t)NTOK * D * 4);
constexpr size_t OFF_LIST = OFF_GATE + al((size_t)NASG * 4);
constexpr size_t OFF_ACT = OFF_LIST + al((size_t)E * NTOK * 4);
constexpr size_t OFF_Y = OFF_ACT + al((size_t)ACT_ROWS * D * 2);
constexpr size_t WS_END = OFF_Y + al((size_t)NASG * D * 2);
}
using namespace cfg;

__device__ __forceinline__ float bf2f(bf16_t v) { return __uint_as_float(((unsigned)v) << 16); }
__device__ __forceinline__ bf16_t f2bf(float f) { unsigned u = __float_as_uint(f); u += 0x7fffu + ((u >> 16) & 1u); return (bf16_t)(u >> 16); }
__device__ __forceinline__ float sigmoidf_(float x) { return 1.0f / (1.0f + __expf(-x)); }

struct Ptrs {
    const float *x, *c, *ada_w, *ada_b, *norm_mix_g, *w_in, *b_forget, *conv_w, *w_conv_out, *w_attn_out, *w_out, *norm_ffn_g,
        *router_w, *router_b, *w_gate, *b_gate, *w_up, *b_up, *w_down, *b_down, *final_g;
    float* out; unsigned char* ws;
};

__device__ __forceinline__ float block_sum_256(float v, float* red) {
    for (int o = 32; o > 0; o >>= 1) v += __shfl_xor(v, o);
    __syncthreads();
    if ((threadIdx.x & 63) == 0) red[threadIdx.x >> 6] = v;
    __syncthreads();
    return red[0] + red[1] + red[2] + red[3];
}

__global__ void __launch_bounds__(256) k_mod(Ptrs p) {
    __shared__ float sc[B * D];
    for (int i = threadIdx.x; i < B * D; i += 256) { float v = p.c[i]; sc[i] = v / (1.0f + __expf(-v)); }
    __syncthreads();
    const int j = blockIdx.x * 256 + threadIdx.x;
    float a0 = 0.f, a1 = 0.f;
    for (int k = 0; k < D; ++k) { float w = p.ada_w[(size_t)k * NMOD + j]; a0 += sc[k] * w; a1 += sc[D + k] * w; }
    float* mod = (float*)(p.ws + OFF_MOD);
    mod[j] = a0 + p.ada_b[j]; mod[NMOD + j] = a1 + p.ada_b[j];
}

__global__ void __launch_bounds__(256) k_norm1(Ptrs p) {
    __shared__ float red[4]; __shared__ float hs[D]; __shared__ float part[16][17];
    const int row = blockIdx.x, b = row / S, t = threadIdx.x;
    const float* xr = p.x + (size_t)row * D; const float* mod = (const float*)(p.ws + OFF_MOD) + (size_t)b * NMOD;
    float v[8]; float ss = 0.f;
#pragma unroll
    for (int i = 0; i < 8; ++i) { v[i] = xr[t + 256 * i]; ss += v[i] * v[i]; }
    ss = block_sum_256(ss, red);
    const float r = rsqrtf(ss * (1.0f / D) + EPS);
    bf16_t* ha = (bf16_t*)(p.ws + OFF_HA) + (size_t)row * D;
#pragma unroll
    for (int i = 0; i < 8; ++i) { const int k = t + 256 * i; float h = (v[i] * r) * p.norm_mix_g[k] * (1.0f + mod[D + k]) + mod[k]; hs[k] = h; ha[k] = f2bf(h); }
    __syncthreads();
    const int j = t & 15, pt = t >> 4; float a = 0.f;
    for (int k = pt * 128; k < pt * 128 + 128; ++k) a += hs[k] * p.w_in[(size_t)k * NIN + W_F + j];
    part[pt][j] = a; __syncthreads();
    if (t < 16) { float s = 0.f; for (int q = 0; q < 16; ++q) s += part[q][t]; const float z = s + p.b_forget[t];
        const float lf = fminf(z, 0.f) - log1pf(__expf(-fabsf(z)));
        ((float*)(p.ws + OFF_LOGF))[((size_t)b * H + t) * S + (row % S)] = lf; }
}

template <class AL, class BL, class EP>
__device__ __forceinline__ void sgemm_tile(const AL& al_, const BL& bl_, const EP& ep_, int row0, int col0, int K) {
    __shared__ float As[16][65]; __shared__ float Bs[16][65];
    const int t = threadIdx.x, tx = t & 15, ty = t >> 4;
    float acc[4][4] = {};
    for (int k0 = 0; k0 < K; k0 += 16) {
#pragma unroll
        for (int i = 0; i < 4; ++i) { const int e = t + 256 * i; { const int r = e >> 4, k = e & 15; As[k][r] = al_(row0 + r, k0 + k); } { const int k = e >> 6, c = e & 63; Bs[k][c] = bl_(k0 + k, col0 + c); } }
        __syncthreads();
#pragma unroll
        for (int k = 0; k < 16; ++k) { float a[4], bb[4];
#pragma unroll
            for (int i = 0; i < 4; ++i) { a[i] = As[k][ty * 4 + i]; bb[i] = Bs[k][tx * 4 + i]; }
#pragma unroll
            for (int i = 0; i < 4; ++i)
#pragma unroll
                for (int j = 0; j < 4; ++j) acc[i][j] += a[i] * bb[j]; }
        __syncthreads();
    }
#pragma unroll
    for (int i = 0; i < 4; ++i)
#pragma unroll
        for (int j = 0; j < 4; ++j) ep_(row0 + ty * 4 + i, col0 + tx * 4 + j, acc[i][j]);
}

__global__ void __launch_bounds__(256) k_gemm1(Ptrs p) {
    const bf16_t* ha = (const bf16_t*)(p.ws + OFF_HA); bf16_t* pr = (bf16_t*)(p.ws + OFF_PROJ); const float* w = p.w_in;
    const int col0 = blockIdx.x * 64, row0 = blockIdx.y * 64;
    auto al_ = [=](int r, int k) { return bf2f(ha[(size_t)r * D + k]); };
    auto bl_ = [=](int k, int c) { const int wc = c < C_GC ? c : c + (W_GC - C_GC); return w[(size_t)k * NIN + wc]; };
    auto ep_ = [=](int r, int c, float v) { float o = v; if (c >= C_Q && c < C_K) o = v * QSCALE; else if (c >= C_GC) o = sigmoidf_(v); pr[(size_t)r * PLD + c] = f2bf(o); };
    sgemm_tile(al_, bl_, ep_, row0, col0, D);
}

__global__ void __launch_bounds__(64) k_cumsum(Ptrs p) {
    const float* lf = (const float*)(p.ws + OFF_LOGF) + (size_t)blockIdx.x * S; float* fc = (float*)(p.ws + OFF_FCUM) + (size_t)blockIdx.x * S;
    const int l = threadIdx.x; float tot = 0.f;
    for (int i = 0; i < 64; ++i) tot += lf[l * 64 + i];
    float inc = tot;
    for (int o = 1; o < 64; o <<= 1) { float n = __shfl_up(inc, o); if (l >= o) inc += n; }
    float run = inc - tot;
    for (int i = 0; i < 64; ++i) { run += lf[l * 64 + i]; fc[l * 64 + i] = run * LOG2E; }
}
__global__ void __launch_bounds__(256) k_conv(Ptrs p) {
    const int idx = blockIdx.x * 256 + threadIdx.x, row = idx / DC, c = idx % DC, s = row % S;
    const bf16_t* pr = (const bf16_t*)(p.ws + OFF_PROJ);
    float a = 0.f;
#pragma unroll
    for (int j = 0; j < 3; ++j) { const int ss = s - 2 + j; if (ss >= 0) { const bf16_t* q = pr + (size_t)(row - 2 + j) * PLD; a += p.conv_w[j * DC + c] * (bf2f(q[C_CC + c]) * bf2f(q[C_XC + c])); } }
    ((bf16_t*)(p.ws + OFF_UA))[(size_t)row * 2048 + c] = f2bf(bf2f(pr[(size_t)row * PLD + C_CB + c]) * a);
}

__global__ void __launch_bounds__(64) k_attn(Ptrs p) {
    const int g = blockIdx.x * 64 + threadIdx.x;
    const int q = g % S, bh = g / S, h = bh % H, b = bh / H;
    const bf16_t* pr = (const bf16_t*)(p.ws + OFF_PROJ); const float* fc = (const float*)(p.ws + OFF_FCUM) + (size_t)bh * S;
    const bf16_t* qp = pr + (size_t)(b * S + q) * PLD + C_Q + h * DH;
    float qv[64], o[64];
#pragma unroll
    for (int d = 0; d < 64; ++d) { qv[d] = bf2f(qp[d]); o[d] = 0.f; }
    const float fq = fc[q]; float m = -INFINITY, l = 0.f;
    const int qmax = (q | 63);
    for (int kv = 0; kv <= qmax; ++kv) {
        const bf16_t* kp = pr + (size_t)(b * S + kv) * PLD + C_K + h * DH; const bf16_t* vp = pr + (size_t)(b * S + kv) * PLD + C_V + h * DH;
        float s = 0.f;
#pragma unroll
        for (int d = 0; d < 64; ++d) s += qv[d] * bf2f(kp[d]);
        s += fq - fc[kv];
        if (kv <= q) {
            const float mn = fmaxf(m, s), al_ = exp2f(m - mn), pp = exp2f(s - mn);
            l = l * al_ + pp; m = mn;
#pragma unroll
            for (int d = 0; d < 64; ++d) o[d] = o[d] * al_ + pp * bf2f(vp[d]);
        }
    }
    bf16_t* op = (bf16_t*)(p.ws + OFF_UA) + (size_t)(b * S + q) * 2048 + 1024 + h * DH; const float il = 1.0f / l;
#pragma unroll
    for (int d = 0; d < 64; ++d) op[d] = f2bf(o[d] * il);
}

__global__ void __launch_bounds__(256) k_gemm_merge(Ptrs p) {
    const bf16_t* ua = (const bf16_t*)(p.ws + OFF_UA); const bf16_t* pr = (const bf16_t*)(p.ws + OFF_PROJ); bf16_t* mg = (bf16_t*)(p.ws + OFF_MRG);
    const float* w1 = p.w_conv_out; const float* w2 = p.w_attn_out; float* tmp = (float*)(p.ws + OFF_TMP);
    const int col0 = blockIdx.x * 64, row0 = blockIdx.y * 64;
    if (blockIdx.z == 0) {
        auto al_ = [=](int r, int k) { return bf2f(ua[(size_t)r * 2048 + k]); };
        auto bl_ = [=](int k, int c) { return w1[(size_t)k * D + c]; };
        auto ep_ = [=](int r, int c, float v) { tmp[(size_t)r * D + c] = v; };
        sgemm_tile(al_, bl_, ep_, row0, col0, DC);
    }
}
__global__ void __launch_bounds__(256) k_gemm_merge2(Ptrs p) {
    const bf16_t* ua = (const bf16_t*)(p.ws + OFF_UA); const bf16_t* pr = (const bf16_t*)(p.ws + OFF_PROJ); bf16_t* mg = (bf16_t*)(p.ws + OFF_MRG);
    const float* w2 = p.w_attn_out; const float* tmp = (const float*)(p.ws + OFF_TMP);
    const int col0 = blockIdx.x * 64, row0 = blockIdx.y * 64;
    auto al_ = [=](int r, int k) { return bf2f(ua[(size_t)r * 2048 + 1024 + k]); };
    auto bl_ = [=](int k, int c) { return w2[(size_t)k * D + c]; };
    auto ep_ = [=](int r, int c, float v) { const float sc = bf2f(pr[(size_t)r * PLD + C_GC + c]), sa = bf2f(pr[(size_t)r * PLD + C_GA + c]);
        mg[(size_t)r * D + c] = f2bf(sc * tmp[(size_t)r * D + c] + sa * v); };
    sgemm_tile(al_, bl_, ep_, row0, col0, DA);
}
__global__ void __launch_bounds__(256) k_gemm_out(Ptrs p) {
    const bf16_t* mg = (const bf16_t*)(p.ws + OFF_MRG); const float* w = p.w_out; const float* x = p.x; float* x1 = (float*)(p.ws + OFF_X1);
    const float* mod = (const float*)(p.ws + OFF_MOD);
    const int col0 = blockIdx.x * 64, row0 = blockIdx.y * 64;
    auto al_ = [=](int r, int k) { return bf2f(mg[(size_t)r * D + k]); };
    auto bl_ = [=](int k, int c) { return w[(size_t)k * D + c]; };
    auto ep_ = [=](int r, int c, float v) { const int b = r / S; x1[(size_t)r * D + c] = x[(size_t)r * D + c] + mod[(size_t)b * NMOD + 2 * D + c] * v; };
    sgemm_tile(al_, bl_, ep_, row0, col0, D);
}

__global__ void __launch_bounds__(256) k_norm2_route(Ptrs p) {
    __shared__ float red[4]; __shared__ float hs[D]; __shared__ float part[8][33]; __shared__ float lg[32];
    const int row = blockIdx.x, b = row / S, t = threadIdx.x;
    const float* xr = (const float*)(p.ws + OFF_X1) + (size_t)row * D; const float* mod = (const float*)(p.ws + OFF_MOD) + (size_t)b * NMOD;
    float v[8]; float ss = 0.f;
#pragma unroll
    for (int i = 0; i < 8; ++i) { v[i] = xr[t + 256 * i]; ss += v[i] * v[i]; }
    ss = block_sum_256(ss, red);
    const float r = rsqrtf(ss * (1.0f / D) + EPS);
    bf16_t* ha = (bf16_t*)(p.ws + OFF_HA) + (size_t)row * D;
#pragma unroll
    for (int i = 0; i < 8; ++i) { const int k = t + 256 * i; float h = (v[i] * r) * p.norm_ffn_g[k] * (1.0f + mod[4 * D + k]) + mod[3 * D + k]; hs[k] = h; ha[k] = f2bf(h); }
    __syncthreads();
    const int e = t & 31, pt = t >> 5; float a = 0.f;
    for (int k = pt * 256; k < pt * 256 + 256; ++k) a += hs[k] * p.router_w[(size_t)k * E + e];
    part[pt][e] = a; __syncthreads();
    if (t < 32) { float s = p.router_b[t]; for (int q = 0; q < 8; ++q) s += part[q][t]; lg[t] = s; }
    __syncthreads();
    if (t == 0) {
        int idx[4]; float val[4]; unsigned used = 0u;
        for (int k = 0; k < 4; ++k) { float best = -INFINITY; int bi = 0; for (int e2 = 0; e2 < 32; ++e2) if (!((used >> e2) & 1u) && lg[e2] > best) { best = lg[e2]; bi = e2; } used |= 1u << bi; idx[k] = bi; val[k] = best; }
        float pe[4], sum = 0.f; for (int k = 0; k < 4; ++k) { pe[k] = __expf(val[k] - val[0]); sum += pe[k]; }
        int* counts = (int*)(p.ws + OFF_CTRL); int* list = (int*)(p.ws + OFF_LIST); float* gate = (float*)(p.ws + OFF_GATE);
        for (int k = 0; k < 4; ++k) { const int a_ = row * 4 + k; gate[a_] = pe[k] / sum; const int rk = atomicAdd(&counts[idx[k]], 1); list[(size_t)idx[k] * NTOK + rk] = a_; }
    }
}

__global__ void __launch_bounds__(256) k_moe_gu(Ptrs p) {
    __shared__ float As[16][65]; __shared__ float Bg[16][65]; __shared__ float Bu[16][65]; __shared__ int toks[64];
    const int e = blockIdx.z, i0 = blockIdx.y * 64, col0 = blockIdx.x * 64;
    const int* counts = (const int*)(p.ws + OFF_CTRL); const int cnt = counts[e];
    if (i0 >= cnt) return;
    int base = 0; for (int q = 0; q < e; ++q) base += (counts[q] + 255) & ~255;
    const int* list = (const int*)(p.ws + OFF_LIST) + (size_t)e * NTOK;
    const int t = threadIdx.x, tx = t & 15, ty = t >> 4;
    if (t < 64) toks[t] = (i0 + t < cnt) ? (list[i0 + t] >> 2) : -1;
    __syncthreads();
    const bf16_t* h2 = (const bf16_t*)(p.ws + OFF_HA); const float* wg = p.w_gate + (size_t)e * D * D; const float* wu = p.w_up + (size_t)e * D * D;
    float ag[4][4] = {}, au[4][4] = {};
    for (int k0 = 0; k0 < D; k0 += 16) {
#pragma unroll
        for (int i = 0; i < 4; ++i) { const int el = t + 256 * i; { const int r = el >> 4, k = el & 15; const int tk = toks[r]; As[k][r] = tk >= 0 ? bf2f(h2[(size_t)tk * D + k0 + k]) : 0.f; }
            { const int k = el >> 6, c = el & 63; Bg[k][c] = wg[(size_t)(k0 + k) * D + col0 + c]; Bu[k][c] = wu[(size_t)(k0 + k) * D + col0 + c]; } }
        __syncthreads();
#pragma unroll
        for (int k = 0; k < 16; ++k) { float a[4], g[4], u[4];
#pragma unroll
            for (int i = 0; i < 4; ++i) { a[i] = As[k][ty * 4 + i]; g[i] = Bg[k][tx * 4 + i]; u[i] = Bu[k][tx * 4 + i]; }
#pragma unroll
            for (int i = 0; i < 4; ++i)
#pragma unroll
                for (int j = 0; j < 4; ++j) { ag[i][j] += a[i] * g[j]; au[i][j] += a[i] * u[j]; } }
        __syncthreads();
    }
    bf16_t* act = (bf16_t*)(p.ws + OFF_ACT);
#pragma unroll
    for (int i = 0; i < 4; ++i)
#pragma unroll
        for (int j = 0; j < 4; ++j) { const int r = i0 + ty * 4 + i, c = col0 + tx * 4 + j; if (r < cnt) {
            float g = ag[i][j] + p.b_gate[(size_t)e * D + c], u = au[i][j] + p.b_up[(size_t)e * D + c];
            g = fminf(g, 7.0f); u = fminf(fmaxf(u, -7.0f), 7.0f);
            act[(size_t)(base + r) * D + c] = f2bf((u + 1.0f) * g * sigmoidf_(1.702f * g)); } }
}
__global__ void __launch_bounds__(256) k_moe_down(Ptrs p) {
    const int e = blockIdx.z, i0 = blockIdx.y * 64, col0 = blockIdx.x * 64;
    const int* counts = (const int*)(p.ws + OFF_CTRL); const int cnt = counts[e];
    if (i0 >= cnt) return;
    int base = 0; for (int q = 0; q < e; ++q) base += (counts[q] + 255) & ~255;
    const int* list = (const int*)(p.ws + OFF_LIST) + (size_t)e * NTOK; const float* gate = (const float*)(p.ws + OFF_GATE);
    const bf16_t* act = (const bf16_t*)(p.ws + OFF_ACT); const float* wd = p.w_down + (size_t)e * D * D; const float* bd = p.b_down + (size_t)e * D; bf16_t* y = (bf16_t*)(p.ws + OFF_Y);
    auto al_ = [=](int r, int k) { return (r < cnt) ? bf2f(act[(size_t)(base + r) * D + k]) : 0.f; };
    auto bl_ = [=](int k, int c) { return wd[(size_t)k * D + c]; };
    auto ep_ = [=](int r, int c, float v) { if (r < cnt) { const int a_ = list[r]; y[(size_t)a_ * D + c] = f2bf((v + bd[c]) * gate[a_]); } };
    sgemm_tile(al_, bl_, ep_, i0, col0, D);
}
__global__ void __launch_bounds__(256) k_final(Ptrs p) {
    __shared__ float red[4];
    const int row = blockIdx.x, b = row / S, t = threadIdx.x;
    const float* xr = (const float*)(p.ws + OFF_X1) + (size_t)row * D; const float* mod = (const float*)(p.ws + OFF_MOD) + (size_t)b * NMOD;
    const bf16_t* y = (const bf16_t*)(p.ws + OFF_Y) + (size_t)row * 4 * D;
    float v[8]; float ss = 0.f;
#pragma unroll
    for (int i = 0; i < 8; ++i) { const int k = t + 256 * i; float s = 0.f;
#pragma unroll
        for (int q = 0; q < 4; ++q) s += bf2f(y[(size_t)q * D + k]);
        v[i] = xr[k] + mod[5 * D + k] * s; ss += v[i] * v[i]; }
    ss = block_sum_256(ss, red);
    const float r = rsqrtf(ss * (1.0f / D) + EPS);
#pragma unroll
    for (int i = 0; i < 8; ++i) { const int k = t + 256 * i; p.out[(size_t)row * D + k] = (v[i] * r) * p.final_g[k]; }
}

extern "C" void kernel_launch(void* const* d_in, const int* in_sizes, int n_in, void* d_out, int out_size, void* d_ws, size_t ws_size, hipStream_t stream) {
    Ptrs p{};
    const float** f = (const float**)&p;
    for (int i = 0; i < 21; ++i) f[i] = (const float*)d_in[i];
    p.out = (float*)d_out; p.ws = (unsigned char*)d_ws;
    hipMemsetAsync(p.ws + OFF_CTRL, 0, 65536, stream);
    k_mod<<<NMOD / 256, 256, 0, stream>>>(p);
    k_norm1<<<NTOK, 256, 0, stream>>>(p);
    k_gemm1<<<dim3(PLD / 64, NTOK / 64), 256, 0, stream>>>(p);
    k_cumsum<<<B * H, 64, 0, stream>>>(p);
    k_conv<<<NTOK * DC / 256, 256, 0, stream>>>(p);
    k_attn<<<B * H * S / 64, 64, 0, stream>>>(p);
    k_gemm_merge<<<dim3(D / 64, NTOK / 64), 256, 0, stream>>>(p);
    k_gemm_merge2<<<dim3(D / 64, NTOK / 64), 256, 0, stream>>>(p);
    k_gemm_out<<<dim3(D / 64, NTOK / 64), 256, 0, stream>>>(p);
    k_norm2_route<<<NTOK, 256, 0, stream>>>(p);
    k_moe_gu<<<dim3(D / 64, NTOK / 64, E), 256, 0, stream>>>(p);
    k_moe_down<<<dim3(D / 64, NTOK / 64, E), 256, 0, stream>>>(p);
    k_final<<<NTOK, 256, 0, stream>>>(p);
}
```

```cpp
#include <hip/hip_runtime.h>
#include <stdint.h>

typedef unsigned short bf16_t;
typedef float f32x4 __attribute__((ext_vector_type(4)));
typedef unsigned u32x4 __attribute__((ext_vector_type(4)));
typedef unsigned u32x2 __attribute__((ext_vector_type(2)));

namespace cfg {
constexpr int B = 2, S = 4096, D = 2048, NTOK = B * S, H = 16, DH = 64, DA = 1024, DC = 1024;
constexpr int NIN = 10256, NMOD = 6 * D, E = 32, TOPK = 4, NASG = NTOK * TOPK;
constexpr int PLD = 10240;
constexpr int C_XC = 0, C_CB = 1024, C_CC = 2048, C_Q = 3072, C_K = 4096, C_V = 5120, C_GC = 6144, C_GA = 8192;
constexpr int W_F = 6144, W_GC = 6160, W_GA = 8208;
constexpr float EPS = 1e-6f, LOG2E = 1.4426950408889634f;
constexpr float QSCALE = 0.125f * LOG2E;
constexpr int ACT_ROWS = NASG + E * 256;
constexpr size_t al(size_t x) { return (x + 255) & ~(size_t)255; }
constexpr size_t OFF_CTRL = 0;
constexpr size_t OFF_MOD = 65536;
constexpr size_t OFF_LOGF = OFF_MOD + al((size_t)B * NMOD * 4);
constexpr size_t OFF_FCUM = OFF_LOGF + al((size_t)B * H * S * 4);
constexpr size_t OFF_HA = OFF_FCUM + al((size_t)B * H * S * 4);
constexpr size_t OFF_PROJ = OFF_HA + al((size_t)NTOK * D * 2);
constexpr size_t OFF_UA = OFF_PROJ + al((size_t)NTOK * PLD * 2);
constexpr size_t OFF_MRG = OFF_UA + al((size_t)NTOK * 2048 * 2);
constexpr size_t OFF_X1 = OFF_MRG + al((size_t)NTOK * D * 2);
constexpr size_t OFF_TMP = OFF_X1 + al((size_t)NTOK * D * 4);
constexpr size_t OFF_GATE = OFF_TMP + al((size_t)NTOK * D * 4);
constexpr size_t OFF_LIST = OFF_GATE + al((size_t)NASG * 4);
constexpr size_t OFF_ACT = OFF_LIST + al((size_t)E * NTOK * 4);
constexpr size_t OFF_Y = OFF_ACT + al((size_t)ACT_ROWS * D * 2);
constexpr size_t WS_END = OFF_Y + al((size_t)NASG * D * 2);
}
using namespace cfg;

__device__ __forceinline__ float bf2f(bf16_t v) { return __uint_as_float(((unsigned)v) << 16); }
__device__ __forceinline__ bf16_t f2bf(float f) { unsigned u = __float_as_uint(f); u += 0x7fffu + ((u >> 16) & 1u); return (bf16_t)(u >> 16); }
__device__ __forceinline__ float sigmoidf_(float x) { return 1.0f / (1.0f + __expf(-x)); }

struct Ptrs {
    const float *x, *c, *ada_w, *ada_b, *norm_mix_g, *w_in, *b_forget, *conv_w, *w_conv_out, *w_attn_out, *w_out, *norm_ffn_g,
        *router_w, *router_b, *w_gate, *b_gate, *w_up, *b_up, *w_down, *b_down, *final_g;
    float* out; unsigned char* ws;
};

__device__ __forceinline__ float block_sum_256(float v, float* red) {
    for (int o = 32; o > 0; o >>= 1) v += __shfl_xor(v, o);
    __syncthreads();
    if ((threadIdx.x & 63) == 0) red[threadIdx.x >> 6] = v;
    __syncthreads();
    return red[0] + red[1] + red[2] + red[3];
}

__global__ void __launch_bounds__(256) k_mod(Ptrs p) {
    __shared__ float sc[B * D];
    for (int i = threadIdx.x; i < B * D; i += 256) { float v = p.c[i]; sc[i] = v / (1.0f + __expf(-v)); }
    __syncthreads();
    const int j = blockIdx.x * 256 + threadIdx.x;
    float a0 = 0.f, a1 = 0.f;
    for (int k = 0; k < D; ++k) { float w = p.ada_w[(size_t)k * NMOD + j]; a0 += sc[k] * w; a1 += sc[D + k] * w; }
    float* mod = (float*)(p.ws + OFF_MOD);
    mod[j] = a0 + p.ada_b[j]; mod[NMOD + j] = a1 + p.ada_b[j];
}

__global__ void __launch_bounds__(256) k_norm1(Ptrs p) {
    __shared__ float red[4]; __shared__ float hs[D]; __shared__ float part[16][17];
    const int row = blockIdx.x, b = row / S, t = threadIdx.x;
    const float* xr = p.x + (size_t)row * D; const float* mod = (const float*)(p.ws + OFF_MOD) + (size_t)b * NMOD;
    float v[8]; float ss = 0.f;
#pragma unroll
    for (int i = 0; i < 8; ++i) { v[i] = xr[t + 256 * i]; ss += v[i] * v[i]; }
    ss = block_sum_256(ss, red);
    const float r = rsqrtf(ss * (1.0f / D) + EPS);
    bf16_t* ha = (bf16_t*)(p.ws + OFF_HA) + (size_t)row * D;
#pragma unroll
    for (int i = 0; i < 8; ++i) { const int k = t + 256 * i; float h = (v[i] * r) * p.norm_mix_g[k] * (1.0f + mod[D + k]) + mod[k]; hs[k] = h; ha[k] = f2bf(h); }
    __syncthreads();
    const int j = t & 15, pt = t >> 4; float a = 0.f;
    for (int k = pt * 128; k < pt * 128 + 128; ++k) a += hs[k] * p.w_in[(size_t)k * NIN + W_F + j];
    part[pt][j] = a; __syncthreads();
    if (t < 16) { float s = 0.f; for (int q = 0; q < 16; ++q) s += part[q][t]; const float z = s + p.b_forget[t];
        const float lf = fminf(z, 0.f) - log1pf(__expf(-fabsf(z)));
        ((float*)(p.ws + OFF_LOGF))[((size_t)b * H + t) * S + (row % S)] = lf; }
}

#define LAS __attribute__((address_space(3)))
typedef short bf16x8 __attribute__((ext_vector_type(8)));
typedef float f32x2_t __attribute__((ext_vector_type(2)));
typedef __bf16 bf16x2_t __attribute__((ext_vector_type(2)));
__device__ __forceinline__ unsigned cvtpk(float lo, float hi) { f32x2_t v = {lo, hi}; bf16x2_t b = __builtin_convertvector(v, bf16x2_t); return __builtin_bit_cast(unsigned, b); }
__device__ __forceinline__ float bflo(unsigned w) { return __uint_as_float(w << 16); }
__device__ __forceinline__ float bfhi(unsigned w) { return __uint_as_float(w & 0xffff0000u); }
constexpr int GEMM_LDS = 131072;

struct GemmT {
    int wr, wc, fr, fq;
    int aR, aC;
    unsigned a_w;
    int b_k, b_wc, b_p, b_cin;
    unsigned b_w;
    unsigned a_r, b_r;
    __device__ __forceinline__ void init() {
        const int tid = threadIdx.x, wid = tid >> 6, lane = tid & 63;
        wr = wid >> 2; wc = wid & 3; fr = lane & 15; fq = lane >> 4;
        aR = (wid >> 1) * 16 + (lane >> 2); aC = (wid & 1) * 32 + (((lane & 3) ^ ((lane >> 5) << 1)) * 8);
        a_w = (unsigned)(wid * 1024 + lane * 16);
        const int kh = wid & 1, kc = lane & 3, sgl = lane >> 2;
        b_k = kh * 32 + kc * 8; b_wc = wid >> 1; b_p = (sgl >> 3) & 1; b_cin = (sgl & 3) * 8 + ((sgl >> 2) & 1) * 4;
        const int slot0 = b_wc * 64 + sgl * 4, row16 = (sgl & 3) * 4;
        b_w = (unsigned)(((slot0 >> 4) * 2 + kh) * 1024 + ((row16 * 64 + kc * 16) ^ ((row16 >> 3) << 5)));
        const unsigned lo = (unsigned)((fr * 64 + fq * 16) ^ ((fr >> 3) << 5));
        a_r = (unsigned)(wr * 16384) + lo; b_r = 32768u + (unsigned)(wc * 8192) + lo;
    }
};

__device__ __forceinline__ void gemm_kloop(f32x4 (&acc)[8][4], LAS unsigned char* lds, const GemmT& T,
                                           const unsigned char* a0, const unsigned char* a1, const unsigned char* a2, const unsigned char* a3,
                                           const unsigned char* bp, size_t ldbB, int nt) {
    u32x4 sa0, sa1, sa2, sa3; f32x4 sb[8];
#define G_ISSUE(t) do { const size_t ko_ = (size_t)(t) * 128; sa0 = *(const u32x4*)(a0 + ko_); sa1 = *(const u32x4*)(a1 + ko_); sa2 = *(const u32x4*)(a2 + ko_); sa3 = *(const u32x4*)(a3 + ko_); \
        const unsigned char* bq_ = bp + (size_t)(t) * 64 * ldbB; _Pragma("unroll") for (int i_ = 0; i_ < 8; ++i_) sb[i_] = *(const f32x4*)(bq_ + (size_t)i_ * ldbB); } while (0)
#define G_WRITE(buf) do { LAS unsigned char* d_ = lds + (buf) * 65536; \
        *(LAS u32x4*)(d_ + T.a_w) = sa0; *(LAS u32x4*)(d_ + T.a_w + 8192) = sa1; *(LAS u32x4*)(d_ + T.a_w + 16384) = sa2; *(LAS u32x4*)(d_ + T.a_w + 24576) = sa3; \
        _Pragma("unroll") for (int j_ = 0; j_ < 4; ++j_) { u32x4 w_; w_.x = cvtpk(sb[0][j_], sb[1][j_]); w_.y = cvtpk(sb[2][j_], sb[3][j_]); w_.z = cvtpk(sb[4][j_], sb[5][j_]); w_.w = cvtpk(sb[6][j_], sb[7][j_]); \
            *(LAS u32x4*)(d_ + 32768 + T.b_w + j_ * 64) = w_; } } while (0)
#define G_KSTEP(buf, ks) do { bf16x8 At_[8], Bf_[4]; const LAS unsigned char* s_ = lds + (buf) * 65536 + (ks) * 1024; \
        _Pragma("unroll") for (int m_ = 0; m_ < 8; ++m_) At_[m_] = *(const LAS bf16x8*)(s_ + T.a_r + m_ * 2048); \
        _Pragma("unroll") for (int n_ = 0; n_ < 4; ++n_) Bf_[n_] = *(const LAS bf16x8*)(s_ + T.b_r + n_ * 2048); \
        _Pragma("unroll") for (int m_ = 0; m_ < 8; ++m_) _Pragma("unroll") for (int n_ = 0; n_ < 4; ++n_) acc[m_][n_] = __builtin_amdgcn_mfma_f32_16x16x32_bf16(Bf_[n_], At_[m_], acc[m_][n_], 0, 0, 0); \
        __builtin_amdgcn_sched_barrier(0); } while (0)
#define G_BAR() do { asm volatile("s_waitcnt lgkmcnt(0)" ::: "memory"); __builtin_amdgcn_s_barrier(); asm volatile("" ::: "memory"); } while (0)
    G_ISSUE(0); G_WRITE(0); if (nt > 1) G_ISSUE(1); G_BAR();
    for (int t = 0; t < nt; ++t) { const int cur = t & 1;
        if (t + 1 < nt) G_WRITE(cur ^ 1);
        if (t + 2 < nt) G_ISSUE(t + 2);
        G_KSTEP(cur, 0); G_KSTEP(cur, 1);
        G_BAR(); }
#undef G_ISSUE
#undef G_WRITE
#undef G_KSTEP
}
__device__ __forceinline__ void acc_zero(f32x4 (&acc)[8][4]) {
#pragma unroll
    for (int m = 0; m < 8; ++m)
#pragma unroll
        for (int n = 0; n < 4; ++n) acc[m][n] = (f32x4){0.f, 0.f, 0.f, 0.f};
}
__device__ __forceinline__ u32x4 pack8(const f32x4 a, const f32x4 b) { u32x4 w; w.x = cvtpk(a[0], a[1]); w.y = cvtpk(a[2], a[3]); w.z = cvtpk(b[0], b[1]); w.w = cvtpk(b[2], b[3]); return w; }
__device__ __forceinline__ int vwg_id() { const int G = gridDim.x; return (G % 8 == 0) ? (int)((blockIdx.x % 8) * (G / 8) + blockIdx.x / 8) : (int)blockIdx.x; }

__device__ __forceinline__ void phase_gemm1(const Ptrs& p, LAS unsigned char* lds) {
    GemmT T; T.init();
    const bf16_t* ha = (const bf16_t*)(p.ws + OFF_HA); bf16_t* pr = (bf16_t*)(p.ws + OFF_PROJ);
    for (int u = vwg_id(); u < 32 * 40; u += gridDim.x) {
        const int pm = (u >> 3) & 31, pn = (u & 7) + 8 * (u >> 8);
        const int row0 = pm * 256, pcol0 = pn * 256, wcol0 = pcol0 < C_GC ? pcol0 : pcol0 + (W_GC - C_GC);
        const unsigned char* ab = (const unsigned char*)(ha + (size_t)(row0 + T.aR) * D + T.aC);
        const unsigned char* bp = (const unsigned char*)(p.w_in + (size_t)T.b_k * NIN + wcol0 + T.b_wc * 64 + T.b_p * 32 + T.b_cin);
        f32x4 acc[8][4]; acc_zero(acc);
        gemm_kloop(acc, lds, T, ab, ab + (size_t)64 * D * 2, ab + (size_t)128 * D * 2, ab + (size_t)192 * D * 2, bp, (size_t)NIN * 4, D / 64);
        const int mode = (pcol0 >= C_GC) ? 2 : ((pcol0 >= C_Q && pcol0 < C_K) ? 1 : 0);
#pragma unroll
        for (int m = 0; m < 8; ++m) { const int row = row0 + T.wr * 128 + m * 16 + T.fr;
#pragma unroll
            for (int pp = 0; pp < 2; ++pp) { f32x4 v0 = acc[m][2 * pp], v1 = acc[m][2 * pp + 1];
                if (mode == 1) { v0 *= QSCALE; v1 *= QSCALE; }
                else if (mode == 2) {
#pragma unroll
                    for (int j = 0; j < 4; ++j) { v0[j] = sigmoidf_(v0[j]); v1[j] = sigmoidf_(v1[j]); } }
                *(u32x4*)(pr + (size_t)row * PLD + pcol0 + T.wc * 64 + pp * 32 + T.fq * 8) = pack8(v0, v1); } }
    }
}
__device__ __forceinline__ void phase_merge(const Ptrs& p, LAS unsigned char* lds) {
    GemmT T; T.init();
    const bf16_t* ua = (const bf16_t*)(p.ws + OFF_UA); const bf16_t* pr = (const bf16_t*)(p.ws + OFF_PROJ); bf16_t* mg = (bf16_t*)(p.ws + OFF_MRG);
    for (int u = vwg_id(); u < 32 * 8; u += gridDim.x) {
        const int pm = u >> 3, pn = u & 7, row0 = pm * 256, col0 = pn * 256;
        const size_t cofs = (size_t)T.b_k * D + col0 + T.b_wc * 64 + T.b_p * 32 + T.b_cin;
        f32x4 acc[8][4]; acc_zero(acc);
#pragma unroll 1
        for (int seg = 0; seg < 2; ++seg) {
            const unsigned char* ab = (const unsigned char*)(ua + (size_t)(row0 + T.aR) * 2048 + T.aC + seg * 1024);
            const unsigned char* bp = (const unsigned char*)((seg ? p.w_attn_out : p.w_conv_out) + cofs);
            gemm_kloop(acc, lds, T, ab, ab + (size_t)64 * 4096, ab + (size_t)128 * 4096, ab + (size_t)192 * 4096, bp, (size_t)D * 4, 1024 / 64);
            int rowb = row0 + T.wr * 128 + T.fr; asm volatile("" : "+v"(rowb));
#pragma unroll
            for (int m = 0; m < 8; ++m) { const int row = rowb + m * 16;
#pragma unroll
                for (int pp = 0; pp < 2; ++pp) { const int c = col0 + T.wc * 64 + pp * 32 + T.fq * 8; const size_t o = (size_t)row * PLD + c;
                    const u32x4 sa = *(const u32x4*)(pr + o + C_GA); u32x4 sc = sa; if (seg == 0) sc = *(const u32x4*)(pr + o + C_GC);
                    f32x4 v0 = acc[m][2 * pp], v1 = acc[m][2 * pp + 1];
#pragma unroll
                    for (int j = 0; j < 2; ++j) {
                        const float a0 = bflo(sa[j]), a1 = bfhi(sa[j]), a2 = bflo(sa[2 + j]), a3 = bfhi(sa[2 + j]);
                        if (seg == 0) { v0[2 * j] *= bflo(sc[j]) / a0; v0[2 * j + 1] *= bfhi(sc[j]) / a1; v1[2 * j] *= bflo(sc[2 + j]) / a2; v1[2 * j + 1] *= bfhi(sc[2 + j]) / a3; }
                        else { v0[2 * j] *= a0; v0[2 * j + 1] *= a1; v1[2 * j] *= a2; v1[2 * j + 1] *= a3; } }
                    acc[m][2 * pp] = v0; acc[m][2 * pp + 1] = v1;
                    if (seg == 1) *(u32x4*)(mg + (size_t)row * D + c) = pack8(v0, v1); }
                asm volatile("" ::: "memory"); }
        }
    }
}
__device__ __forceinline__ void phase_out(const Ptrs& p, LAS unsigned char* lds) {
    GemmT T; T.init();
    const bf16_t* mg = (const bf16_t*)(p.ws + OFF_MRG); float* x1 = (float*)(p.ws + OFF_X1); const float* mod = (const float*)(p.ws + OFF_MOD);
    for (int u = vwg_id(); u < 32 * 8; u += gridDim.x) {
        const int pm = u >> 3, pn = u & 7, row0 = pm * 256, col0 = pn * 256;
        const unsigned char* ab = (const unsigned char*)(mg + (size_t)(row0 + T.aR) * D + T.aC);
        const unsigned char* bp = (const unsigned char*)(p.w_out + (size_t)T.b_k * D + col0 + T.b_wc * 64 + T.b_p * 32 + T.b_cin);
        f32x4 acc[8][4]; acc_zero(acc);
        gemm_kloop(acc, lds, T, ab, ab + (size_t)64 * 4096, ab + (size_t)128 * 4096, ab + (size_t)192 * 4096, bp, (size_t)D * 4, D / 64);
        const float* gm = mod + (size_t)(row0 / S) * NMOD + 2 * D;
#pragma unroll
        for (int m = 0; m < 8; ++m) { const int row = row0 + T.wr * 128 + m * 16 + T.fr;
#pragma unroll
            for (int pp = 0; pp < 2; ++pp) { const int c = col0 + T.wc * 64 + pp * 32 + T.fq * 8; const size_t o = (size_t)row * D + c;
                const f32x4 g0 = *(const f32x4*)(gm + c), g1 = *(const f32x4*)(gm + c + 4), x0 = *(const f32x4*)(p.x + o), x1v = *(const f32x4*)(p.x + o + 4);
                *(f32x4*)(x1 + o) = x0 + g0 * acc[m][2 * pp]; *(f32x4*)(x1 + o + 4) = x1v + g1 * acc[m][2 * pp + 1]; } }
    }
}
struct MoeUnit { int e, mt, nt, cnt, base; };
__device__ __forceinline__ bool moe_unit(const int* counts, int u, int ntiles_n, MoeUnit& mu) {
    int base = 0;
    for (int e = 0; e < E; ++e) { const int c = counts[e], tm = (c + 255) >> 8, nu = tm * ntiles_n;
        if (u < nu) { mu.e = e; mu.cnt = c; mu.base = base; mu.nt = u / tm; mu.mt = u - mu.nt * tm; return true; }
        u -= nu; base += tm * 256; }
    return false;
}
__device__ __forceinline__ void phase_moe_gu(const Ptrs& p, LAS unsigned char* lds) {
    GemmT T; T.init();
    const int* counts = (const int*)(p.ws + OFF_CTRL); const bf16_t* h2 = (const bf16_t*)(p.ws + OFF_HA); bf16_t* act = (bf16_t*)(p.ws + OFF_ACT);
    MoeUnit mu;
    for (int u = vwg_id(); moe_unit(counts, u, 16, mu); u += gridDim.x) {
        const int* list = (const int*)(p.ws + OFF_LIST) + (size_t)mu.e * NTOK; const int i0 = mu.mt * 256, n0 = mu.nt * 128;
        const unsigned char* ap[4];
#pragma unroll
        for (int i = 0; i < 4; ++i) { const int r = i0 + T.aR + 64 * i; const int tok = (r < mu.cnt) ? (list[r] >> 2) : 0; ap[i] = (const unsigned char*)(h2 + (size_t)tok * D + T.aC); }
        const float* wsel = (T.b_p ? p.w_up : p.w_gate) + (size_t)mu.e * D * D;
        const unsigned char* bp = (const unsigned char*)(wsel + (size_t)T.b_k * D + n0 + T.b_wc * 32 + T.b_cin);
        f32x4 acc[8][4]; acc_zero(acc);
        gemm_kloop(acc, lds, T, ap[0], ap[1], ap[2], ap[3], bp, (size_t)D * 4, D / 64);
        const int c = n0 + T.wc * 32 + T.fq * 8;
        const float* bg = p.b_gate + (size_t)mu.e * D + c; const float* bu = p.b_up + (size_t)mu.e * D + c;
        const f32x4 bg0 = *(const f32x4*)bg, bg1 = *(const f32x4*)(bg + 4), bu0 = *(const f32x4*)bu, bu1 = *(const f32x4*)(bu + 4);
#pragma unroll
        for (int m = 0; m < 8; ++m) { const int r = i0 + T.wr * 128 + m * 16 + T.fr;
            f32x4 g0 = acc[m][0] + bg0, g1 = acc[m][1] + bg1, u0 = acc[m][2] + bu0, u1 = acc[m][3] + bu1;
#pragma unroll
            for (int j = 0; j < 4; ++j) { float g = fminf(g0[j], 7.0f), uu = fminf(fmaxf(u0[j], -7.0f), 7.0f); g0[j] = (uu + 1.0f) * g * sigmoidf_(1.702f * g);
                g = fminf(g1[j], 7.0f); uu = fminf(fmaxf(u1[j], -7.0f), 7.0f); g1[j] = (uu + 1.0f) * g * sigmoidf_(1.702f * g); }
            if (r < mu.cnt) *(u32x4*)(act + (size_t)(mu.base + r) * D + c) = pack8(g0, g1); }
    }
}
__device__ __forceinline__ void phase_moe_down(const Ptrs& p, LAS unsigned char* lds) {
    GemmT T; T.init();
    const int* counts = (const int*)(p.ws + OFF_CTRL); const bf16_t* act = (const bf16_t*)(p.ws + OFF_ACT); bf16_t* y = (bf16_t*)(p.ws + OFF_Y); const float* gate = (const float*)(p.ws + OFF_GATE);
    MoeUnit mu;
    for (int u = vwg_id(); moe_unit(counts, u, 8, mu); u += gridDim.x) {
        const int* list = (const int*)(p.ws + OFF_LIST) + (size_t)mu.e * NTOK; const int i0 = mu.mt * 256, col0 = mu.nt * 256;
        const unsigned char* ab = (const unsigned char*)(act + (size_t)(mu.base + i0 + T.aR) * D + T.aC);
        const unsigned char* bp = (const unsigned char*)(p.w_down + (size_t)mu.e * D * D + (size_t)T.b_k * D + col0 + T.b_wc * 64 + T.b_p * 32 + T.b_cin);
        f32x4 acc[8][4]; acc_zero(acc);
        gemm_kloop(acc, lds, T, ab, ab + (size_t)64 * 4096, ab + (size_t)128 * 4096, ab + (size_t)192 * 4096, bp, (size_t)D * 4, D / 64);
        const float* bd = p.b_down + (size_t)mu.e * D;
#pragma unroll
        for (int m = 0; m < 8; ++m) { const int r = i0 + T.wr * 128 + m * 16 + T.fr;
            if (r < mu.cnt) { const int a = list[r]; const float gt = gate[a];
#pragma unroll
                for (int pp = 0; pp < 2; ++pp) { const int c = col0 + T.wc * 64 + pp * 32 + T.fq * 8;
                    const f32x4 v0 = (acc[m][2 * pp] + *(const f32x4*)(bd + c)) * gt, v1 = (acc[m][2 * pp + 1] + *(const f32x4*)(bd + c + 4)) * gt;
                    *(u32x4*)(y + (size_t)a * D + c) = pack8(v0, v1); } } }
    }
}
extern __shared__ __attribute__((aligned(1024))) unsigned char dyn_lds[];
__global__ void __launch_bounds__(512, 2) k_gemm1(Ptrs p) { phase_gemm1(p, (LAS unsigned char*)dyn_lds); }
__global__ void __launch_bounds__(512, 2) k_merge(Ptrs p) { phase_merge(p, (LAS unsigned char*)dyn_lds); }
__global__ void __launch_bounds__(512, 2) k_out(Ptrs p) { phase_out(p, (LAS unsigned char*)dyn_lds); }
__global__ void __launch_bounds__(512, 2) k_moe_gu(Ptrs p) { phase_moe_gu(p, (LAS unsigned char*)dyn_lds); }
__global__ void __launch_bounds__(512, 2) k_moe_down(Ptrs p) { phase_moe_down(p, (LAS unsigned char*)dyn_lds); }

__global__ void __launch_bounds__(64) k_cumsum(Ptrs p) {
    const float* lf = (const float*)(p.ws + OFF_LOGF) + (size_t)blockIdx.x * S; float* fc = (float*)(p.ws + OFF_FCUM) + (size_t)blockIdx.x * S;
    const int l = threadIdx.x; float tot = 0.f;
    for (int i = 0; i < 64; ++i) tot += lf[l * 64 + i];
    float inc = tot;
    for (int o = 1; o < 64; o <<= 1) { float n = __shfl_up(inc, o); if (l >= o) inc += n; }
    float run = inc - tot;
    for (int i = 0; i < 64; ++i) { run += lf[l * 64 + i]; fc[l * 64 + i] = run * LOG2E; }
}
__global__ void __launch_bounds__(256) k_conv(Ptrs p) {
    const int idx = blockIdx.x * 256 + threadIdx.x, row = idx / DC, c = idx % DC, s = row % S;
    const bf16_t* pr = (const bf16_t*)(p.ws + OFF_PROJ);
    float a = 0.f;
#pragma unroll
    for (int j = 0; j < 3; ++j) { const int ss = s - 2 + j; if (ss >= 0) { const bf16_t* q = pr + (size_t)(row - 2 + j) * PLD; a += p.conv_w[j * DC + c] * (bf2f(q[C_CC + c]) * bf2f(q[C_XC + c])); } }
    ((bf16_t*)(p.ws + OFF_UA))[(size_t)row * 2048 + c] = f2bf(bf2f(pr[(size_t)row * PLD + C_CB + c]) * a);
}

__global__ void __launch_bounds__(64) k_attn(Ptrs p) {
    const int g = blockIdx.x * 64 + threadIdx.x;
    const int q = g % S, bh = g / S, h = bh % H, b = bh / H;
    const bf16_t* pr = (const bf16_t*)(p.ws + OFF_PROJ); const float* fc = (const float*)(p.ws + OFF_FCUM) + (size_t)bh * S;
    const bf16_t* qp = pr + (size_t)(b * S + q) * PLD + C_Q + h * DH;
    float qv[64], o[64];
#pragma unroll
    for (int d = 0; d < 64; ++d) { qv[d] = bf2f(qp[d]); o[d] = 0.f; }
    const float fq = fc[q]; float m = -INFINITY, l = 0.f;
    const int qmax = (q | 63);
    for (int kv = 0; kv <= qmax; ++kv) {
        const bf16_t* kp = pr + (size_t)(b * S + kv) * PLD + C_K + h * DH; const bf16_t* vp = pr + (size_t)(b * S + kv) * PLD + C_V + h * DH;
        float s = 0.f;
#pragma unroll
        for (int d = 0; d < 64; ++d) s += qv[d] * bf2f(kp[d]);
        s += fq - fc[kv];
        if (kv <= q) {
            const float mn = fmaxf(m, s), al_ = exp2f(m - mn), pp = exp2f(s - mn);
            l = l * al_ + pp; m = mn;
#pragma unroll
            for (int d = 0; d < 64; ++d) o[d] = o[d] * al_ + pp * bf2f(vp[d]);
        }
    }
    bf16_t* op = (bf16_t*)(p.ws + OFF_UA) + (size_t)(b * S + q) * 2048 + 1024 + h * DH; const float il = 1.0f / l;
#pragma unroll
    for (int d = 0; d < 64; ++d) op[d] = f2bf(o[d] * il);
}

__global__ void __launch_bounds__(256) k_norm2_route(Ptrs p) {
    __shared__ float red[4]; __shared__ float hs[D]; __shared__ float part[8][33]; __shared__ float lg[32];
    const int row = blockIdx.x, b = row / S, t = threadIdx.x;
    const float* xr = (const float*)(p.ws + OFF_X1) + (size_t)row * D; const float* mod = (const float*)(p.ws + OFF_MOD) + (size_t)b * NMOD;
    float v[8]; float ss = 0.f;
#pragma unroll
    for (int i = 0; i < 8; ++i) { v[i] = xr[t + 256 * i]; ss += v[i] * v[i]; }
    ss = block_sum_256(ss, red);
    const float r = rsqrtf(ss * (1.0f / D) + EPS);
    bf16_t* ha = (bf16_t*)(p.ws + OFF_HA) + (size_t)row * D;
#pragma unroll
    for (int i = 0; i < 8; ++i) { const int k = t + 256 * i; float h = (v[i] * r) * p.norm_ffn_g[k] * (1.0f + mod[4 * D + k]) + mod[3 * D + k]; hs[k] = h; ha[k] = f2bf(h); }
    __syncthreads();
    const int e = t & 31, pt = t >> 5; float a = 0.f;
    for (int k = pt * 256; k < pt * 256 + 256; ++k) a += hs[k] * p.router_w[(size_t)k * E + e];
    part[pt][e] = a; __syncthreads();
    if (t < 32) { float s = p.router_b[t]; for (int q = 0; q < 8; ++q) s += part[q][t]; lg[t] = s; }
    __syncthreads();
    if (t == 0) {
        int idx[4]; float val[4]; unsigned used = 0u;
        for (int k = 0; k < 4; ++k) { float best = -INFINITY; int bi = 0; for (int e2 = 0; e2 < 32; ++e2) if (!((used >> e2) & 1u) && lg[e2] > best) { best = lg[e2]; bi = e2; } used |= 1u << bi; idx[k] = bi; val[k] = best; }
        float pe[4], sum = 0.f; for (int k = 0; k < 4; ++k) { pe[k] = __expf(val[k] - val[0]); sum += pe[k]; }
        int* counts = (int*)(p.ws + OFF_CTRL); int* list = (int*)(p.ws + OFF_LIST); float* gate = (float*)(p.ws + OFF_GATE);
        for (int k = 0; k < 4; ++k) { const int a_ = row * 4 + k; gate[a_] = pe[k] / sum; const int rk = atomicAdd(&counts[idx[k]], 1); list[(size_t)idx[k] * NTOK + rk] = a_; }
    }
}

__global__ void __launch_bounds__(256) k_final(Ptrs p) {
    __shared__ float red[4];
    const int row = blockIdx.x, b = row / S, t = threadIdx.x;
    const float* xr = (const float*)(p.ws + OFF_X1) + (size_t)row * D; const float* mod = (const float*)(p.ws + OFF_MOD) + (size_t)b * NMOD;
    const bf16_t* y = (const bf16_t*)(p.ws + OFF_Y) + (size_t)row * 4 * D;
    float v[8]; float ss = 0.f;
#pragma unroll
    for (int i = 0; i < 8; ++i) { const int k = t + 256 * i; float s = 0.f;
#pragma unroll
        for (int q = 0; q < 4; ++q) s += bf2f(y[(size_t)q * D + k]);
        v[i] = xr[k] + mod[5 * D + k] * s; ss += v[i] * v[i]; }
    ss = block_sum_256(ss, red);
    const float r = rsqrtf(ss * (1.0f / D) + EPS);
#pragma unroll
    for (int i = 0; i < 8; ++i) { const int k = t + 256 * i; p.out[(size_t)row * D + k] = (v[i] * r) * p.final_g[k]; }
}

extern "C" void kernel_launch(void* const* d_in, const int* in_sizes, int n_in, void* d_out, int out_size, void* d_ws, size_t ws_size, hipStream_t stream) {
    Ptrs p{};
    const float** f = (const float**)&p;
    for (int i = 0; i < 21; ++i) f[i] = (const float*)d_in[i];
    p.out = (float*)d_out; p.ws = (unsigned char*)d_ws;
    static bool attr_done = false;
    if (!attr_done) { attr_done = true;
        (void)hipFuncSetAttribute((const void*)k_gemm1, hipFuncAttributeMaxDynamicSharedMemorySize, GEMM_LDS);
        (void)hipFuncSetAttribute((const void*)k_merge, hipFuncAttributeMaxDynamicSharedMemorySize, GEMM_LDS);
        (void)hipFuncSetAttribute((const void*)k_out, hipFuncAttributeMaxDynamicSharedMemorySize, GEMM_LDS);
        (void)hipFuncSetAttribute((const void*)k_moe_gu, hipFuncAttributeMaxDynamicSharedMemorySize, GEMM_LDS);
        (void)hipFuncSetAttribute((const void*)k_moe_down, hipFuncAttributeMaxDynamicSharedMemorySize, GEMM_LDS); }
    (void)hipMemsetAsync(p.ws + OFF_CTRL, 0, 65536, stream);
    k_mod<<<NMOD / 256, 256, 0, stream>>>(p);
    k_norm1<<<NTOK, 256, 0, stream>>>(p);
    k_gemm1<<<256, 512, GEMM_LDS, stream>>>(p);
    k_cumsum<<<B * H, 64, 0, stream>>>(p);
    k_conv<<<NTOK * DC / 256, 256, 0, stream>>>(p);
    k_attn<<<B * H * S / 64, 64, 0, stream>>>(p);
    k_merge<<<256, 512, GEMM_LDS, stream>>>(p);
    k_out<<<256, 512, GEMM_LDS, stream>>>(p);
    k_norm2_route<<<NTOK, 256, 0, stream>>>(p);
    k_moe_gu<<<256, 512, GEMM_LDS, stream>>>(p);
    k_moe_down<<<256, 512, GEMM_LDS, stream>>>(p);
    k_final<<<NTOK, 256, 0, stream>>>(p);
}
```

```cpp
#include <hip/hip_runtime.h>
#include <stdint.h>

typedef unsigned short bf16_t;
typedef float f32x4 __attribute__((ext_vector_type(4)));
typedef unsigned u32x4 __attribute__((ext_vector_type(4)));
typedef unsigned u32x2 __attribute__((ext_vector_type(2)));

namespace cfg {
constexpr int B = 2, S = 4096, D = 2048, NTOK = B * S, H = 16, DH = 64, DA = 1024, DC = 1024;
constexpr int NIN = 10256, NMOD = 6 * D, E = 32, TOPK = 4, NASG = NTOK * TOPK;
constexpr int PLD = 10240;
constexpr int C_XC = 0, C_CB = 1024, C_CC = 2048, C_Q = 3072, C_K = 4096, C_V = 5120, C_GC = 6144, C_GA = 8192;
constexpr int W_F = 6144, W_GC = 6160, W_GA = 8208;
constexpr float EPS = 1e-6f, LOG2E = 1.4426950408889634f;
constexpr float QSCALE = 0.125f * LOG2E;
constexpr int ACT_ROWS = NASG + E * 256;
constexpr size_t al(size_t x) { return (x + 255) & ~(size_t)255; }
constexpr size_t OFF_CTRL = 0;
constexpr size_t OFF_MOD = 65536;
constexpr size_t OFF_LOGF = OFF_MOD + al((size_t)B * NMOD * 4);
constexpr size_t OFF_FCUM = OFF_LOGF + al((size_t)B * H * S * 4);
constexpr size_t OFF_HA = OFF_FCUM + al((size_t)B * H * S * 4);
constexpr size_t OFF_PROJ = OFF_HA + al((size_t)NTOK * D * 2);
constexpr size_t OFF_UA = OFF_PROJ + al((size_t)NTOK * PLD * 2);
constexpr size_t OFF_MRG = OFF_UA + al((size_t)NTOK * 2048 * 2);
constexpr size_t OFF_X1 = OFF_MRG + al((size_t)NTOK * D * 2);
constexpr size_t OFF_TMP = OFF_X1 + al((size_t)NTOK * D * 4);
constexpr size_t OFF_GATE = OFF_TMP + al((size_t)NTOK * D * 4);
constexpr size_t OFF_LIST = OFF_GATE + al((size_t)NASG * 4);
constexpr size_t OFF_ACT = OFF_LIST + al((size_t)E * NTOK * 4);
constexpr size_t OFF_Y = OFF_ACT + al((size_t)ACT_ROWS * D * 2);
constexpr size_t WS_END = OFF_Y + al((size_t)NASG * D * 2);
}
using namespace cfg;

__device__ __forceinline__ float bf2f(bf16_t v) { return __uint_as_float(((unsigned)v) << 16); }
__device__ __forceinline__ bf16_t f2bf(float f) { unsigned u = __float_as_uint(f); u += 0x7fffu + ((u >> 16) & 1u); return (bf16_t)(u >> 16); }
__device__ __forceinline__ float sigmoidf_(float x) { return 1.0f / (1.0f + __expf(-x)); }

struct Ptrs {
    const float *x, *c, *ada_w, *ada_b, *norm_mix_g, *w_in, *b_forget, *conv_w, *w_conv_out, *w_attn_out, *w_out, *norm_ffn_g,
        *router_w, *router_b, *w_gate, *b_gate, *w_up, *b_up, *w_down, *b_down, *final_g;
    float* out; unsigned char* ws;
};

#define LAS __attribute__((address_space(3)))
typedef short bf16x8 __attribute__((ext_vector_type(8)));
typedef float f32x2_t __attribute__((ext_vector_type(2)));
typedef __bf16 bf16x2_t __attribute__((ext_vector_type(2)));
__device__ __forceinline__ unsigned cvtpk(float lo, float hi) { f32x2_t v = {lo, hi}; bf16x2_t b = __builtin_convertvector(v, bf16x2_t); return __builtin_bit_cast(unsigned, b); }
__device__ __forceinline__ float bflo(unsigned w) { return __uint_as_float(w << 16); }
__device__ __forceinline__ float bfhi(unsigned w) { return __uint_as_float(w & 0xffff0000u); }
constexpr int GEMM_LDS = 131072;

struct GemmT {
    int wr, wc, fr, fq;
    int aR, aC;
    unsigned a_w;
    int b_k, b_wc, b_p, b_cin;
    unsigned b_w;
    unsigned a_r, b_r;
    __device__ __forceinline__ void init() {
        const int tid = threadIdx.x, wid = tid >> 6, lane = tid & 63;
        wr = wid >> 2; wc = wid & 3; fr = lane & 15; fq = lane >> 4;
        aR = (wid >> 1) * 16 + (lane >> 2); aC = (wid & 1) * 32 + (((lane & 3) ^ ((lane >> 5) << 1)) * 8);
        a_w = (unsigned)(wid * 1024 + lane * 16);
        const int kh = wid & 1, kc = lane & 3, sgl = lane >> 2;
        b_k = kh * 32 + kc * 8; b_wc = wid >> 1; b_p = (sgl >> 3) & 1; b_cin = (sgl & 3) * 8 + ((sgl >> 2) & 1) * 4;
        const int slot0 = b_wc * 64 + sgl * 4, row16 = (sgl & 3) * 4;
        b_w = (unsigned)(((slot0 >> 4) * 2 + kh) * 1024 + ((row16 * 64 + kc * 16) ^ ((row16 >> 3) << 5)));
        const unsigned lo = (unsigned)((fr * 64 + fq * 16) ^ ((fr >> 3) << 5));
        a_r = (unsigned)(wr * 16384) + lo; b_r = 32768u + (unsigned)(wc * 8192) + lo;
    }
};

__device__ __forceinline__ void gemm_kloop(f32x4 (&acc)[8][4], LAS unsigned char* lds, const GemmT& T,
                                           const unsigned char* a0, const unsigned char* a1, const unsigned char* a2, const unsigned char* a3,
                                           const unsigned char* bp, size_t ldbB, int nt) {
    u32x4 sa0, sa1, sa2, sa3; f32x4 sb[8];
#define G_ISSUE(t) do { const size_t ko_ = (size_t)(t) * 128; sa0 = *(const u32x4*)(a0 + ko_); sa1 = *(const u32x4*)(a1 + ko_); sa2 = *(const u32x4*)(a2 + ko_); sa3 = *(const u32x4*)(a3 + ko_); \
        const unsigned char* bq_ = bp + (size_t)(t) * 64 * ldbB; _Pragma("unroll") for (int i_ = 0; i_ < 8; ++i_) sb[i_] = *(const f32x4*)(bq_ + (size_t)i_ * ldbB); } while (0)
#define G_WRITE(buf) do { LAS unsigned char* d_ = lds + (buf) * 65536; \
        *(LAS u32x4*)(d_ + T.a_w) = sa0; *(LAS u32x4*)(d_ + T.a_w + 8192) = sa1; *(LAS u32x4*)(d_ + T.a_w + 16384) = sa2; *(LAS u32x4*)(d_ + T.a_w + 24576) = sa3; \
        _Pragma("unroll") for (int j_ = 0; j_ < 4; ++j_) { u32x4 w_; w_.x = cvtpk(sb[0][j_], sb[1][j_]); w_.y = cvtpk(sb[2][j_], sb[3][j_]); w_.z = cvtpk(sb[4][j_], sb[5][j_]); w_.w = cvtpk(sb[6][j_], sb[7][j_]); \
            *(LAS u32x4*)(d_ + 32768 + T.b_w + j_ * 64) = w_; } } while (0)
#define G_KSTEP(buf, ks) do { bf16x8 At_[8], Bf_[4]; const LAS unsigned char* s_ = lds + (buf) * 65536 + (ks) * 1024; \
        _Pragma("unroll") for (int m_ = 0; m_ < 8; ++m_) At_[m_] = *(const LAS bf16x8*)(s_ + T.a_r + m_ * 2048); \
        _Pragma("unroll") for (int n_ = 0; n_ < 4; ++n_) Bf_[n_] = *(const LAS bf16x8*)(s_ + T.b_r + n_ * 2048); \
        _Pragma("unroll") for (int m_ = 0; m_ < 8; ++m_) _Pragma("unroll") for (int n_ = 0; n_ < 4; ++n_) acc[m_][n_] = __builtin_amdgcn_mfma_f32_16x16x32_bf16(Bf_[n_], At_[m_], acc[m_][n_], 0, 0, 0); \
        __builtin_amdgcn_sched_barrier(0); } while (0)
#define G_BAR() do { asm volatile("s_waitcnt lgkmcnt(0)" ::: "memory"); __builtin_amdgcn_s_barrier(); asm volatile("" ::: "memory"); } while (0)
    G_ISSUE(0); G_WRITE(0); if (nt > 1) G_ISSUE(1); G_BAR();
    for (int t = 0; t < nt; ++t) { const int cur = t & 1;
        if (t + 1 < nt) G_WRITE(cur ^ 1);
        if (t + 2 < nt) G_ISSUE(t + 2);
        G_KSTEP(cur, 0); G_KSTEP(cur, 1);
        G_BAR(); }
#undef G_ISSUE
#undef G_WRITE
#undef G_KSTEP
}
__device__ __forceinline__ void acc_zero(f32x4 (&acc)[8][4]) {
#pragma unroll
    for (int m = 0; m < 8; ++m)
#pragma unroll
        for (int n = 0; n < 4; ++n) acc[m][n] = (f32x4){0.f, 0.f, 0.f, 0.f};
}
__device__ __forceinline__ u32x4 pack8(const f32x4 a, const f32x4 b) { u32x4 w; w.x = cvtpk(a[0], a[1]); w.y = cvtpk(a[2], a[3]); w.z = cvtpk(b[0], b[1]); w.w = cvtpk(b[2], b[3]); return w; }
__device__ __forceinline__ int vwg_id() { const int G = gridDim.x; return (G % 8 == 0) ? (int)((blockIdx.x % 8) * (G / 8) + blockIdx.x / 8) : (int)blockIdx.x; }

__device__ __forceinline__ void phase_gemm1(const Ptrs& p, LAS unsigned char* lds) {
    GemmT T; T.init();
    const bf16_t* ha = (const bf16_t*)(p.ws + OFF_HA); bf16_t* pr = (bf16_t*)(p.ws + OFF_PROJ);
    for (int u = vwg_id(); u < 32 * 40; u += gridDim.x) {
        const int pm = (u >> 3) & 31, pn = (u & 7) + 8 * (u >> 8);
        const int row0 = pm * 256, pcol0 = pn * 256, wcol0 = pcol0 < C_GC ? pcol0 : pcol0 + (W_GC - C_GC);
        const unsigned char* ab = (const unsigned char*)(ha + (size_t)(row0 + T.aR) * D + T.aC);
        const unsigned char* bp = (const unsigned char*)(p.w_in + (size_t)T.b_k * NIN + wcol0 + T.b_wc * 64 + T.b_p * 32 + T.b_cin);
        f32x4 acc[8][4]; acc_zero(acc);
        gemm_kloop(acc, lds, T, ab, ab + (size_t)64 * D * 2, ab + (size_t)128 * D * 2, ab + (size_t)192 * D * 2, bp, (size_t)NIN * 4, D / 64);
        const int mode = (pcol0 >= C_GC) ? 2 : ((pcol0 >= C_Q && pcol0 < C_K) ? 1 : 0);
#pragma unroll
        for (int m = 0; m < 8; ++m) { const int row = row0 + T.wr * 128 + m * 16 + T.fr;
#pragma unroll
            for (int pp = 0; pp < 2; ++pp) { f32x4 v0 = acc[m][2 * pp], v1 = acc[m][2 * pp + 1];
                if (mode == 1) { v0 *= QSCALE; v1 *= QSCALE; }
                else if (mode == 2) {
#pragma unroll
                    for (int j = 0; j < 4; ++j) { v0[j] = sigmoidf_(v0[j]); v1[j] = sigmoidf_(v1[j]); } }
                *(u32x4*)(pr + (size_t)row * PLD + pcol0 + T.wc * 64 + pp * 32 + T.fq * 8) = pack8(v0, v1); } }
    }
}
__device__ __forceinline__ void phase_merge(const Ptrs& p, LAS unsigned char* lds) {
    GemmT T; T.init();
    const bf16_t* ua = (const bf16_t*)(p.ws + OFF_UA); const bf16_t* pr = (const bf16_t*)(p.ws + OFF_PROJ); bf16_t* mg = (bf16_t*)(p.ws + OFF_MRG);
    for (int u = vwg_id(); u < 32 * 8; u += gridDim.x) {
        const int pm = u >> 3, pn = u & 7, row0 = pm * 256, col0 = pn * 256;
        const size_t cofs = (size_t)T.b_k * D + col0 + T.b_wc * 64 + T.b_p * 32 + T.b_cin;
        f32x4 acc[8][4]; acc_zero(acc);
#pragma unroll 1
        for (int seg = 0; seg < 2; ++seg) {
            const unsigned char* ab = (const unsigned char*)(ua + (size_t)(row0 + T.aR) * 2048 + T.aC + seg * 1024);
            const unsigned char* bp = (const unsigned char*)((seg ? p.w_attn_out : p.w_conv_out) + cofs);
            gemm_kloop(acc, lds, T, ab, ab + (size_t)64 * 4096, ab + (size_t)128 * 4096, ab + (size_t)192 * 4096, bp, (size_t)D * 4, 1024 / 64);
            int rowb = row0 + T.wr * 128 + T.fr; asm volatile("" : "+v"(rowb));
#pragma unroll
            for (int m = 0; m < 8; ++m) { const int row = rowb + m * 16;
#pragma unroll
                for (int pp = 0; pp < 2; ++pp) { const int c = col0 + T.wc * 64 + pp * 32 + T.fq * 8; const size_t o = (size_t)row * PLD + c;
                    const u32x4 sa = *(const u32x4*)(pr + o + C_GA); u32x4 sc = sa; if (seg == 0) sc = *(const u32x4*)(pr + o + C_GC);
                    f32x4 v0 = acc[m][2 * pp], v1 = acc[m][2 * pp + 1];
#pragma unroll
                    for (int j = 0; j < 2; ++j) {
                        const float a0 = bflo(sa[j]), a1 = bfhi(sa[j]), a2 = bflo(sa[2 + j]), a3 = bfhi(sa[2 + j]);
                        if (seg == 0) { v0[2 * j] *= bflo(sc[j]) / a0; v0[2 * j + 1] *= bfhi(sc[j]) / a1; v1[2 * j] *= bflo(sc[2 + j]) / a2; v1[2 * j + 1] *= bfhi(sc[2 + j]) / a3; }
                        else { v0[2 * j] *= a0; v0[2 * j + 1] *= a1; v1[2 * j] *= a2; v1[2 * j + 1] *= a3; } }
                    acc[m][2 * pp] = v0; acc[m][2 * pp + 1] = v1;
                    if (seg == 1) *(u32x4*)(mg + (size_t)row * D + c) = pack8(v0, v1); }
                asm volatile("" ::: "memory"); }
        }
    }
}
__device__ __forceinline__ void phase_out(const Ptrs& p, LAS unsigned char* lds) {
    GemmT T; T.init();
    const bf16_t* mg = (const bf16_t*)(p.ws + OFF_MRG); float* x1 = (float*)(p.ws + OFF_X1); const float* mod = (const float*)(p.ws + OFF_MOD);
    for (int u = vwg_id(); u < 32 * 8; u += gridDim.x) {
        const int pm = u >> 3, pn = u & 7, row0 = pm * 256, col0 = pn * 256;
        const unsigned char* ab = (const unsigned char*)(mg + (size_t)(row0 + T.aR) * D + T.aC);
        const unsigned char* bp = (const unsigned char*)(p.w_out + (size_t)T.b_k * D + col0 + T.b_wc * 64 + T.b_p * 32 + T.b_cin);
        f32x4 acc[8][4]; acc_zero(acc);
        gemm_kloop(acc, lds, T, ab, ab + (size_t)64 * 4096, ab + (size_t)128 * 4096, ab + (size_t)192 * 4096, bp, (size_t)D * 4, D / 64);
        const float* gm = mod + (size_t)(row0 / S) * NMOD + 2 * D;
#pragma unroll
        for (int m = 0; m < 8; ++m) { const int row = row0 + T.wr * 128 + m * 16 + T.fr;
#pragma unroll
            for (int pp = 0; pp < 2; ++pp) { const int c = col0 + T.wc * 64 + pp * 32 + T.fq * 8; const size_t o = (size_t)row * D + c;
                const f32x4 g0 = *(const f32x4*)(gm + c), g1 = *(const f32x4*)(gm + c + 4), x0 = *(const f32x4*)(p.x + o), x1v = *(const f32x4*)(p.x + o + 4);
                *(f32x4*)(x1 + o) = x0 + g0 * acc[m][2 * pp]; *(f32x4*)(x1 + o + 4) = x1v + g1 * acc[m][2 * pp + 1]; } }
    }
}
struct MoeUnit { int e, mt, nt, cnt, base; };
__device__ __forceinline__ bool moe_unit(const int* counts, int u, int ntiles_n, MoeUnit& mu) {
    int base = 0;
    for (int e = 0; e < E; ++e) { const int c = counts[e], tm = (c + 255) >> 8, nu = tm * ntiles_n;
        if (u < nu) { mu.e = e; mu.cnt = c; mu.base = base; mu.nt = u / tm; mu.mt = u - mu.nt * tm; return true; }
        u -= nu; base += tm * 256; }
    return false;
}
__device__ __forceinline__ void phase_moe_gu(const Ptrs& p, LAS unsigned char* lds) {
    GemmT T; T.init();
    const int* counts = (const int*)(p.ws + OFF_CTRL); const bf16_t* h2 = (const bf16_t*)(p.ws + OFF_HA); bf16_t* act = (bf16_t*)(p.ws + OFF_ACT);
    MoeUnit mu;
    for (int u = vwg_id(); moe_unit(counts, u, 16, mu); u += gridDim.x) {
        const int* list = (const int*)(p.ws + OFF_LIST) + (size_t)mu.e * NTOK; const int i0 = mu.mt * 256, n0 = mu.nt * 128;
        const unsigned char* ap[4];
#pragma unroll
        for (int i = 0; i < 4; ++i) { const int r = i0 + T.aR + 64 * i; const int tok = (r < mu.cnt) ? (list[r] >> 2) : 0; ap[i] = (const unsigned char*)(h2 + (size_t)tok * D + T.aC); }
        const float* wsel = (T.b_p ? p.w_up : p.w_gate) + (size_t)mu.e * D * D;
        const unsigned char* bp = (const unsigned char*)(wsel + (size_t)T.b_k * D + n0 + T.b_wc * 32 + T.b_cin);
        f32x4 acc[8][4]; acc_zero(acc);
        gemm_kloop(acc, lds, T, ap[0], ap[1], ap[2], ap[3], bp, (size_t)D * 4, D / 64);
        const int c = n0 + T.wc * 32 + T.fq * 8;
        const float* bg = p.b_gate + (size_t)mu.e * D + c; const float* bu = p.b_up + (size_t)mu.e * D + c;
        const f32x4 bg0 = *(const f32x4*)bg, bg1 = *(const f32x4*)(bg + 4), bu0 = *(const f32x4*)bu, bu1 = *(const f32x4*)(bu + 4);
#pragma unroll
        for (int m = 0; m < 8; ++m) { const int r = i0 + T.wr * 128 + m * 16 + T.fr;
            f32x4 g0 = acc[m][0] + bg0, g1 = acc[m][1] + bg1, u0 = acc[m][2] + bu0, u1 = acc[m][3] + bu1;
#pragma unroll
            for (int j = 0; j < 4; ++j) { float g = fminf(g0[j], 7.0f), uu = fminf(fmaxf(u0[j], -7.0f), 7.0f); g0[j] = (uu + 1.0f) * g * sigmoidf_(1.702f * g);
                g = fminf(g1[j], 7.0f); uu = fminf(fmaxf(u1[j], -7.0f), 7.0f); g1[j] = (uu + 1.0f) * g * sigmoidf_(1.702f * g); }
            if (r < mu.cnt) *(u32x4*)(act + (size_t)(mu.base + r) * D + c) = pack8(g0, g1); }
    }
}
__device__ __forceinline__ void phase_moe_down(const Ptrs& p, LAS unsigned char* lds) {
    GemmT T; T.init();
    const int* counts = (const int*)(p.ws + OFF_CTRL); const bf16_t* act = (const bf16_t*)(p.ws + OFF_ACT); bf16_t* y = (bf16_t*)(p.ws + OFF_Y); const float* gate = (const float*)(p.ws + OFF_GATE);
    MoeUnit mu;
    for (int u = vwg_id(); moe_unit(counts, u, 8, mu); u += gridDim.x) {
        const int* list = (const int*)(p.ws + OFF_LIST) + (size_t)mu.e * NTOK; const int i0 = mu.mt * 256, col0 = mu.nt * 256;
        const unsigned char* ab = (const unsigned char*)(act + (size_t)(mu.base + i0 + T.aR) * D + T.aC);
        const unsigned char* bp = (const unsigned char*)(p.w_down + (size_t)mu.e * D * D + (size_t)T.b_k * D + col0 + T.b_wc * 64 + T.b_p * 32 + T.b_cin);
        f32x4 acc[8][4]; acc_zero(acc);
        gemm_kloop(acc, lds, T, ab, ab + (size_t)64 * 4096, ab + (size_t)128 * 4096, ab + (size_t)192 * 4096, bp, (size_t)D * 4, D / 64);
        const float* bd = p.b_down + (size_t)mu.e * D;
#pragma unroll
        for (int m = 0; m < 8; ++m) { const int r = i0 + T.wr * 128 + m * 16 + T.fr;
            if (r < mu.cnt) { const int a = list[r]; const float gt = gate[a];
#pragma unroll
                for (int pp = 0; pp < 2; ++pp) { const int c = col0 + T.wc * 64 + pp * 32 + T.fq * 8;
                    const f32x4 v0 = (acc[m][2 * pp] + *(const f32x4*)(bd + c)) * gt, v1 = (acc[m][2 * pp + 1] + *(const f32x4*)(bd + c + 4)) * gt;
                    *(u32x4*)(y + (size_t)a * D + c) = pack8(v0, v1); } } }
    }
}
extern __shared__ __attribute__((aligned(1024))) unsigned char dyn_lds[];
__global__ void __launch_bounds__(512, 2) k_gemm1(Ptrs p) { phase_gemm1(p, (LAS unsigned char*)dyn_lds); }
__global__ void __launch_bounds__(512, 2) k_merge(Ptrs p) { phase_merge(p, (LAS unsigned char*)dyn_lds); }
__global__ void __launch_bounds__(512, 2) k_out(Ptrs p) { phase_out(p, (LAS unsigned char*)dyn_lds); }
__global__ void __launch_bounds__(512, 2) k_moe_gu(Ptrs p) { phase_moe_gu(p, (LAS unsigned char*)dyn_lds); }
__global__ void __launch_bounds__(512, 2) k_moe_down(Ptrs p) { phase_moe_down(p, (LAS unsigned char*)dyn_lds); }

typedef float f32x16 __attribute__((ext_vector_type(16)));
typedef short v4i16_t __attribute__((ext_vector_type(4)));
__device__ __forceinline__ float wave_sum(float v) {
#pragma unroll
    for (int o = 32; o > 0; o >>= 1) v += __shfl_xor(v, o);
    return v;
}
__device__ __forceinline__ float reduce16(float (&v)[16], int lane) {
    float a[8], b[4], c[2];
    { const bool up = (lane & 32) != 0;
#pragma unroll
      for (int i = 0; i < 8; ++i) { const float send = up ? v[i] : v[i + 8], keep = up ? v[i + 8] : v[i]; a[i] = keep + __shfl_xor(send, 32); } }
    { const bool up = (lane & 16) != 0;
#pragma unroll
      for (int i = 0; i < 4; ++i) { const float send = up ? a[i] : a[i + 4], keep = up ? a[i + 4] : a[i]; b[i] = keep + __shfl_xor(send, 16); } }
    { const bool up = (lane & 8) != 0;
#pragma unroll
      for (int i = 0; i < 2; ++i) { const float send = up ? b[i] : b[i + 2], keep = up ? b[i + 2] : b[i]; c[i] = keep + __shfl_xor(send, 8); } }
    float d; { const bool up = (lane & 4) != 0; const float send = up ? c[0] : c[1], keep = up ? c[1] : c[0]; d = keep + __shfl_xor(send, 4); }
    d += __shfl_xor(d, 1); d += __shfl_xor(d, 2);
    return d;
}
constexpr int WT_LDS = 16 * 2048 * 4;
constexpr int AUX_LDS = WT_LDS + 16384 + 4096 + 2048;

__device__ __forceinline__ void phase_mod(const Ptrs& p, LAS unsigned char* lds) {
    LAS float* sc = (LAS float*)lds;
    LAS float* red = (LAS float*)(lds + 16384);
    const int tid = threadIdx.x;
    for (int i = tid; i < B * D; i += 512) { const float v = p.c[i]; sc[i] = v / (1.0f + __expf(-v)); }
    __syncthreads();
    float* mod = (float*)(p.ws + OFF_MOD);
    for (int ch = vwg_id(); ch < NMOD / 48; ch += gridDim.x) {
        const int cq = tid % 12, kg = tid / 12;
        if (kg < 42) {
            f32x4 a0 = {0.f, 0.f, 0.f, 0.f}, a1 = {0.f, 0.f, 0.f, 0.f};
            const float* wp = p.ada_w + (size_t)ch * 48 + cq * 4;
#pragma unroll 7
            for (int k = kg; k < D; k += 42) { const f32x4 w = *(const f32x4*)(wp + (size_t)k * NMOD); a0 += w * sc[k]; a1 += w * sc[D + k]; }
#pragma unroll
            for (int j = 0; j < 4; ++j) { red[kg * 96 + cq * 4 + j] = a0[j]; red[kg * 96 + 48 + cq * 4 + j] = a1[j]; }
        }
        __syncthreads();
        if (tid < 96) { float s = 0.f; for (int g = 0; g < 42; ++g) s += red[g * 96 + tid]; const int b = tid / 48, c = ch * 48 + tid % 48; mod[(size_t)b * NMOD + c] = s + p.ada_b[c]; }
        __syncthreads();
    }
}
__device__ __forceinline__ void stage_wt16(LAS float* wt, const float* w, size_t ldw) {
    const int tid = threadIdx.x;
    for (int i = tid; i < 2048 * 4; i += 512) { const int k = i >> 2, q = i & 3; const f32x4 v = *(const f32x4*)(w + (size_t)k * ldw + q * 4);
#pragma unroll
        for (int j = 0; j < 4; ++j) wt[(q * 4 + j) * 2048 + k] = v[j]; }
}
__device__ __forceinline__ void phase_norm1(const Ptrs& p, LAS unsigned char* lds) {
    LAS float* wt = (LAS float*)lds; LAS float* gs = (LAS float*)(lds + WT_LDS); LAS float* sh = gs + 2048;
    const int tid = threadIdx.x, lane = tid & 63, wid = tid >> 6;
    stage_wt16(wt, p.w_in + W_F, NIN);
    bf16_t* ha = (bf16_t*)(p.ws + OFF_HA); float* logf = (float*)(p.ws + OFF_LOGF);
    for (int blk = vwg_id(); blk < NTOK / 32; blk += gridDim.x) {
        const int b = (blk * 32) / S; const float* mod = (const float*)(p.ws + OFF_MOD) + (size_t)b * NMOD;
        __syncthreads();
        for (int i = tid; i < 2048; i += 512) { gs[i] = p.norm_mix_g[i] * (1.0f + mod[D + i]); sh[i] = mod[i]; }
        __syncthreads();
#pragma unroll 1
        for (int rr = 0; rr < 4; ++rr) {
            asm volatile("" ::: "memory");
            const int row = blk * 32 + wid * 4 + rr; const float* xr = p.x + (size_t)row * D;
            f32x4 v[8]; float ss = 0.f;
#pragma unroll
            for (int c = 0; c < 8; ++c) { v[c] = *(const f32x4*)(xr + c * 256 + lane * 4); ss += v[c][0] * v[c][0] + v[c][1] * v[c][1] + v[c][2] * v[c][2] + v[c][3] * v[c][3]; }
            ss = wave_sum(ss); const float r = rsqrtf(ss * (1.0f / D) + EPS);
#pragma unroll
            for (int c = 0; c < 8; ++c) { const int k = c * 256 + lane * 4; const f32x4 g4 = *(const LAS f32x4*)(gs + k), s4 = *(const LAS f32x4*)(sh + k);
                v[c] = (v[c] * r) * g4 + s4; u32x2 w; w.x = cvtpk(v[c][0], v[c][1]); w.y = cvtpk(v[c][2], v[c][3]); *(u32x2*)(ha + (size_t)row * D + k) = w; }
            float acc[16];
#pragma unroll
            for (int j = 0; j < 16; ++j) { float a = 0.f;
#pragma unroll
                for (int c = 0; c < 8; ++c) { const f32x4 w4 = *(const LAS f32x4*)(wt + j * 2048 + c * 256 + lane * 4); a += v[c][0] * w4[0] + v[c][1] * w4[1] + v[c][2] * w4[2] + v[c][3] * w4[3]; }
                acc[j] = a; }
            const float tot = reduce16(acc, lane);
            if ((lane & 3) == 0) { const int j = ((lane >> 5) & 1) * 8 + ((lane >> 4) & 1) * 4 + ((lane >> 3) & 1) * 2 + ((lane >> 2) & 1);
                const float z = tot + p.b_forget[j]; logf[((size_t)b * H + j) * S + (row % S)] = fminf(z, 0.f) - log1pf(__expf(-fabsf(z))); }
        }
    }
}
__device__ __forceinline__ void phase_scan_conv(const Ptrs& p, LAS unsigned char* lds) {
    const int tid = threadIdx.x, lane = tid & 63, wid = tid >> 6; LAS float* wtot = (LAS float*)lds;
    for (int sq = vwg_id(); sq < B * H; sq += gridDim.x) {
        const float* lf = (const float*)(p.ws + OFF_LOGF) + (size_t)sq * S; float* fc = (float*)(p.ws + OFF_FCUM) + (size_t)sq * S;
        f32x4 a = *(const f32x4*)(lf + tid * 8), b4 = *(const f32x4*)(lf + tid * 8 + 4);
        a[1] += a[0]; a[2] += a[1]; a[3] += a[2]; b4[0] += a[3]; b4[1] += b4[0]; b4[2] += b4[1]; b4[3] += b4[2];
        const float tot = b4[3]; float inc = tot;
#pragma unroll
        for (int o = 1; o < 64; o <<= 1) { const float n = __shfl_up(inc, o); if (lane >= o) inc += n; }
        __syncthreads();
        if (lane == 63) wtot[wid] = inc;
        __syncthreads();
        float off = inc - tot; for (int w = 0; w < wid; ++w) off += wtot[w];
        *(f32x4*)(fc + tid * 8) = (a + off) * LOG2E; *(f32x4*)(fc + tid * 8 + 4) = (b4 + off) * LOG2E;
    }
    const bf16_t* pr = (const bf16_t*)(p.ws + OFF_PROJ); bf16_t* ua = (bf16_t*)(p.ws + OFF_UA);
    for (int item = vwg_id() * 512 + tid; item < (NTOK / 8) * (DC / 8); item += gridDim.x * 512) {
        const int cg = item & 127, rc = item >> 7, r0 = rc * 8, c = cg * 8;
        float w0[8], w1[8], w2[8], pm2[8], pm1[8];
#pragma unroll
        for (int j = 0; j < 8; ++j) { w0[j] = p.conv_w[c + j]; w1[j] = p.conv_w[DC + c + j]; w2[j] = p.conv_w[2 * DC + c + j]; pm2[j] = 0.f; pm1[j] = 0.f; }
        if ((r0 % S) != 0) {
#pragma unroll
            for (int d = 0; d < 2; ++d) { const bf16_t* q = pr + (size_t)(r0 - 2 + d) * PLD; const u32x4 xc = *(const u32x4*)(q + C_XC + c), cc = *(const u32x4*)(q + C_CC + c);
#pragma unroll
                for (int j = 0; j < 4; ++j) { const float e0 = bflo(xc[j]) * bflo(cc[j]), e1 = bfhi(xc[j]) * bfhi(cc[j]); if (d == 0) { pm2[2 * j] = e0; pm2[2 * j + 1] = e1; } else { pm1[2 * j] = e0; pm1[2 * j + 1] = e1; } } }
        }
#pragma unroll
        for (int i = 0; i < 8; ++i) { const bf16_t* q = pr + (size_t)(r0 + i) * PLD; const u32x4 xc = *(const u32x4*)(q + C_XC + c), cc = *(const u32x4*)(q + C_CC + c), cb = *(const u32x4*)(q + C_CB + c);
            float o[8];
#pragma unroll
            for (int j = 0; j < 4; ++j) { const float e0 = bflo(xc[j]) * bflo(cc[j]), e1 = bfhi(xc[j]) * bfhi(cc[j]);
                o[2 * j] = bflo(cb[j]) * (w0[2 * j] * pm2[2 * j] + w1[2 * j] * pm1[2 * j] + w2[2 * j] * e0); o[2 * j + 1] = bfhi(cb[j]) * (w0[2 * j + 1] * pm2[2 * j + 1] + w1[2 * j + 1] * pm1[2 * j + 1] + w2[2 * j + 1] * e1);
                pm2[2 * j] = pm1[2 * j]; pm2[2 * j + 1] = pm1[2 * j + 1]; pm1[2 * j] = e0; pm1[2 * j + 1] = e1; }
            u32x4 w; w.x = cvtpk(o[0], o[1]); w.y = cvtpk(o[2], o[3]); w.z = cvtpk(o[4], o[5]); w.w = cvtpk(o[6], o[7]);
            *(u32x4*)(ua + (size_t)(r0 + i) * 2048 + c) = w; }
    }
}
constexpr int ATT_LDS = 16384 + 16384 + 512;
__device__ __forceinline__ int crow(int r, int hi) { return (r & 3) + 8 * (r >> 2) + 4 * hi; }
__device__ __forceinline__ void phase_attn(const Ptrs& p, LAS unsigned char* lds) {
    const int tid = threadIdx.x, lane = tid & 63, wid = __builtin_amdgcn_readfirstlane(tid >> 6), r32 = lane & 31, hi = lane >> 5;
    const bf16_t* pr = (const bf16_t*)(p.ws + OFF_PROJ); bf16_t* ua = (bf16_t*)(p.ws + OFF_UA);
    const int k_row = tid >> 3, k_ch = tid & 7;
    const unsigned kdst = (unsigned)(k_row * 128 + ((k_ch ^ ((k_row >> 1) & 7)) * 16));
    const int v_ch = (tid & 3) + 4 * ((tid >> 3) & 1), v_kv = ((tid >> 2) & 1) + 2 * (tid >> 4);
    const unsigned vdst = (unsigned)(16384 + ((v_kv >> 3) * 2 + (v_ch >> 2)) * 512 + (v_kv & 7) * 64 + (v_ch & 3) * 16);
    const int ksw = (r32 >> 1) & 7; const unsigned kfr = (unsigned)(r32 * 128);
    const unsigned vfr = (unsigned)(16384 + (4 * hi + ((lane & 15) >> 2)) * 64 + ((lane >> 4) & 1) * 32 + (lane & 3) * 8);
    constexpr float THR = 6.0f;
    for (int pi = vwg_id(); pi < 256; pi += gridDim.x) {
#pragma unroll 1
        for (int half = 0; half < 2; ++half) {
            const int s_ = pi & 7, qb = half ? 15 - s_ : s_, bh = pi >> 3, b = bh >> 4, h = bh & 15, q0 = qb * 256;
            const float* fc = (const float*)(p.ws + OFF_FCUM) + (size_t)bh * S; const size_t rowb = (size_t)b * S;
            const bf16_t* ksrc = pr + (rowb + k_row) * PLD + C_K + h * 64 + k_ch * 8;
            const bf16_t* vsrc = pr + (rowb + v_kv) * PLD + C_V + h * 64 + v_ch * 8;
            const int qrow = q0 + 32 * wid + r32;
            bf16x8 qr[4];
#pragma unroll
            for (int d0 = 0; d0 < 4; ++d0) qr[d0] = *(const bf16x8*)(pr + (rowb + qrow) * PLD + C_Q + h * 64 + 16 * d0 + 8 * hi);
            const float Fq = fc[qrow];
            const int JT = 4 * qb + 4, jmax = 4 * qb + (wid >> 1);
            float mhat = 0.f, lsum = 0.f; f32x16 o0, o1;
#pragma unroll
            for (int r = 0; r < 16; ++r) { o0[r] = 0.f; o1[r] = 0.f; }
            u32x4 kreg = *(const u32x4*)(ksrc + (size_t)(JT - 1) * 64 * PLD), vreg = *(const u32x4*)(vsrc + (size_t)(JT - 1) * 64 * PLD); f32x4 freg = {0.f, 0.f, 0.f, 0.f};
            if (tid < 16) freg = *(const f32x4*)(fc + (JT - 1) * 64 + tid * 4);
            *(LAS u32x4*)(lds + kdst) = kreg; *(LAS u32x4*)(lds + vdst) = vreg; if (tid < 16) *(LAS f32x4*)(lds + 32768 + tid * 16) = freg;
            G_BAR();
#pragma unroll 1
            for (int j = JT - 1; j >= 0; --j) {
                const int cur = (JT - 1 - j) & 1;
                if (j > 0) { kreg = *(const u32x4*)(ksrc + (size_t)(j - 1) * 64 * PLD); vreg = *(const u32x4*)(vsrc + (size_t)(j - 1) * 64 * PLD); if (tid < 16) freg = *(const f32x4*)(fc + (j - 1) * 64 + tid * 4); }
                if (j <= jmax) {
                    const LAS unsigned char* kb = lds + cur * 8192; const LAS float* fk = (const LAS float*)(lds + 32768 + cur * 256);
                    f32x16 p0, p1; const float base = Fq - mhat;
#pragma unroll
                    for (int g = 0; g < 4; ++g) { const f32x4 fa = *(const LAS f32x4*)(fk + 8 * g + 4 * hi), fb = *(const LAS f32x4*)(fk + 32 + 8 * g + 4 * hi);
#pragma unroll
                        for (int i = 0; i < 4; ++i) { p0[4 * g + i] = base - fa[i]; p1[4 * g + i] = base - fb[i]; } }
#pragma unroll
                    for (int d0 = 0; d0 < 4; ++d0) { const unsigned a = kfr + (unsigned)(((2 * d0 + hi) ^ ksw) * 16);
                        const bf16x8 k0 = *(const LAS bf16x8*)(kb + a), k1 = *(const LAS bf16x8*)(kb + a + 4096);
                        p0 = __builtin_amdgcn_mfma_f32_32x32x16_bf16(k0, qr[d0], p0, 0, 0, 0); p1 = __builtin_amdgcn_mfma_f32_32x32x16_bf16(k1, qr[d0], p1, 0, 0, 0); }
                    if (j == jmax) { const int lim = 32 * (wid & 1) + r32;
#pragma unroll
                        for (int r = 0; r < 16; ++r) { const int kv = crow(r, hi); if (kv > lim) p0[r] = -INFINITY; if (kv + 32 > lim) p1[r] = -INFINITY; } }
                    float rm = fmaxf(p0[0], p1[0]);
#pragma unroll
                    for (int r = 1; r < 16; ++r) rm = fmaxf(rm, fmaxf(p0[r], p1[r]));
                    rm = fmaxf(rm, __shfl_xor(rm, 32));
                    const bool need = (j == jmax) || (rm > THR);
                    if (__any(need)) { const float dl = need ? rm : 0.f; mhat += dl; const float f = __builtin_amdgcn_exp2f(-dl); lsum *= f;
#pragma unroll
                        for (int r = 0; r < 16; ++r) { p0[r] -= dl; p1[r] -= dl; o0[r] *= f; o1[r] *= f; } }
                    float ps = 0.f;
#pragma unroll
                    for (int r = 0; r < 16; ++r) { p0[r] = __builtin_amdgcn_exp2f(p0[r]); p1[r] = __builtin_amdgcn_exp2f(p1[r]); ps += p0[r] + p1[r]; }
                    lsum += ps;
#pragma unroll
                    for (int bl = 0; bl < 2; ++bl)
#pragma unroll
                        for (int ks = 0; ks < 2; ++ks) {
                            u32x4 pw;
                            if (bl == 0) { pw.x = cvtpk(p0[8 * ks], p0[8 * ks + 1]); pw.y = cvtpk(p0[8 * ks + 2], p0[8 * ks + 3]); pw.z = cvtpk(p0[8 * ks + 4], p0[8 * ks + 5]); pw.w = cvtpk(p0[8 * ks + 6], p0[8 * ks + 7]); }
                            else { pw.x = cvtpk(p1[8 * ks], p1[8 * ks + 1]); pw.y = cvtpk(p1[8 * ks + 2], p1[8 * ks + 3]); pw.z = cvtpk(p1[8 * ks + 4], p1[8 * ks + 5]); pw.w = cvtpk(p1[8 * ks + 6], p1[8 * ks + 7]); }
                            const bf16x8 pf = __builtin_bit_cast(bf16x8, pw);
#pragma unroll
                            for (int d0 = 0; d0 < 2; ++d0) { const LAS unsigned char* va = lds + vfr + cur * 8192 + ((4 * bl + 2 * ks) * 2 + d0) * 512;
                                const v4i16_t lo = __builtin_amdgcn_ds_read_tr16_b64_v4i16((LAS v4i16_t*)va), h2 = __builtin_amdgcn_ds_read_tr16_b64_v4i16((LAS v4i16_t*)(va + 1024));
                                const bf16x8 vf = (bf16x8){lo[0], lo[1], lo[2], lo[3], h2[0], h2[1], h2[2], h2[3]};
                                if (d0 == 0) o0 = __builtin_amdgcn_mfma_f32_32x32x16_bf16(vf, pf, o0, 0, 0, 0); else o1 = __builtin_amdgcn_mfma_f32_32x32x16_bf16(vf, pf, o1, 0, 0, 0); } }
                }
                if (j > 0) { LAS unsigned char* d = lds + (cur ^ 1) * 8192; *(LAS u32x4*)(d + kdst) = kreg; *(LAS u32x4*)(d + vdst) = vreg; if (tid < 16) *(LAS f32x4*)(lds + 32768 + (cur ^ 1) * 256 + tid * 16) = freg; }
                G_BAR();
            }
            const float inv = 1.0f / (lsum + __shfl_xor(lsum, 32));
            bf16_t* op = ua + (rowb + qrow) * 2048 + 1024 + h * 64 + 4 * hi;
#pragma unroll
            for (int g = 0; g < 4; ++g) { u32x2 w0, w1; w0.x = cvtpk(o0[4 * g] * inv, o0[4 * g + 1] * inv); w0.y = cvtpk(o0[4 * g + 2] * inv, o0[4 * g + 3] * inv);
                w1.x = cvtpk(o1[4 * g] * inv, o1[4 * g + 1] * inv); w1.y = cvtpk(o1[4 * g + 2] * inv, o1[4 * g + 3] * inv);
                *(u32x2*)(op + 8 * g) = w0; *(u32x2*)(op + 32 + 8 * g) = w1; }
        }
    }
}
__device__ __forceinline__ void phase_norm2_route(const Ptrs& p, LAS unsigned char* lds) {
    LAS float* wt = (LAS float*)lds; LAS float* gs = (LAS float*)(lds + WT_LDS); LAS float* sh = gs + 2048;
    LAS float* lg = (LAS float*)(lds + WT_LDS + 16384);
    const int tid = threadIdx.x, lane = tid & 63, wid = tid >> 6;
    bf16_t* ha = (bf16_t*)(p.ws + OFF_HA); const float* x1 = (const float*)(p.ws + OFF_X1);
    int* counts = (int*)(p.ws + OFF_CTRL); int* list = (int*)(p.ws + OFF_LIST); float* gate = (float*)(p.ws + OFF_GATE);
    for (int blk = vwg_id(); blk < NTOK / 32; blk += gridDim.x) {
        const int b = (blk * 32) / S; const float* mod = (const float*)(p.ws + OFF_MOD) + (size_t)b * NMOD;
        __syncthreads();
        for (int i = tid; i < 2048; i += 512) { gs[i] = p.norm_ffn_g[i] * (1.0f + mod[4 * D + i]); sh[i] = mod[3 * D + i]; }
#pragma unroll 1
        for (int pass = 0; pass < 2; ++pass) {
            __syncthreads();
            stage_wt16(wt, p.router_w + pass * 16, E);
            __syncthreads();
#pragma unroll 1
            for (int rr = 0; rr < 4; ++rr) {
                asm volatile("" ::: "memory");
                const int rl = wid * 4 + rr, row = blk * 32 + rl; const float* xr = x1 + (size_t)row * D;
                f32x4 v[8]; float ss = 0.f;
#pragma unroll
                for (int c = 0; c < 8; ++c) { v[c] = *(const f32x4*)(xr + c * 256 + lane * 4); ss += v[c][0] * v[c][0] + v[c][1] * v[c][1] + v[c][2] * v[c][2] + v[c][3] * v[c][3]; }
                ss = wave_sum(ss); const float r = rsqrtf(ss * (1.0f / D) + EPS);
#pragma unroll
                for (int c = 0; c < 8; ++c) { const int k = c * 256 + lane * 4; const f32x4 g4 = *(const LAS f32x4*)(gs + k), s4 = *(const LAS f32x4*)(sh + k);
                    v[c] = (v[c] * r) * g4 + s4;
                    if (pass == 0) { u32x2 w; w.x = cvtpk(v[c][0], v[c][1]); w.y = cvtpk(v[c][2], v[c][3]); *(u32x2*)(ha + (size_t)row * D + k) = w; } }
                float acc[16];
#pragma unroll
                for (int j = 0; j < 16; ++j) { float a = 0.f;
#pragma unroll
                    for (int c = 0; c < 8; ++c) { const f32x4 w4 = *(const LAS f32x4*)(wt + j * 2048 + c * 256 + lane * 4); a += v[c][0] * w4[0] + v[c][1] * w4[1] + v[c][2] * w4[2] + v[c][3] * w4[3]; }
                    acc[j] = a; }
                const float tot = reduce16(acc, lane);
                if ((lane & 3) == 0) { const int j = ((lane >> 5) & 1) * 8 + ((lane >> 4) & 1) * 4 + ((lane >> 3) & 1) * 2 + ((lane >> 2) & 1); lg[rl * 32 + pass * 16 + j] = tot + p.router_b[pass * 16 + j]; }
            }
        }
        LAS int* lcnt = (LAS int*)(lds + WT_LDS + 16384 + 4096);
        LAS int* lbase = lcnt + 32;
        LAS int* asg_e = lbase + 32;
        LAS int* asg_r = asg_e + 128;
        if (tid < 32) lcnt[tid] = 0;
        __syncthreads();
#pragma unroll 1
        for (int rr = 0; rr < 4; ++rr) {
            const int rl = wid * 4 + rr, row = blk * 32 + rl;
            float val = (lane < 32) ? lg[rl * 32 + lane] : -INFINITY;
            float tv[4]; int ti[4];
#pragma unroll
            for (int k = 0; k < 4; ++k) { float m = val;
#pragma unroll
                for (int o = 32; o > 0; o >>= 1) m = fmaxf(m, __shfl_xor(m, o));
                const unsigned long long bal = __ballot(val == m); const int idx = __ffsll((long long)bal) - 1;
                tv[k] = m; ti[k] = idx; if (lane == idx) val = -INFINITY; }
            if (lane < 4) { float pe[4], sum = 0.f;
#pragma unroll
                for (int k = 0; k < 4; ++k) { pe[k] = __expf(tv[k] - tv[0]); sum += pe[k]; }
                const int e = lane == 0 ? ti[0] : lane == 1 ? ti[1] : lane == 2 ? ti[2] : ti[3]; const float pk = (lane == 0 ? pe[0] : lane == 1 ? pe[1] : lane == 2 ? pe[2] : pe[3]) / sum;
                const int lr = __hip_atomic_fetch_add((int*)(lcnt + e), 1, __ATOMIC_RELAXED, __HIP_MEMORY_SCOPE_WORKGROUP); asg_e[rl * 4 + lane] = e; asg_r[rl * 4 + lane] = lr; gate[row * 4 + lane] = pk; }
        }
        __syncthreads();
        if (tid < 32) lbase[tid] = atomicAdd(&counts[tid], lcnt[tid]);
        __syncthreads();
        if (tid < 128) { const int e = asg_e[tid]; list[(size_t)e * NTOK + lbase[e] + asg_r[tid]] = (blk * 32) * 4 + tid; }
    }
}
__device__ __forceinline__ void phase_final(const Ptrs& p, LAS unsigned char* lds) {
    const int tid = threadIdx.x, lane = tid & 63, wid = tid >> 6;
    const float* x1 = (const float*)(p.ws + OFF_X1); const bf16_t* y = (const bf16_t*)(p.ws + OFF_Y);
    for (int row = vwg_id() * 8 + wid; row < NTOK; row += gridDim.x * 8) {
        const int b = row / S; const float* gf = (const float*)(p.ws + OFF_MOD) + (size_t)b * NMOD + 5 * D; const float* xr = x1 + (size_t)row * D; const bf16_t* yr = y + (size_t)row * 4 * D;
        f32x4 v[8]; float ss = 0.f;
#pragma unroll
        for (int c = 0; c < 8; ++c) { const int k = c * 256 + lane * 4; f32x4 s = {0.f, 0.f, 0.f, 0.f};
#pragma unroll
            for (int q = 0; q < 4; ++q) { const u32x2 w = *(const u32x2*)(yr + (size_t)q * D + k); s[0] += bflo(w.x); s[1] += bfhi(w.x); s[2] += bflo(w.y); s[3] += bfhi(w.y); }
            v[c] = *(const f32x4*)(xr + k) + *(const f32x4*)(gf + k) * s; ss += v[c][0] * v[c][0] + v[c][1] * v[c][1] + v[c][2] * v[c][2] + v[c][3] * v[c][3]; }
        ss = wave_sum(ss); const float r = rsqrtf(ss * (1.0f / D) + EPS);
#pragma unroll
        for (int c = 0; c < 8; ++c) { const int k = c * 256 + lane * 4; *(f32x4*)(p.out + (size_t)row * D + k) = (v[c] * r) * *(const f32x4*)(p.final_g + k); }
    }
}
__global__ void __launch_bounds__(512, 2) k_mod(Ptrs p) { phase_mod(p, (LAS unsigned char*)dyn_lds); }
__global__ void __launch_bounds__(512, 2) k_norm1(Ptrs p) { phase_norm1(p, (LAS unsigned char*)dyn_lds); }
__global__ void __launch_bounds__(512, 2) k_scan_conv(Ptrs p) { phase_scan_conv(p, (LAS unsigned char*)dyn_lds); }
__global__ void __launch_bounds__(512, 2) k_attn(Ptrs p) { phase_attn(p, (LAS unsigned char*)dyn_lds); }
__global__ void __launch_bounds__(512, 2) k_norm2_route(Ptrs p) { phase_norm2_route(p, (LAS unsigned char*)dyn_lds); }
__global__ void __launch_bounds__(512, 2) k_final(Ptrs p) { phase_final(p, (LAS unsigned char*)dyn_lds); }

extern "C" void kernel_launch(void* const* d_in, const int* in_sizes, int n_in, void* d_out, int out_size, void* d_ws, size_t ws_size, hipStream_t stream) {
    Ptrs p{};
    const float** f = (const float**)&p;
    for (int i = 0; i < 21; ++i) f[i] = (const float*)d_in[i];
    p.out = (float*)d_out; p.ws = (unsigned char*)d_ws;
    static bool attr_done = false;
    if (!attr_done) { attr_done = true;
        const void* ks[] = {(const void*)k_gemm1, (const void*)k_merge, (const void*)k_out, (const void*)k_moe_gu, (const void*)k_moe_down, (const void*)k_mod, (const void*)k_norm1, (const void*)k_scan_conv, (const void*)k_attn, (const void*)k_norm2_route, (const void*)k_final};
        for (int i = 0; i < 11; ++i) (void)hipFuncSetAttribute(ks[i], hipFuncAttributeMaxDynamicSharedMemorySize, 160 * 1024); }
    (void)hipMemsetAsync(p.ws + OFF_CTRL, 0, 65536, stream);
    const int G = 256;
    k_mod<<<G, 512, AUX_LDS, stream>>>(p);
    k_norm1<<<G, 512, AUX_LDS, stream>>>(p);
    k_gemm1<<<G, 512, GEMM_LDS, stream>>>(p);
    k_scan_conv<<<G, 512, AUX_LDS, stream>>>(p);
    k_attn<<<G, 512, ATT_LDS, stream>>>(p);
    k_merge<<<G, 512, GEMM_LDS, stream>>>(p);
    k_out<<<G, 512, GEMM_LDS, stream>>>(p);
    k_norm2_route<<<G, 512, AUX_LDS, stream>>>(p);
    k_moe_gu<<<G, 512, GEMM_LDS, stream>>>(p);
    k_moe_down<<<G, 512, GEMM_LDS, stream>>>(p);
    k_final<<<G, 512, AUX_LDS, stream>>>(p);
}
```

```cpp
#include <hip/hip_runtime.h>
#include <stdint.h>

typedef unsigned short bf16_t;
typedef float f32x4 __attribute__((ext_vector_type(4)));
typedef unsigned u32x4 __attribute__((ext_vector_type(4)));
typedef unsigned u32x2 __attribute__((ext_vector_type(2)));

namespace cfg {
constexpr int B = 2, S = 4096, D = 2048, NTOK = B * S, H = 16, DH = 64, DA = 1024, DC = 1024;
constexpr int NIN = 10256, NMOD = 6 * D, E = 32, TOPK = 4, NASG = NTOK * TOPK;
constexpr int PLD = 10240;
constexpr int C_XC = 0, C_CB = 1024, C_CC = 2048, C_Q = 3072, C_K = 4096, C_V = 5120, C_GC = 6144, C_GA = 8192;
constexpr int W_F = 6144, W_GC = 6160, W_GA = 8208;
constexpr float EPS = 1e-6f, LOG2E = 1.4426950408889634f;
constexpr float QSCALE = 0.125f * LOG2E;
constexpr int ACT_ROWS = NASG + E * 256;
constexpr size_t al(size_t x) { return (x + 255) & ~(size_t)255; }
constexpr size_t OFF_CTRL = 0;
constexpr size_t OFF_MOD = 65536;
constexpr size_t OFF_LOGF = OFF_MOD + al((size_t)B * NMOD * 4);
constexpr size_t OFF_FCUM = OFF_LOGF + al((size_t)B * H * S * 4);
constexpr size_t OFF_HA = OFF_FCUM + al((size_t)B * H * S * 4);
constexpr size_t OFF_PROJ = OFF_HA + al((size_t)NTOK * D * 2);
constexpr size_t OFF_UA = OFF_PROJ + al((size_t)NTOK * PLD * 2);
constexpr size_t OFF_MRG = OFF_UA + al((size_t)NTOK * 2048 * 2);
constexpr size_t OFF_X1 = OFF_MRG + al((size_t)NTOK * D * 2);
constexpr size_t OFF_TMP = OFF_X1 + al((size_t)NTOK * D * 4);
constexpr size_t OFF_GATE = OFF_TMP + al((size_t)NTOK * D * 4);
constexpr size_t OFF_LIST = OFF_GATE + al((size_t)NASG * 4);
constexpr size_t OFF_ACT = OFF_LIST + al((size_t)E * NTOK * 4);
constexpr size_t OFF_Y = OFF_ACT + al((size_t)ACT_ROWS * D * 2);
constexpr size_t WS_END = OFF_Y + al((size_t)NASG * D * 2);
}
using namespace cfg;

__device__ __forceinline__ float bf2f(bf16_t v) { return __uint_as_float(((unsigned)v) << 16); }
__device__ __forceinline__ bf16_t f2bf(float f) { unsigned u = __float_as_uint(f); u += 0x7fffu + ((u >> 16) & 1u); return (bf16_t)(u >> 16); }
__device__ __forceinline__ float sigmoidf_(float x) { return __builtin_amdgcn_rcpf(1.0f + __builtin_amdgcn_exp2f(x * -1.4426950408889634f)); }

struct Ptrs {
    const float *x, *c, *ada_w, *ada_b, *norm_mix_g, *w_in, *b_forget, *conv_w, *w_conv_out, *w_attn_out, *w_out, *norm_ffn_g,
        *router_w, *router_b, *w_gate, *b_gate, *w_up, *b_up, *w_down, *b_down, *final_g;
    float* out; unsigned char* ws;
};

#define LAS __attribute__((address_space(3)))
typedef short bf16x8 __attribute__((ext_vector_type(8)));
typedef float f32x2_t __attribute__((ext_vector_type(2)));
typedef __bf16 bf16x2_t __attribute__((ext_vector_type(2)));
__device__ __forceinline__ unsigned cvtpk(float lo, float hi) { f32x2_t v = {lo, hi}; bf16x2_t b = __builtin_convertvector(v, bf16x2_t); return __builtin_bit_cast(unsigned, b); }
__device__ __forceinline__ float bflo(unsigned w) { return __uint_as_float(w << 16); }
__device__ __forceinline__ float bfhi(unsigned w) { return __uint_as_float(w & 0xffff0000u); }
__device__ __forceinline__ int tid_opaque() { int t = threadIdx.x; asm volatile("" : "+v"(t)); return t; }
constexpr int GEMM_LDS = 131072;

struct GemmT {
    int wr, wc, fr, fq;
    int aR, aC;
    unsigned a_w;
    int b_k, b_col, b_p, b_gucol;
    unsigned b_w, b_rot;
    unsigned a_r, b_r;
    __device__ __forceinline__ void init_epi() { const int tid = tid_opaque(), wid = tid >> 6, lane = tid & 63; wr = wid >> 2; wc = wid & 3; fr = lane & 15; fq = lane >> 4; }
    __device__ __forceinline__ void init() {
        const int tid = tid_opaque(), wid = tid >> 6, lane = tid & 63;
        wr = wid >> 2; wc = wid & 3; fr = lane & 15; fq = lane >> 4;
        aR = (wid >> 1) * 16 + (lane >> 2); aC = (wid & 1) * 32 + (((lane & 3) ^ ((lane >> 5) << 1)) * 8);
        a_w = (unsigned)(wid * 1024 + lane * 16);
        { const int l32 = lane & 31, kc8 = 2 * (wid >> 1) + (lane >> 5), wc_ = l32 >> 3, bfq = (l32 >> 1) & 3, nlo = l32 & 1; b_p = wid & 1;
          b_k = kc8 * 8; b_col = wc_ * 64 + b_p * 32 + bfq * 8 + nlo * 4; b_gucol = wc_ * 32 + bfq * 8 + nlo * 4;
          const int sub = wc_ * 4 + 2 * b_p + nlo;
          b_w = (unsigned)((sub * 2 + (kc8 >> 2)) * 1024 + (((4 * bfq) * 64 + (kc8 & 3) * 16) ^ ((bfq >> 1) << 5))); b_rot = (unsigned)(nlo * 64); }
        const unsigned lo = (unsigned)((fr * 64 + fq * 16) ^ ((fr >> 3) << 5));
        a_r = (unsigned)(wr * 16384) + lo; b_r = 32768u + (unsigned)(wc * 8192) + lo;
    }
};

__device__ __forceinline__ void gemm_kloop(f32x4 (&acc)[8][4], LAS unsigned char* lds, const GemmT& T,
                                           __amdgpu_buffer_rsrc_t ra, unsigned ao0, unsigned ao1, unsigned ao2, unsigned ao3,
                                           __amdgpu_buffer_rsrc_t rb, unsigned bo, unsigned ldbB, int nt) {
    f32x4 sb[8];
    const unsigned a_wu = (unsigned)__builtin_amdgcn_readfirstlane((int)(T.a_w & ~1023u));
#define G_DMA_A(buf, t, i_) __builtin_amdgcn_raw_ptr_buffer_load_lds(ra, (LAS void*)(lds + (buf) * 65536 + a_wu + (i_) * 8192), 16, ao##i_, (unsigned)(t) * 128u, 0, 0)
#define G_ISSUE_B(t) do { const unsigned so_ = (unsigned)(t) * 64u * ldbB; _Pragma("unroll") for (int i_ = 0; i_ < 8; ++i_) sb[i_] = __builtin_bit_cast(f32x4, __builtin_amdgcn_raw_buffer_load_b128(rb, bo, so_ + (unsigned)i_ * ldbB, 0)); } while (0)
#define G_RETIRE() asm volatile("s_waitcnt vmcnt(0)" : "+v"(sb[0]), "+v"(sb[1]), "+v"(sb[2]), "+v"(sb[3]), "+v"(sb[4]), "+v"(sb[5]), "+v"(sb[6]), "+v"(sb[7]) :: "memory")
#define G_WRITE_B(buf) do { LAS unsigned char* d_ = lds + (buf) * 65536; \
        _Pragma("unroll") for (int j_ = 0; j_ < 4; ++j_) { u32x4 w_; w_.x = cvtpk(sb[0][j_], sb[1][j_]); w_.y = cvtpk(sb[2][j_], sb[3][j_]); w_.z = cvtpk(sb[4][j_], sb[5][j_]); w_.w = cvtpk(sb[6][j_], sb[7][j_]); \
            *(LAS u32x4*)(d_ + 32768 + T.b_w + ((T.b_rot + 64u * j_) & 255u)) = w_; } } while (0)
#define G_LDB(dst, buf, ks) do { const LAS unsigned char* s_ = lds + (buf) * 65536 + (ks) * 1024; _Pragma("unroll") for (int n_ = 0; n_ < 4; ++n_) dst[n_] = *(const LAS bf16x8*)(s_ + T.b_r + n_ * 2048); } while (0)
#define G_LDA(dst, buf, ks, h_) do { const LAS unsigned char* s_ = lds + (buf) * 65536 + (ks) * 1024; _Pragma("unroll") for (int m_ = 0; m_ < 4; ++m_) dst[m_] = *(const LAS bf16x8*)(s_ + T.a_r + ((h_) * 4 + m_) * 2048); } while (0)
#define G_MMA(At_, Bf_, h_) do { _Pragma("unroll") for (int m_ = 0; m_ < 4; ++m_) _Pragma("unroll") for (int n_ = 0; n_ < 4; ++n_) \
        acc[(h_) * 4 + m_][n_] = __builtin_amdgcn_mfma_f32_16x16x32_bf16(Bf_[n_], At_[m_], acc[(h_) * 4 + m_][n_], 0, 0, 0); } while (0)
#define G_SB() __builtin_amdgcn_sched_barrier(0)
#define G_BAR() do { asm volatile("s_waitcnt lgkmcnt(0)" ::: "memory"); __builtin_amdgcn_s_barrier(); asm volatile("" ::: "memory"); } while (0)
    bf16x8 Bf0[4], Bf1[4], AtA[4], AtB[4];
    G_ISSUE_B(0); G_DMA_A(0, 0, 0); G_DMA_A(0, 0, 1); G_DMA_A(0, 0, 2); G_DMA_A(0, 0, 3); G_RETIRE(); G_WRITE_B(0);
    if (nt > 1) G_ISSUE_B(1);
    G_BAR();
    for (int t = 0; t < nt; ++t) { const int cur = t & 1; const bool w1 = t + 1 < nt, i2 = t + 2 < nt;
        G_LDB(Bf0, cur, 0); G_LDA(AtA, cur, 0, 0); G_SB();
        G_LDA(AtB, cur, 0, 1); if (w1) { G_DMA_A(cur ^ 1, t + 1, 0); G_DMA_A(cur ^ 1, t + 1, 1); G_DMA_A(cur ^ 1, t + 1, 2); G_DMA_A(cur ^ 1, t + 1, 3); } G_MMA(AtA, Bf0, 0); G_SB();
        G_LDB(Bf1, cur, 1); G_LDA(AtA, cur, 1, 0); G_MMA(AtB, Bf0, 1); G_SB();
        G_LDA(AtB, cur, 1, 1); if (w1) { G_RETIRE(); G_WRITE_B(cur ^ 1); } if (i2) G_ISSUE_B(t + 2); G_MMA(AtA, Bf1, 0); G_SB();
        G_MMA(AtB, Bf1, 1); G_SB();
        G_BAR(); }
#undef G_LDA
#undef G_MMA
#undef G_SB
#undef G_DMA_A
#undef G_ISSUE_B
#undef G_WRITE_B
#undef G_RETIRE
#undef G_LDB
}
__device__ __forceinline__ void gemm_kloop_light(f32x4 (&acc)[8][4], LAS unsigned char* lds, const GemmT& T,
                                                 __amdgpu_buffer_rsrc_t ra, unsigned ao0, unsigned ao1, unsigned ao2, unsigned ao3,
                                                 __amdgpu_buffer_rsrc_t rb, unsigned bo, unsigned ldbB, int nt, int mlim) {
    f32x4 sb[8];
    const unsigned a_wu = (unsigned)__builtin_amdgcn_readfirstlane((int)(T.a_w & ~1023u));
#define G_DMA_A(buf, t, i_) __builtin_amdgcn_raw_ptr_buffer_load_lds(ra, (LAS void*)(lds + (buf) * 65536 + a_wu + (i_) * 8192), 16, ao##i_, (unsigned)(t) * 128u, 0, 0)
#define G_ISSUE_B(t) do { const unsigned so_ = (unsigned)(t) * 64u * ldbB; _Pragma("unroll") for (int i_ = 0; i_ < 8; ++i_) sb[i_] = __builtin_bit_cast(f32x4, __builtin_amdgcn_raw_buffer_load_b128(rb, bo, so_ + (unsigned)i_ * ldbB, 0)); } while (0)
#define G_RETIRE() asm volatile("s_waitcnt vmcnt(0)" : "+v"(sb[0]), "+v"(sb[1]), "+v"(sb[2]), "+v"(sb[3]), "+v"(sb[4]), "+v"(sb[5]), "+v"(sb[6]), "+v"(sb[7]) :: "memory")
#define G_WRITE_B(buf) do { LAS unsigned char* d_ = lds + (buf) * 65536; \
        _Pragma("unroll") for (int j_ = 0; j_ < 4; ++j_) { u32x4 w_; w_.x = cvtpk(sb[0][j_], sb[1][j_]); w_.y = cvtpk(sb[2][j_], sb[3][j_]); w_.z = cvtpk(sb[4][j_], sb[5][j_]); w_.w = cvtpk(sb[6][j_], sb[7][j_]); \
            *(LAS u32x4*)(d_ + 32768 + T.b_w + ((T.b_rot + 64u * j_) & 255u)) = w_; } } while (0)
    G_ISSUE_B(0); G_DMA_A(0, 0, 0); G_DMA_A(0, 0, 1); G_DMA_A(0, 0, 2); G_DMA_A(0, 0, 3); G_RETIRE(); G_WRITE_B(0);
    if (nt > 1) G_ISSUE_B(1);
    G_BAR();
    for (int t = 0; t < nt; ++t) { const int cur = t & 1; const bool w1 = t + 1 < nt, i2 = t + 2 < nt;
        if (w1) { G_DMA_A(cur ^ 1, t + 1, 0); G_DMA_A(cur ^ 1, t + 1, 1); G_DMA_A(cur ^ 1, t + 1, 2); G_DMA_A(cur ^ 1, t + 1, 3); }
        if (mlim > 0) {
#pragma unroll
            for (int ks = 0; ks < 2; ++ks) { const LAS unsigned char* s_ = lds + cur * 65536 + ks * 1024; bf16x8 Bf_[4];
#pragma unroll
                for (int n_ = 0; n_ < 4; ++n_) Bf_[n_] = *(const LAS bf16x8*)(s_ + T.b_r + n_ * 2048);
#pragma unroll
                for (int m_ = 0; m_ < 8; ++m_) if (m_ < mlim) { const bf16x8 At_ = *(const LAS bf16x8*)(s_ + T.a_r + m_ * 2048);
#pragma unroll
                    for (int n_ = 0; n_ < 4; ++n_) acc[m_][n_] = __builtin_amdgcn_mfma_f32_16x16x32_bf16(Bf_[n_], At_, acc[m_][n_], 0, 0, 0); } } }
        if (w1) { G_RETIRE(); G_WRITE_B(cur ^ 1); }
        if (i2) G_ISSUE_B(t + 2);
        G_BAR(); }
#undef G_DMA_A
#undef G_ISSUE_B
#undef G_RETIRE
#undef G_WRITE_B
}
__device__ __forceinline__ __amdgpu_buffer_rsrc_t mk_rsrc(const void* p) { return __builtin_amdgcn_make_buffer_rsrc((void*)p, 0, 0x7ffffff0, 0x00020000); }
__device__ __forceinline__ void acc_zero(f32x4 (&acc)[8][4]) {
#pragma unroll
    for (int m = 0; m < 8; ++m)
#pragma unroll
        for (int n = 0; n < 4; ++n) acc[m][n] = (f32x4){0.f, 0.f, 0.f, 0.f};
}
__device__ __forceinline__ f32x4 rot1(const f32x4 a) { return (f32x4){a[1], a[2], a[3], a[0]}; }
__device__ __forceinline__ f32x4 rotinv(const f32x4 a) { return (f32x4){a[3], a[0], a[1], a[2]}; }
__device__ __forceinline__ u32x4 pack8(const f32x4 a, const f32x4 b) { u32x4 w; w.x = cvtpk(a[0], a[1]); w.y = cvtpk(a[2], a[3]); w.z = cvtpk(b[0], b[1]); w.w = cvtpk(b[2], b[3]); return w; }
__device__ __forceinline__ int vwg_id() { const int G = gridDim.x; return (G % 8 == 0) ? (int)((blockIdx.x % 8) * (G / 8) + blockIdx.x / 8) : (int)blockIdx.x; }

__device__ __forceinline__ void phase_gemm1(const Ptrs& p, LAS unsigned char* lds) {
    const bf16_t* ha = (const bf16_t*)(p.ws + OFF_HA); bf16_t* pr = (bf16_t*)(p.ws + OFF_PROJ);
    for (int u = vwg_id(); u < 32 * 40; u += gridDim.x) {
        GemmT T; T.init();
        const int pm = (u >> 3) & 31, pn = (u & 7) + 8 * (u >> 8);
        const int row0 = pm * 256, pcol0 = pn * 256, wcol0 = pcol0 < C_GC ? pcol0 : pcol0 + (W_GC - C_GC);
        const unsigned ao = (unsigned)((T.aR * D + T.aC) * 2), bo = (unsigned)((T.b_k * NIN + T.b_col) * 4);
        f32x4 acc[8][4]; acc_zero(acc);
        gemm_kloop(acc, lds, T, mk_rsrc(ha + (size_t)row0 * D), ao, ao + 64u * D * 2, ao + 128u * D * 2, ao + 192u * D * 2, mk_rsrc(p.w_in + wcol0), bo, NIN * 4u, D / 64);
T.init_epi();
        const int mode = (pcol0 >= C_GC) ? 2 : ((pcol0 >= C_Q && pcol0 < C_K) ? 1 : 0);
#pragma unroll
        for (int m = 0; m < 8; ++m) { const int row = row0 + T.wr * 128 + m * 16 + T.fr;
#pragma unroll
            for (int pp = 0; pp < 2; ++pp) { f32x4 v0 = acc[m][2 * pp], v1 = rot1(acc[m][2 * pp + 1]);
                if (mode == 1) { v0 *= QSCALE; v1 *= QSCALE; }
                else if (mode == 2) {
#pragma unroll
                    for (int j = 0; j < 4; ++j) { v0[j] = sigmoidf_(v0[j]); v1[j] = sigmoidf_(v1[j]); } }
                *(u32x4*)(pr + (size_t)row * PLD + pcol0 + T.wc * 64 + pp * 32 + T.fq * 8) = pack8(v0, v1); } }
    }
}
__device__ __forceinline__ void phase_merge(const Ptrs& p, LAS unsigned char* lds) {
    const bf16_t* ua = (const bf16_t*)(p.ws + OFF_UA); const bf16_t* pr = (const bf16_t*)(p.ws + OFF_PROJ); bf16_t* mg = (bf16_t*)(p.ws + OFF_MRG);
    for (int u = vwg_id(); u < 32 * 8; u += gridDim.x) {
        GemmT T; T.init();
        const int pm = u >> 3, pn = u & 7, row0 = pm * 256, col0 = pn * 256;
        const unsigned ao = (unsigned)((T.aR * 2048 + T.aC) * 2), bo = (unsigned)((T.b_k * D + T.b_col) * 4);
        f32x4 acc[8][4]; acc_zero(acc);
#pragma unroll 1
        for (int seg = 0; seg < 2; ++seg) {
            gemm_kloop(acc, lds, T, mk_rsrc(ua + (size_t)row0 * 2048 + seg * 1024), ao, ao + 64u * 4096, ao + 128u * 4096, ao + 192u * 4096,
                       mk_rsrc((seg ? p.w_attn_out : p.w_conv_out) + col0), bo, D * 4u, 1024 / 64);
            T.init_epi();
            int rowb = row0 + T.wr * 128 + T.fr; asm volatile("" : "+v"(rowb));
#pragma unroll
            for (int m = 0; m < 8; ++m) { const int row = rowb + m * 16;
#pragma unroll
                for (int pp = 0; pp < 2; ++pp) { const int c = col0 + T.wc * 64 + pp * 32 + T.fq * 8; const size_t o = (size_t)row * PLD + c;
                    const u32x4 sa = *(const u32x4*)(pr + o + C_GA); u32x4 sc = sa; if (seg == 0) sc = *(const u32x4*)(pr + o + C_GC);
                    f32x4 v0 = acc[m][2 * pp], v1 = rot1(acc[m][2 * pp + 1]);
#pragma unroll
                    for (int j = 0; j < 2; ++j) {
                        const float a0 = bflo(sa[j]), a1 = bfhi(sa[j]), a2 = bflo(sa[2 + j]), a3 = bfhi(sa[2 + j]);
                        if (seg == 0) { v0[2 * j] *= bflo(sc[j]) * __builtin_amdgcn_rcpf(a0); v0[2 * j + 1] *= bfhi(sc[j]) * __builtin_amdgcn_rcpf(a1); v1[2 * j] *= bflo(sc[2 + j]) * __builtin_amdgcn_rcpf(a2); v1[2 * j + 1] *= bfhi(sc[2 + j]) * __builtin_amdgcn_rcpf(a3); }
                        else { v0[2 * j] *= a0; v0[2 * j + 1] *= a1; v1[2 * j] *= a2; v1[2 * j + 1] *= a3; } }
                    acc[m][2 * pp] = v0; acc[m][2 * pp + 1] = rotinv(v1);
                    if (seg == 1) *(u32x4*)(mg + (size_t)row * D + c) = pack8(v0, v1); }
                asm volatile("" ::: "memory"); }
        }
    }
}
__device__ __forceinline__ void phase_out(const Ptrs& p, LAS unsigned char* lds) {
    const bf16_t* mg = (const bf16_t*)(p.ws + OFF_MRG); float* x1 = (float*)(p.ws + OFF_X1); const float* mod = (const float*)(p.ws + OFF_MOD);
    for (int u = vwg_id(); u < 32 * 8; u += gridDim.x) {
        GemmT T; T.init();
        const int pm = u >> 3, pn = u & 7, row0 = pm * 256, col0 = pn * 256;
        const unsigned ao = (unsigned)((T.aR * D + T.aC) * 2), bo = (unsigned)((T.b_k * D + T.b_col) * 4);
        f32x4 acc[8][4]; acc_zero(acc);
        gemm_kloop(acc, lds, T, mk_rsrc(mg + (size_t)row0 * D), ao, ao + 64u * 4096, ao + 128u * 4096, ao + 192u * 4096, mk_rsrc(p.w_out + col0), bo, D * 4u, D / 64);
T.init_epi();
        const float* gm = mod + (size_t)(row0 / S) * NMOD + 2 * D;
#pragma unroll
        for (int m = 0; m < 8; ++m) { const int row = row0 + T.wr * 128 + m * 16 + T.fr;
#pragma unroll
            for (int pp = 0; pp < 2; ++pp) { const int c = col0 + T.wc * 64 + pp * 32 + T.fq * 8; const size_t o = (size_t)row * D + c;
                const f32x4 g0 = *(const f32x4*)(gm + c), g1 = *(const f32x4*)(gm + c + 4), x0 = *(const f32x4*)(p.x + o), x1v = *(const f32x4*)(p.x + o + 4);
                *(f32x4*)(x1 + o) = x0 + g0 * acc[m][2 * pp]; *(f32x4*)(x1 + o + 4) = x1v + g1 * rot1(acc[m][2 * pp + 1]); } }
    }
}
constexpr size_t OFF_GUTOT = OFF_CTRL + 1024;
constexpr size_t OFF_GUDONE = OFF_CTRL + 2048;
struct MoeUnit { int e, mt, nt, cnt, base, light; };
__device__ __forceinline__ bool moe_unit(int cv, int u, int ntiles_n, MoeUnit& mu) {
    int base = 0;
#pragma unroll
    for (int e = 0; e < E; ++e) { const int c = __builtin_amdgcn_readlane(cv, e), tm = (c + 255) >> 8, nu = tm * ntiles_n;
        if (u < nu) { mu.e = e; mu.cnt = c; mu.base = base; mu.nt = u / tm; mu.mt = u - mu.nt * tm; mu.light = (mu.mt == tm - 1 && c - mu.mt * 256 <= 128) ? 1 : 0; return true; }
        u -= nu; base += tm * 256; }
    return false;
}
__device__ __forceinline__ void phase_moe_gu(const Ptrs& p, LAS unsigned char* lds) {
    const int* counts = (const int*)(p.ws + OFF_CTRL); const bf16_t* h2 = (const bf16_t*)(p.ws + OFF_HA); bf16_t* act = (bf16_t*)(p.ws + OFF_ACT);
    const __amdgpu_buffer_rsrc_t ract = __builtin_amdgcn_make_buffer_rsrc((void*)act, 0, 0x7ffffff0, 0x00020000);
    MoeUnit mu; const int cv = counts[tid_opaque() & 31];
    for (int u = vwg_id(); moe_unit(cv, u, 16, mu); u += gridDim.x) {
        GemmT T; T.init();
        const int* list = (const int*)(p.ws + OFF_LIST) + (size_t)mu.e * NTOK; const int i0 = mu.mt * 256, n0 = mu.nt * 128;
        unsigned ao[4];
#pragma unroll
        for (int i = 0; i < 4; ++i) { const int r = i0 + T.aR + 64 * i; const int tok = (r < mu.cnt) ? (list[r] >> 2) : 0; ao[i] = (unsigned)((tok * D + T.aC) * 2); }
        const float* wsel = ((__builtin_amdgcn_readfirstlane(T.b_p) & 1) ? p.w_up : p.w_gate) + (size_t)mu.e * D * D + n0;
        const unsigned bo = (unsigned)((T.b_k * D + T.b_gucol) * 4);
        f32x4 acc[8][4]; acc_zero(acc);
        const int mlim = __builtin_amdgcn_readfirstlane(T.wr) ? 0 : ((mu.cnt - i0 + 15) >> 4);
        if (mu.light) gemm_kloop_light(acc, lds, T, mk_rsrc(h2), ao[0], ao[1], ao[2], ao[3], mk_rsrc(wsel), bo, D * 4u, D / 64, mlim);
        else gemm_kloop(acc, lds, T, mk_rsrc(h2), ao[0], ao[1], ao[2], ao[3], mk_rsrc(wsel), bo, D * 4u, D / 64);
T.init_epi();
        const int c = n0 + T.wc * 32 + T.fq * 8;
        const float* bg = p.b_gate + (size_t)mu.e * D + c; const float* bu = p.b_up + (size_t)mu.e * D + c;
        const f32x4 bg0 = *(const f32x4*)bg, bg1 = *(const f32x4*)(bg + 4), bu0 = *(const f32x4*)bu, bu1 = *(const f32x4*)(bu + 4);
#pragma unroll
        for (int m = 0; m < 8; ++m) { const int r = i0 + T.wr * 128 + m * 16 + T.fr;
            f32x4 g0 = acc[m][0] + bg0, g1 = rot1(acc[m][1]) + bg1, u0 = acc[m][2] + bu0, u1 = rot1(acc[m][3]) + bu1;
#pragma unroll
            for (int j = 0; j < 4; ++j) { float g = fminf(g0[j], 7.0f), uu = fminf(fmaxf(u0[j], -7.0f), 7.0f); g0[j] = (uu + 1.0f) * g * sigmoidf_(1.702f * g);
                g = fminf(g1[j], 7.0f); uu = fminf(fmaxf(u1[j], -7.0f), 7.0f); g1[j] = (uu + 1.0f) * g * sigmoidf_(1.702f * g); }
            if (r < mu.cnt) __builtin_amdgcn_raw_buffer_store_b128(pack8(g0, g1), ract, (unsigned)(((mu.base + r) * D + c) * 2), 0, 16); }
        asm volatile("s_waitcnt vmcnt(0)" ::: "memory");
        __syncthreads();
        if (threadIdx.x == 0) { __hip_atomic_fetch_add((unsigned*)(p.ws + OFF_GUDONE) + mu.e * 16, 1u, __ATOMIC_RELAXED, __HIP_MEMORY_SCOPE_AGENT);
                                __hip_atomic_fetch_add((unsigned*)(p.ws + OFF_GUTOT), 1u, __ATOMIC_RELAXED, __HIP_MEMORY_SCOPE_AGENT); }
    }
}
__device__ __forceinline__ void phase_moe_down(const Ptrs& p, LAS unsigned char* lds) {
    const int* counts = (const int*)(p.ws + OFF_CTRL); const bf16_t* act = (const bf16_t*)(p.ws + OFF_ACT); bf16_t* y = (bf16_t*)(p.ws + OFF_Y); const float* gate = (const float*)(p.ws + OFF_GATE);
    MoeUnit mu; const int cv = counts[tid_opaque() & 31];
    int Ttot = 0;
#pragma unroll
    for (int e = 0; e < E; ++e) Ttot += (__builtin_amdgcn_readlane(cv, e) + 255) >> 8;
    const int G = (int)gridDim.x, Ugu = Ttot * 16, u0 = ((vwg_id() - Ugu % G) % G + G) % G;
    LAS int* wslot = (LAS int*)(lds + GEMM_LDS + 4096);
    int all_done = 0;
    for (int u = u0; moe_unit(cv, u, 8, mu); u += G) {
        if (!all_done) {
            if (threadIdx.x == 0) {
                unsigned* tot = (unsigned*)(p.ws + OFF_GUTOT); unsigned* de = (unsigned*)(p.ws + OFF_GUDONE) + mu.e * 16;
                const unsigned need = (unsigned)(((mu.cnt + 255) >> 8) * 16); int all = 0;
                for (unsigned sp = 0; sp < (1u << 22); ++sp) {
                    if (__hip_atomic_load(tot, __ATOMIC_RELAXED, __HIP_MEMORY_SCOPE_AGENT) >= (unsigned)Ugu) { all = 1; break; }
                    if (__hip_atomic_load(de, __ATOMIC_RELAXED, __HIP_MEMORY_SCOPE_AGENT) >= need) break;
                    __builtin_amdgcn_s_sleep(8); }
                __builtin_amdgcn_fence(__ATOMIC_ACQUIRE, "agent");
                *wslot = all; }
            asm volatile("s_waitcnt vmcnt(0)" ::: "memory");
            __syncthreads();
            all_done = __builtin_amdgcn_readfirstlane(*wslot);
            __syncthreads(); }
        GemmT T; T.init();
        const int* list = (const int*)(p.ws + OFF_LIST) + (size_t)mu.e * NTOK; const int i0 = mu.mt * 256, col0 = mu.nt * 256;
        const unsigned ao = (unsigned)((T.aR * D + T.aC) * 2), bo = (unsigned)((T.b_k * D + T.b_col) * 4);
        int pa = -1; float pg = 0.f;
        { const int t_ = tid_opaque(); if (t_ < 256 && i0 + t_ < mu.cnt) { pa = list[i0 + t_]; pg = gate[pa]; } }
        f32x4 acc[8][4]; acc_zero(acc);
        const int mlim = __builtin_amdgcn_readfirstlane(T.wr) ? 0 : ((mu.cnt - i0 + 15) >> 4);
        if (mu.light) gemm_kloop_light(acc, lds, T, mk_rsrc(act + (size_t)(mu.base + i0) * D), ao, ao + 64u * 4096, ao + 128u * 4096, ao + 192u * 4096,
                                       mk_rsrc(p.w_down + (size_t)mu.e * D * D + col0), bo, D * 4u, D / 64, mlim);
        else gemm_kloop(acc, lds, T, mk_rsrc(act + (size_t)(mu.base + i0) * D), ao, ao + 64u * 4096, ao + 128u * 4096, ao + 192u * 4096,
                        mk_rsrc(p.w_down + (size_t)mu.e * D * D + col0), bo, D * 4u, D / 64);
T.init_epi();
        LAS int* tab = (LAS int*)(lds + GEMM_LDS);
        { const int t_ = tid_opaque(); if (t_ < 256) { tab[2 * t_] = pa; tab[2 * t_ + 1] = __float_as_int(pg); } }
        __syncthreads();
        const float* bd = p.b_down + (size_t)mu.e * D;
#pragma unroll
        for (int m = 0; m < 8; ++m) { const int rl = T.wr * 128 + m * 16 + T.fr, r = i0 + rl;
            if (r < mu.cnt) { const int a = tab[2 * rl]; const float gt = __int_as_float(tab[2 * rl + 1]);
#pragma unroll
                for (int pp = 0; pp < 2; ++pp) { const int c = col0 + T.wc * 64 + pp * 32 + T.fq * 8;
                    const f32x4 v0 = (acc[m][2 * pp] + *(const f32x4*)(bd + c)) * gt, v1 = (rot1(acc[m][2 * pp + 1]) + *(const f32x4*)(bd + c + 4)) * gt;
                    *(u32x4*)(y + (size_t)a * D + c) = pack8(v0, v1); } } }
        __syncthreads();
    }
}
extern __shared__ __attribute__((aligned(1024))) unsigned char dyn_lds[];
typedef float f32x16 __attribute__((ext_vector_type(16)));
typedef short v4i16_t __attribute__((ext_vector_type(4)));
__device__ __forceinline__ float xhalf_max(float v) { const auto rr = __builtin_amdgcn_permlane32_swap(__float_as_uint(v), __float_as_uint(v), false, false); return fmaxf(__uint_as_float(rr[0]), __uint_as_float(rr[1])); }
__device__ __forceinline__ float xhalf_sum(float v) { const auto rr = __builtin_amdgcn_permlane32_swap(__float_as_uint(v), __float_as_uint(v), false, false); return __uint_as_float(rr[0]) + __uint_as_float(rr[1]); }
template <int CTRL> __device__ __forceinline__ float dppf(float x) { return __builtin_bit_cast(float, __builtin_amdgcn_mov_dpp(__builtin_bit_cast(int, x), CTRL, 0xf, 0xf, true)); }
constexpr int DPP_XOR1 = 0xB1, DPP_XOR2 = 0x4E, DPP_XOR7 = 0x141, DPP_XOR8 = 0x128;
__device__ __forceinline__ float xrow_sum(float x) { const auto s = __builtin_amdgcn_permlane16_swap(__float_as_uint(x), __float_as_uint(x), false, false); x = __uint_as_float(s[0]) + __uint_as_float(s[1]); return xhalf_sum(x); }
__device__ __forceinline__ float xrow_max(float x) { const auto s = __builtin_amdgcn_permlane16_swap(__float_as_uint(x), __float_as_uint(x), false, false); x = fmaxf(__uint_as_float(s[0]), __uint_as_float(s[1])); return xhalf_max(x); }
__device__ __forceinline__ float wave_sum(float v) { v += dppf<DPP_XOR1>(v); v += dppf<DPP_XOR2>(v); v += dppf<DPP_XOR7>(v); v += dppf<DPP_XOR8>(v); return xrow_sum(v); }
__device__ __forceinline__ float wave_max(float v) { v = fmaxf(v, dppf<DPP_XOR1>(v)); v = fmaxf(v, dppf<DPP_XOR2>(v)); v = fmaxf(v, dppf<DPP_XOR7>(v)); v = fmaxf(v, dppf<DPP_XOR8>(v)); return xrow_max(v); }
__device__ __forceinline__ float reduce16(float (&v)[16], int lane) {
    float a[8], b[4], c[2];
#pragma unroll
    for (int i = 0; i < 8; ++i) { const auto r = __builtin_amdgcn_permlane32_swap(__float_as_uint(v[i]), __float_as_uint(v[i + 8]), false, false); a[i] = __uint_as_float(r[0]) + __uint_as_float(r[1]); }
#pragma unroll
    for (int i = 0; i < 4; ++i) { const auto r = __builtin_amdgcn_permlane16_swap(__float_as_uint(a[i]), __float_as_uint(a[i + 4]), false, false); b[i] = __uint_as_float(r[0]) + __uint_as_float(r[1]); }
#pragma unroll
    for (int i = 0; i < 2; ++i) { const float t1 = b[i] + dppf<DPP_XOR8>(b[i]), t2 = b[i + 2] + dppf<DPP_XOR8>(b[i + 2]); c[i] = (lane & 8) ? t2 : t1; }
    float d; { const float t1 = c[0] + dppf<DPP_XOR7>(c[0]), t2 = c[1] + dppf<DPP_XOR7>(c[1]); d = (lane & 4) ? t2 : t1; }
    d += dppf<DPP_XOR1>(d); d += dppf<DPP_XOR2>(d);
    return d;
}
constexpr int WT_LDS = 16 * 2048 * 4;
constexpr int AUX_LDS = 160 * 1024 - 64;

__device__ __forceinline__ void phase_mod(const Ptrs& p, LAS unsigned char* lds) {
    LAS float* sc = (LAS float*)lds;
    LAS float* red = (LAS float*)(lds + 16384);
    const int tid = tid_opaque();
    for (int i = tid; i < B * D; i += 512) { const float v = p.c[i]; sc[i] = v / (1.0f + __expf(-v)); }
    __syncthreads();
    float* mod = (float*)(p.ws + OFF_MOD);
    for (int ch = vwg_id(); ch < NMOD / 48; ch += gridDim.x) {
        const int cq = tid % 12, kg = tid / 12;
        if (kg < 42) {
            f32x4 a0 = {0.f, 0.f, 0.f, 0.f}, a1 = {0.f, 0.f, 0.f, 0.f};
            const float* wp = p.ada_w + (size_t)ch * 48 + cq * 4;
#pragma unroll 7
            for (int k = kg; k < D; k += 42) { const f32x4 w = *(const f32x4*)(wp + (size_t)k * NMOD); a0 += w * sc[k]; a1 += w * sc[D + k]; }
#pragma unroll
            for (int j = 0; j < 4; ++j) { red[kg * 96 + cq * 4 + j] = a0[j]; red[kg * 96 + 48 + cq * 4 + j] = a1[j]; }
        }
        __syncthreads();
        if (tid < 96) { float s = 0.f; for (int g = 0; g < 42; ++g) s += red[g * 96 + tid]; const int b = tid / 48, c = ch * 48 + tid % 48; mod[(size_t)b * NMOD + c] = s + p.ada_b[c]; }
        __syncthreads();
    }
}
__device__ __forceinline__ void stage_wt16(LAS float* wt, const float* w, size_t ldw) {
    const int tid = tid_opaque();
    for (int i = tid; i < 2048 * 4; i += 512) { const int k = i >> 2, q = i & 3; const f32x4 v = *(const f32x4*)(w + (size_t)k * ldw + q * 4);
#pragma unroll
        for (int j = 0; j < 4; ++j) wt[(q * 4 + j) * 2048 + k] = v[j]; }
}
constexpr int N1_PITCH = 2048 * 2 + 16;
constexpr int N1_WT = 0, N1_HS = 16 * N1_PITCH, N1_GS = 2 * 16 * N1_PITCH, N1_PS = N1_GS + 16384, N1_END = N1_PS + 8 * 256 * 4;
__device__ __forceinline__ void phase_norm1(const Ptrs& p, LAS unsigned char* lds) {
    LAS float* gs = (LAS float*)(lds + N1_GS); LAS float* sh = gs + 2048; LAS float* ps = (LAS float*)(lds + N1_PS);
    const int tid = tid_opaque(), lane = tid & 63, wid = tid >> 6;
    for (int i = tid; i < 1024 * 4; i += 512) { const int kp = i >> 2, q = i & 3; const float* w = p.w_in + (size_t)(2 * kp) * NIN + W_F + q * 4;
        const f32x4 v0 = *(const f32x4*)w, v1 = *(const f32x4*)(w + NIN);
#pragma unroll
        for (int j = 0; j < 4; ++j) *(LAS unsigned*)(lds + N1_WT + (q * 4 + j) * N1_PITCH + kp * 4) = cvtpk(v0[j], v1[j]); }
    bf16_t* ha = (bf16_t*)(p.ws + OFF_HA); float* logf = (float*)(p.ws + OFF_LOGF);
    for (int blk = vwg_id(); blk < NTOK / 32; blk += gridDim.x) {
        const int b = (blk * 32) / S; const float* mod = (const float*)(p.ws + OFF_MOD) + (size_t)b * NMOD;
        __syncthreads();
        for (int i = tid; i < 2048; i += 512) { gs[i] = p.norm_mix_g[i] * (1.0f + mod[D + i]); sh[i] = mod[i]; }
        __syncthreads();
#pragma unroll 1
        for (int half = 0; half < 2; ++half) {
            {
                const int rowa = blk * 32 + half * 16 + wid * 2; const float* xr = p.x + (size_t)rowa * D;
                f32x4 v[2][8];
#pragma unroll
                for (int rr = 0; rr < 2; ++rr)
#pragma unroll
                    for (int c = 0; c < 8; ++c) v[rr][c] = *(const f32x4*)(xr + rr * D + c * 256 + lane * 4);
#pragma unroll
                for (int rr = 0; rr < 2; ++rr) { const int r16 = wid * 2 + rr, row = rowa + rr; float ss = 0.f;
#pragma unroll
                    for (int c = 0; c < 8; ++c) ss += v[rr][c][0] * v[rr][c][0] + v[rr][c][1] * v[rr][c][1] + v[rr][c][2] * v[rr][c][2] + v[rr][c][3] * v[rr][c][3];
                    ss = wave_sum(ss); const float r = rsqrtf(ss * (1.0f / D) + EPS);
#pragma unroll
                    for (int c = 0; c < 8; ++c) { const int k = c * 256 + lane * 4; const f32x4 g4 = *(const LAS f32x4*)(gs + k), s4 = *(const LAS f32x4*)(sh + k);
                        const f32x4 h4 = (v[rr][c] * r) * g4 + s4; u32x2 w; w.x = cvtpk(h4[0], h4[1]); w.y = cvtpk(h4[2], h4[3]);
                        *(u32x2*)(ha + (size_t)row * D + k) = w; *(LAS u32x2*)(lds + N1_HS + r16 * N1_PITCH + k * 2) = w; } }
            }
            __syncthreads();
            {
                f32x4 acc = {0.f, 0.f, 0.f, 0.f};
                const LAS unsigned char* ap = lds + N1_HS + (lane & 15) * N1_PITCH + wid * 512 + (lane >> 4) * 16;
                const LAS unsigned char* bp = lds + N1_WT + (lane & 15) * N1_PITCH + wid * 512 + (lane >> 4) * 16;
#pragma unroll
                for (int ks = 0; ks < 8; ++ks) acc = __builtin_amdgcn_mfma_f32_16x16x32_bf16(*(const LAS bf16x8*)(ap + ks * 64), *(const LAS bf16x8*)(bp + ks * 64), acc, 0, 0, 0);
#pragma unroll
                for (int i = 0; i < 4; ++i) ps[wid * 256 + (4 * (lane >> 4) + i) * 16 + (lane & 15)] = acc[i];
            }
            __syncthreads();
            if (tid < 256) { float z = p.b_forget[tid & 15];
#pragma unroll
                for (int w = 0; w < 8; ++w) z += ps[w * 256 + tid];
                const int row = blk * 32 + half * 16 + (tid >> 4);
                logf[((size_t)b * H + (tid & 15)) * S + (row % S)] = fminf(z, 0.f) - log1pf(__expf(-fabsf(z))); }
        }
    }
}
__device__ __forceinline__ void phase_scan_conv(const Ptrs& p, LAS unsigned char* lds) {
    const int tid = tid_opaque(), lane = tid & 63, wid = tid >> 6; LAS float* wtot = (LAS float*)lds;
    for (int sq = vwg_id(); sq < B * H; sq += gridDim.x) {
        const float* lf = (const float*)(p.ws + OFF_LOGF) + (size_t)sq * S; float* fc = (float*)(p.ws + OFF_FCUM) + (size_t)sq * S;
        f32x4 a = *(const f32x4*)(lf + tid * 8), b4 = *(const f32x4*)(lf + tid * 8 + 4);
        a[1] += a[0]; a[2] += a[1]; a[3] += a[2]; b4[0] += a[3]; b4[1] += b4[0]; b4[2] += b4[1]; b4[3] += b4[2];
        const float tot = b4[3]; float inc = tot;
#pragma unroll
        for (int o = 1; o < 64; o <<= 1) { const float n = __shfl_up(inc, o); if (lane >= o) inc += n; }
        __syncthreads();
        if (lane == 63) wtot[wid] = inc;
        __syncthreads();
        float off = inc - tot; for (int w = 0; w < wid; ++w) off += wtot[w];
        *(f32x4*)(fc + tid * 8) = (a + off) * LOG2E; *(f32x4*)(fc + tid * 8 + 4) = (b4 + off) * LOG2E;
    }
    const bf16_t* pr = (const bf16_t*)(p.ws + OFF_PROJ); bf16_t* ua = (bf16_t*)(p.ws + OFF_UA);
    for (int item = vwg_id() * 512 + tid; item < (NTOK / 8) * (DC / 8); item += gridDim.x * 512) {
        const int cg = item & 127, rc = item >> 7, r0 = rc * 8, c = cg * 8;
        float w0[8], w1[8], w2[8], pm2[8], pm1[8];
#pragma unroll
        for (int j = 0; j < 8; ++j) { w0[j] = p.conv_w[c + j]; w1[j] = p.conv_w[DC + c + j]; w2[j] = p.conv_w[2 * DC + c + j]; pm2[j] = 0.f; pm1[j] = 0.f; }
        if ((r0 % S) != 0) {
#pragma unroll
            for (int d = 0; d < 2; ++d) { const bf16_t* q = pr + (size_t)(r0 - 2 + d) * PLD; const u32x4 xc = *(const u32x4*)(q + C_XC + c), cc = *(const u32x4*)(q + C_CC + c);
#pragma unroll
                for (int j = 0; j < 4; ++j) { const float e0 = bflo(xc[j]) * bflo(cc[j]), e1 = bfhi(xc[j]) * bfhi(cc[j]); if (d == 0) { pm2[2 * j] = e0; pm2[2 * j + 1] = e1; } else { pm1[2 * j] = e0; pm1[2 * j + 1] = e1; } } }
        }
#pragma unroll
        for (int i = 0; i < 8; ++i) { const bf16_t* q = pr + (size_t)(r0 + i) * PLD; const u32x4 xc = *(const u32x4*)(q + C_XC + c), cc = *(const u32x4*)(q + C_CC + c), cb = *(const u32x4*)(q + C_CB + c);
            float o[8];
#pragma unroll
            for (int j = 0; j < 4; ++j) { const float e0 = bflo(xc[j]) * bflo(cc[j]), e1 = bfhi(xc[j]) * bfhi(cc[j]);
                o[2 * j] = bflo(cb[j]) * (w0[2 * j] * pm2[2 * j] + w1[2 * j] * pm1[2 * j] + w2[2 * j] * e0); o[2 * j + 1] = bfhi(cb[j]) * (w0[2 * j + 1] * pm2[2 * j + 1] + w1[2 * j + 1] * pm1[2 * j + 1] + w2[2 * j + 1] * e1);
                pm2[2 * j] = pm1[2 * j]; pm2[2 * j + 1] = pm1[2 * j + 1]; pm1[2 * j] = e0; pm1[2 * j + 1] = e1; }
            u32x4 w; w.x = cvtpk(o[0], o[1]); w.y = cvtpk(o[2], o[3]); w.z = cvtpk(o[4], o[5]); w.w = cvtpk(o[6], o[7]);
            *(u32x4*)(ua + (size_t)(r0 + i) * 2048 + c) = w; }
    }
}
constexpr int ATT_LDS = 16384 + 16384 + 512;
__device__ __forceinline__ int crow(int r, int hi) { return (r & 3) + 8 * (r >> 2) + 4 * hi; }
__device__ __forceinline__ void phase_attn(const Ptrs& p, LAS unsigned char* lds) {
    const int tid = tid_opaque(), lane = tid & 63, wid = __builtin_amdgcn_readfirstlane(tid >> 6), r32 = lane & 31, hi = lane >> 5;
    const bf16_t* pr = (const bf16_t*)(p.ws + OFF_PROJ); bf16_t* ua = (bf16_t*)(p.ws + OFF_UA);
    const int k_row = tid >> 3, k_ch = tid & 7;
    const unsigned kdst = (unsigned)(k_row * 128 + ((k_ch ^ ((k_row >> 1) & 7)) * 16));
    const int v_ch = (tid & 3) + 4 * ((tid >> 3) & 1), v_kv = ((tid >> 2) & 1) + 2 * (tid >> 4);
    const unsigned vdst = (unsigned)(16384 + ((v_kv >> 3) * 2 + (v_ch >> 2)) * 512 + (v_kv & 7) * 64 + (v_ch & 3) * 16);
    const int ksw = (r32 >> 1) & 7; const unsigned kfr = (unsigned)(r32 * 128);
    const unsigned vfr = (unsigned)(16384 + (4 * hi + ((lane & 15) >> 2)) * 64 + ((lane >> 4) & 1) * 32 + (lane & 3) * 8);
    constexpr float THR = 6.0f;
    for (int pi = vwg_id(); pi < 256; pi += gridDim.x) {
#pragma unroll 1
        for (int half = 0; half < 2; ++half) {
            const int s_ = pi & 7, qb = half ? 15 - s_ : s_, bh = pi >> 3, b = bh >> 4, h = bh & 15, q0 = qb * 256;
            const float* fc = (const float*)(p.ws + OFF_FCUM) + (size_t)bh * S; const size_t rowb = (size_t)b * S;
            const bf16_t* ksrc = pr + (rowb + k_row) * PLD + C_K + h * 64 + k_ch * 8;
            const bf16_t* vsrc = pr + (rowb + v_kv) * PLD + C_V + h * 64 + v_ch * 8;
            const int qrow = q0 + 32 * wid + r32;
            bf16x8 qr[4];
#pragma unroll
            for (int d0 = 0; d0 < 4; ++d0) qr[d0] = *(const bf16x8*)(pr + (rowb + qrow) * PLD + C_Q + h * 64 + 16 * d0 + 8 * hi);
            const float Fq = fc[qrow];
            const int JT = 4 * qb + 4, jmax = 4 * qb + (wid >> 1);
            float mhat = 0.f, lsum = 0.f; f32x16 o0, o1;
#pragma unroll
            for (int r = 0; r < 16; ++r) { o0[r] = 0.f; o1[r] = 0.f; }
            u32x4 kreg = *(const u32x4*)(ksrc + (size_t)(JT - 1) * 64 * PLD), vreg = *(const u32x4*)(vsrc + (size_t)(JT - 1) * 64 * PLD); f32x4 freg = {0.f, 0.f, 0.f, 0.f};
            if (tid < 16) freg = *(const f32x4*)(fc + (JT - 1) * 64 + tid * 4);
            *(LAS u32x4*)(lds + kdst) = kreg; *(LAS u32x4*)(lds + vdst) = vreg; if (tid < 16) *(LAS f32x4*)(lds + 32768 + tid * 16) = freg;
            G_BAR();
#pragma unroll 1
            for (int j = JT - 1; j >= 0; --j) {
                const int cur = (JT - 1 - j) & 1;
                if (j > 0) { kreg = *(const u32x4*)(ksrc + (size_t)(j - 1) * 64 * PLD); vreg = *(const u32x4*)(vsrc + (size_t)(j - 1) * 64 * PLD); if (tid < 16) freg = *(const f32x4*)(fc + (j - 1) * 64 + tid * 4); }
                if (j <= jmax) {
                    const LAS unsigned char* kb = lds + cur * 8192; const LAS float* fk = (const LAS float*)(lds + 32768 + cur * 256);
                    f32x16 p0, p1; const float base = Fq - mhat;
#pragma unroll
                    for (int g = 0; g < 4; ++g) { const f32x4 fa = *(const LAS f32x4*)(fk + 8 * g + 4 * hi), fb = *(const LAS f32x4*)(fk + 32 + 8 * g + 4 * hi);
#pragma unroll
                        for (int i = 0; i < 4; ++i) { p0[4 * g + i] = base - fa[i]; p1[4 * g + i] = base - fb[i]; } }
#pragma unroll
                    for (int d0 = 0; d0 < 4; ++d0) { const unsigned a = kfr + (unsigned)(((2 * d0 + hi) ^ ksw) * 16);
                        const bf16x8 k0 = *(const LAS bf16x8*)(kb + a), k1 = *(const LAS bf16x8*)(kb + a + 4096);
                        p0 = __builtin_amdgcn_mfma_f32_32x32x16_bf16(k0, qr[d0], p0, 0, 0, 0); p1 = __builtin_amdgcn_mfma_f32_32x32x16_bf16(k1, qr[d0], p1, 0, 0, 0); }
                    if (j == jmax) { const int lim = 32 * (wid & 1) + r32;
                        asm volatile("; diagonal tile: mask" ::: "memory");
#pragma unroll
                        for (int r = 0; r < 16; ++r) { const int kv = crow(r, hi); if (kv > lim) p0[r] = -INFINITY; if (kv + 32 > lim) p1[r] = -INFINITY; } }
                    float rm = __builtin_fmaxf(__builtin_fmaxf(p0[0], p1[0]), __builtin_fmaxf(p0[1], p1[1]));
#pragma unroll
                    for (int r = 2; r < 16; r += 1) rm = __builtin_fmaxf(__builtin_fmaxf(rm, p0[r]), p1[r]);
                    rm = xhalf_max(rm);
                    const bool need = (j == jmax) || (rm > THR);
                    if (__any(need)) { const float dl = need ? rm : 0.f; mhat += dl; const float f = __builtin_amdgcn_exp2f(-dl); lsum *= f;
#pragma unroll
                        for (int r = 0; r < 16; ++r) { p0[r] -= dl; p1[r] -= dl; o0[r] *= f; o1[r] *= f; } }
                    float ps = 0.f;
#pragma unroll
                    for (int r = 0; r < 16; ++r) { p0[r] = __builtin_amdgcn_exp2f(p0[r]); p1[r] = __builtin_amdgcn_exp2f(p1[r]); ps += p0[r] + p1[r]; }
                    lsum += ps;
#pragma unroll
                    for (int bl = 0; bl < 2; ++bl)
#pragma unroll
                        for (int ks = 0; ks < 2; ++ks) {
                            u32x4 pw;
                            if (bl == 0) { pw.x = cvtpk(p0[8 * ks], p0[8 * ks + 1]); pw.y = cvtpk(p0[8 * ks + 2], p0[8 * ks + 3]); pw.z = cvtpk(p0[8 * ks + 4], p0[8 * ks + 5]); pw.w = cvtpk(p0[8 * ks + 6], p0[8 * ks + 7]); }
                            else { pw.x = cvtpk(p1[8 * ks], p1[8 * ks + 1]); pw.y = cvtpk(p1[8 * ks + 2], p1[8 * ks + 3]); pw.z = cvtpk(p1[8 * ks + 4], p1[8 * ks + 5]); pw.w = cvtpk(p1[8 * ks + 6], p1[8 * ks + 7]); }
                            const bf16x8 pf = __builtin_bit_cast(bf16x8, pw);
#pragma unroll
                            for (int d0 = 0; d0 < 2; ++d0) { const LAS unsigned char* va = lds + vfr + cur * 8192 + ((4 * bl + 2 * ks) * 2 + d0) * 512;
                                const v4i16_t lo = __builtin_amdgcn_ds_read_tr16_b64_v4i16((LAS v4i16_t*)va), h2 = __builtin_amdgcn_ds_read_tr16_b64_v4i16((LAS v4i16_t*)(va + 1024));
                                const bf16x8 vf = (bf16x8){lo[0], lo[1], lo[2], lo[3], h2[0], h2[1], h2[2], h2[3]};
                                if (d0 == 0) o0 = __builtin_amdgcn_mfma_f32_32x32x16_bf16(vf, pf, o0, 0, 0, 0); else o1 = __builtin_amdgcn_mfma_f32_32x32x16_bf16(vf, pf, o1, 0, 0, 0); } }
                }
                if (j > 0) { LAS unsigned char* d = lds + (cur ^ 1) * 8192; *(LAS u32x4*)(d + kdst) = kreg; *(LAS u32x4*)(d + vdst) = vreg; if (tid < 16) *(LAS f32x4*)(lds + 32768 + (cur ^ 1) * 256 + tid * 16) = freg; }
                G_BAR();
            }
            const float inv = __builtin_amdgcn_rcpf(xhalf_sum(lsum));
            bf16_t* op = ua + (rowb + qrow) * 2048 + 1024 + h * 64 + 4 * hi;
#pragma unroll
            for (int g = 0; g < 4; ++g) { u32x2 w0, w1; w0.x = cvtpk(o0[4 * g] * inv, o0[4 * g + 1] * inv); w0.y = cvtpk(o0[4 * g + 2] * inv, o0[4 * g + 3] * inv);
                w1.x = cvtpk(o1[4 * g] * inv, o1[4 * g + 1] * inv); w1.y = cvtpk(o1[4 * g + 2] * inv, o1[4 * g + 3] * inv);
                *(u32x2*)(op + 8 * g) = w0; *(u32x2*)(op + 32 + 8 * g) = w1; }
        }
    }
}
constexpr int R_PITCH = 512 * 2 + 16, R_WHI = 0, R_WLO = 32 * R_PITCH, R_HHI = 64 * R_PITCH, R_HLO = 96 * R_PITCH, R_GS = 128 * R_PITCH, R_LG = R_GS + 16384, R_TAB = R_LG + 4096, R_END = R_TAB + 2048;
__device__ __forceinline__ void phase_norm2_route(const Ptrs& p, LAS unsigned char* lds) {
    LAS float* gs = (LAS float*)(lds + R_GS); LAS float* sh = gs + 2048; LAS float* lg = (LAS float*)(lds + R_LG); LAS float* ps = (LAS float*)lds;
    const int tid = tid_opaque(), lane = tid & 63, wid = tid >> 6;
    bf16_t* ha = (bf16_t*)(p.ws + OFF_HA); const float* x1 = (const float*)(p.ws + OFF_X1);
    int* counts = (int*)(p.ws + OFF_CTRL); int* list = (int*)(p.ws + OFF_LIST); float* gate = (float*)(p.ws + OFF_GATE);
    for (int blk = vwg_id(); blk < NTOK / 32; blk += gridDim.x) {
        const int b = (blk * 32) / S; const float* mod = (const float*)(p.ws + OFF_MOD) + (size_t)b * NMOD;
        __syncthreads();
        for (int i = tid; i < 2048; i += 512) { gs[i] = p.norm_ffn_g[i] * (1.0f + mod[4 * D + i]); sh[i] = mod[3 * D + i]; }
        __syncthreads();
#pragma unroll 1
        for (int half = 0; half < 2; ++half) {
            f32x4 v[2][8];
#pragma unroll
            for (int q = 0; q < 2; ++q) { const float* xr = x1 + (size_t)(blk * 32 + half * 16 + wid * 2 + q) * D;
#pragma unroll
                for (int c = 0; c < 8; ++c) v[q][c] = *(const f32x4*)(xr + c * 256 + lane * 4); }
#pragma unroll
            for (int q = 0; q < 2; ++q) { const int row = blk * 32 + half * 16 + wid * 2 + q; float ss = 0.f;
#pragma unroll
                for (int c = 0; c < 8; ++c) ss += v[q][c][0] * v[q][c][0] + v[q][c][1] * v[q][c][1] + v[q][c][2] * v[q][c][2] + v[q][c][3] * v[q][c][3];
                ss = wave_sum(ss); const float r = rsqrtf(ss * (1.0f / D) + EPS);
#pragma unroll
                for (int c = 0; c < 8; ++c) { const int k = c * 256 + lane * 4; const f32x4 g4 = *(const LAS f32x4*)(gs + k), s4 = *(const LAS f32x4*)(sh + k);
                    v[q][c] = (v[q][c] * r) * g4 + s4; u32x2 w; w.x = cvtpk(v[q][c][0], v[q][c][1]); w.y = cvtpk(v[q][c][2], v[q][c][3]); *(u32x2*)(ha + (size_t)row * D + k) = w; } }
            f32x4 acc[2];
            acc[0] = (f32x4){0.f, 0.f, 0.f, 0.f}; acc[1] = (f32x4){0.f, 0.f, 0.f, 0.f};
#pragma unroll
            for (int ch = 0; ch < 4; ++ch) {
                __syncthreads();
                for (int i = tid; i < 2048; i += 512) { const int kp = i >> 3, cq = i & 7; const float* w = p.router_w + (size_t)(512 * ch + 2 * kp) * E + cq * 4;
                    const f32x4 w0 = *(const f32x4*)w, w1 = *(const f32x4*)(w + E);
#pragma unroll
                    for (int j = 0; j < 4; ++j) { const unsigned hi = cvtpk(w0[j], w1[j]), lo = cvtpk(w0[j] - bflo(hi), w1[j] - bfhi(hi));
                        *(LAS unsigned*)(lds + R_WHI + (cq * 4 + j) * R_PITCH + kp * 4) = hi; *(LAS unsigned*)(lds + R_WLO + (cq * 4 + j) * R_PITCH + kp * 4) = lo; } }
#pragma unroll
                for (int q = 0; q < 2; ++q)
#pragma unroll
                    for (int cc = 0; cc < 2; ++cc) { const f32x4 h4 = v[q][2 * ch + cc]; u32x2 hi, lo; hi.x = cvtpk(h4[0], h4[1]); hi.y = cvtpk(h4[2], h4[3]);
                        lo.x = cvtpk(h4[0] - bflo(hi.x), h4[1] - bfhi(hi.x)); lo.y = cvtpk(h4[2] - bflo(hi.y), h4[3] - bfhi(hi.y));
                        const int o = (wid * 2 + q) * R_PITCH + (cc * 256 + lane * 4) * 2;
                        *(LAS u32x2*)(lds + R_HHI + o) = hi; *(LAS u32x2*)(lds + R_HLO + o) = lo; }
                __syncthreads();
#pragma unroll
                for (int s2 = 0; s2 < 2; ++s2) { const int off = (lane & 15) * R_PITCH + (2 * wid + s2) * 64 + (lane >> 4) * 16;
                    const bf16x8 ahi = *(const LAS bf16x8*)(lds + R_HHI + off), alo = *(const LAS bf16x8*)(lds + R_HLO + off);
#pragma unroll
                    for (int ct = 0; ct < 2; ++ct) { const bf16x8 bhi = *(const LAS bf16x8*)(lds + R_WHI + ct * 16 * R_PITCH + off), blo = *(const LAS bf16x8*)(lds + R_WLO + ct * 16 * R_PITCH + off);
                        acc[ct] = __builtin_amdgcn_mfma_f32_16x16x32_bf16(ahi, bhi, acc[ct], 0, 0, 0); acc[ct] = __builtin_amdgcn_mfma_f32_16x16x32_bf16(alo, bhi, acc[ct], 0, 0, 0);
                        acc[ct] = __builtin_amdgcn_mfma_f32_16x16x32_bf16(ahi, blo, acc[ct], 0, 0, 0); } }
            }
            __syncthreads();
#pragma unroll
            for (int ct = 0; ct < 2; ++ct)
#pragma unroll
                for (int i = 0; i < 4; ++i) ps[wid * 512 + (4 * (lane >> 4) + i) * 32 + ct * 16 + (lane & 15)] = acc[ct][i];
            __syncthreads();
            { const int o = tid; float z = p.router_b[o & 31];
#pragma unroll
              for (int w = 0; w < 8; ++w) z += ps[w * 512 + o];
              lg[half * 512 + o] = z; }
        }
        LAS int* lcnt = (LAS int*)(lds + R_TAB);
        LAS int* lbase = lcnt + 32;
        LAS int* asg_e = lbase + 32;
        LAS int* asg_r = asg_e + 128;
        if (tid < 32) lcnt[tid] = 0;
        __syncthreads();
#pragma unroll 1
        for (int rr = 0; rr < 4; ++rr) {
            const int rl = wid * 4 + rr, row = blk * 32 + rl;
            float val = (lane < 32) ? lg[rl * 32 + lane] : -INFINITY;
            float tv[4]; int ti[4];
#pragma unroll
            for (int k = 0; k < 4; ++k) { const float m = wave_max(val);
                const unsigned long long bal = __ballot(val == m); const int idx = __ffsll((long long)bal) - 1;
                tv[k] = m; ti[k] = idx; if (lane == idx) val = -INFINITY; }
            if (lane < 4) { float pe[4], sum = 0.f;
#pragma unroll
                for (int k = 0; k < 4; ++k) { pe[k] = __expf(tv[k] - tv[0]); sum += pe[k]; }
                const int e = lane == 0 ? ti[0] : lane == 1 ? ti[1] : lane == 2 ? ti[2] : ti[3]; const float pk = (lane == 0 ? pe[0] : lane == 1 ? pe[1] : lane == 2 ? pe[2] : pe[3]) / sum;
                const int lr = __hip_atomic_fetch_add((int*)(lcnt + e), 1, __ATOMIC_RELAXED, __HIP_MEMORY_SCOPE_WORKGROUP); asg_e[rl * 4 + lane] = e; asg_r[rl * 4 + lane] = lr; gate[row * 4 + lane] = pk; }
        }
        __syncthreads();
        if (tid < 32) lbase[tid] = atomicAdd(&counts[tid], lcnt[tid]);
        __syncthreads();
        if (tid < 128) { const int e = asg_e[tid]; list[(size_t)e * NTOK + lbase[e] + asg_r[tid]] = (blk * 32) * 4 + tid; }
    }
}
__device__ __forceinline__ void phase_final(const Ptrs& p, LAS unsigned char* lds) {
    const int tid = tid_opaque(), lane = tid & 63, wid = tid >> 6;
    const float* x1 = (const float*)(p.ws + OFF_X1); const bf16_t* y = (const bf16_t*)(p.ws + OFF_Y);
    for (int row = vwg_id() * 8 + wid; row < NTOK; row += gridDim.x * 8) {
        const int b = row / S; const float* gf = (const float*)(p.ws + OFF_MOD) + (size_t)b * NMOD + 5 * D; const float* xr = x1 + (size_t)row * D; const bf16_t* yr = y + (size_t)row * 4 * D;
        f32x4 v[8]; float ss = 0.f;
#pragma unroll
        for (int c = 0; c < 8; ++c) { const int k = c * 256 + lane * 4; f32x4 s = {0.f, 0.f, 0.f, 0.f};
#pragma unroll
            for (int q = 0; q < 4; ++q) { const u32x2 w = *(const u32x2*)(yr + (size_t)q * D + k); s[0] += bflo(w.x); s[1] += bfhi(w.x); s[2] += bflo(w.y); s[3] += bfhi(w.y); }
            v[c] = *(const f32x4*)(xr + k) + *(const f32x4*)(gf + k) * s; ss += v[c][0] * v[c][0] + v[c][1] * v[c][1] + v[c][2] * v[c][2] + v[c][3] * v[c][3]; }
        ss = wave_sum(ss); const float r = rsqrtf(ss * (1.0f / D) + EPS);
#pragma unroll
        for (int c = 0; c < 8; ++c) { const int k = c * 256 + lane * 4; *(f32x4*)(p.out + (size_t)row * D + k) = (v[c] * r) * *(const f32x4*)(p.final_g + k); }
    }
}

#define XB_TMO      128
#define XB_XCNT(j)  (256  + 64 * (j))
#define XB_XSUB(j)  (1280 + 64 * (j))
#define XB_XGEN(j)  (2304 + 64 * (j))
#define XB_TOP      3328
#define XB_TOPGEN   3392
#define XCD_BAR_WORDS 3456
#define XB_SPIN_CAP (1u << 18)

__device__ __forceinline__ unsigned xb_ld(unsigned* p)              { return __hip_atomic_load(p, __ATOMIC_RELAXED, __HIP_MEMORY_SCOPE_AGENT); }
__device__ __forceinline__ unsigned xb_add(unsigned* p, unsigned v) { return __hip_atomic_fetch_add(p, v, __ATOMIC_RELAXED, __HIP_MEMORY_SCOPE_AGENT); }
__device__ __forceinline__ unsigned xb_xcc_id() { return (unsigned)__builtin_amdgcn_s_getreg((3 << 11) | 20) & 0xFu; }
#define XB_SPIN(cond, bar) do { unsigned _sp = 0; while (cond) { __builtin_amdgcn_s_sleep(1); \
    if ((++_sp & 255u) == 0u) { if (xb_ld(&(bar)[XB_TMO])) break; if (_sp > XB_SPIN_CAP) { atomicAdd(&(bar)[XB_TMO], 1u); break; } } } } while (0)

struct XcdBarrier {
    unsigned* bar; unsigned x;
    volatile LAS unsigned* st;
};

__device__ __forceinline__ XcdBarrier xcd_barrier_post(unsigned* bar, volatile LAS unsigned* st) {
    XcdBarrier b; b.bar = bar; b.x = xb_xcc_id(); b.st = st;
    if (threadIdx.x == 0) (void)xb_add(&bar[XB_XCNT(b.x)], 1u);
    return b;
}
__device__ __forceinline__ void xcd_barrier_complete(unsigned* bar, unsigned x, unsigned& nloc, unsigned& nx) {
    const unsigned G = gridDim.x * gridDim.y * gridDim.z;
    unsigned sum, cnt, mine, sp = 0u;
    for (;;) {
        sum = 0u; cnt = 0u; mine = 0u;
#pragma unroll
        for (unsigned j = 0; j < 16; ++j) { const unsigned c = xb_ld(&bar[XB_XCNT(j)]); sum += c; cnt += (c > 0u) ? 1u : 0u; mine = (j == x) ? c : mine; }
        if (sum == G) break;
        __builtin_amdgcn_s_sleep(1);
        if ((++sp & 255u) == 0u) { if (xb_ld(&bar[XB_TMO])) break; if (sp > XB_SPIN_CAP) { atomicAdd(&bar[XB_TMO], 1u); break; } }
    }
    nloc = mine > 0u ? mine : 1u; nx = cnt > 0u ? cnt : 1u;
}

__device__ __forceinline__ void xcd_barrier(const XcdBarrier& b) {
    asm volatile("s_waitcnt vmcnt(0)" ::: "memory");
    __syncthreads();
    if (threadIdx.x == 0) {
        unsigned* bar = b.bar;
        __builtin_amdgcn_s_waitcnt(0);
        unsigned nloc = b.st[0], nx = b.st[1];
        if (nloc == 0u) { xcd_barrier_complete(bar, b.x, nloc, nx); b.st[0] = nloc; b.st[1] = nx; }
        const unsigned old = xb_add(&bar[XB_XSUB(b.x)], 1u);
        const unsigned gen = old / nloc;
        if (old + 1u == (gen + 1u) * nloc) {
            __builtin_amdgcn_fence(__ATOMIC_RELEASE, "agent");
            asm volatile("s_waitcnt vmcnt(0)" ::: "memory");
            const unsigned og = xb_add(&bar[XB_TOP], 1u);
            const unsigned tg = og / nx;
            if (og + 1u == (tg + 1u) * nx) xb_add(&bar[XB_TOPGEN], 1u);
            else XB_SPIN(xb_ld(&bar[XB_TOPGEN]) == tg, bar);
            __builtin_amdgcn_fence(__ATOMIC_ACQUIRE, "agent");
            xb_add(&bar[XB_XGEN(b.x)], 1u);
            asm volatile("s_waitcnt vmcnt(0)" ::: "memory");
        } else {
            XB_SPIN(xb_ld(&bar[XB_XGEN(b.x)]) == gen, bar);
            __builtin_amdgcn_fence(__ATOMIC_ACQUIRE, "agent");
            asm volatile("s_waitcnt vmcnt(0)" ::: "memory");
        }
    }
    __syncthreads();
}


constexpr int LDS_TOTAL = AUX_LDS + 16;
constexpr size_t OFF_BAR = OFF_CTRL + 4096;
static_assert(GEMM_LDS <= AUX_LDS && ATT_LDS <= AUX_LDS && N1_END <= AUX_LDS && R_END <= AUX_LDS, "LDS");
static_assert(4096 + XCD_BAR_WORDS * 4 <= 65536, "ctrl");
__global__ void __launch_bounds__(512, 2) mega_fwd(Ptrs p) {
    LAS unsigned char* lds = (LAS unsigned char*)dyn_lds;
    volatile LAS unsigned* st = (volatile LAS unsigned*)(lds + AUX_LDS);
    if (threadIdx.x == 0) { st[0] = 0u; st[1] = 0u; st[2] = 0u; st[3] = 0u; }
    __syncthreads();
    XcdBarrier bar = xcd_barrier_post((unsigned*)(p.ws + OFF_BAR), st);
    phase_mod(p, lds);          xcd_barrier(bar);
    phase_norm1(p, lds);        xcd_barrier(bar);
    phase_gemm1(p, lds);        xcd_barrier(bar);
    phase_scan_conv(p, lds);    xcd_barrier(bar);
    phase_attn(p, lds);         xcd_barrier(bar);
    phase_merge(p, lds);        xcd_barrier(bar);
    phase_out(p, lds);          xcd_barrier(bar);
    phase_norm2_route(p, lds);  xcd_barrier(bar);
    phase_moe_gu(p, lds);
    phase_moe_down(p, lds);     xcd_barrier(bar);
    phase_final(p, lds);
}

extern "C" void kernel_launch(void* const* d_in, const int* in_sizes, int n_in, void* d_out, int out_size, void* d_ws, size_t ws_size, hipStream_t stream) {
    Ptrs p{};
    const float** f = (const float**)&p;
    for (int i = 0; i < 21; ++i) f[i] = (const float*)d_in[i];
    p.out = (float*)d_out; p.ws = (unsigned char*)d_ws;
    static int grid = 0;
    if (!grid) {
        (void)hipFuncSetAttribute((const void*)mega_fwd, hipFuncAttributeMaxDynamicSharedMemorySize, LDS_TOTAL);
        int dev = 0, cus = 0, per_cu = 0;
        (void)hipGetDevice(&dev);
        (void)hipDeviceGetAttribute(&cus, hipDeviceAttributeMultiprocessorCount, dev);
        (void)hipOccupancyMaxActiveBlocksPerMultiprocessor(&per_cu, mega_fwd, 512, LDS_TOTAL);
        grid = cus * (per_cu < 1 ? per_cu : 1);
        if (grid <= 0) grid = cus > 0 ? cus : 256;
    }
    (void)hipMemsetAsync(p.ws + OFF_CTRL, 0, 65536, stream);
    mega_fwd<<<grid, 512, LDS_TOTAL, stream>>>(p);
}
```

```cpp
#include <hip/hip_runtime.h>
#include <stdint.h>

typedef unsigned short bf16_t;
typedef float f32x4 __attribute__((ext_vector_type(4)));
typedef unsigned u32x4 __attribute__((ext_vector_type(4)));
typedef unsigned u32x2 __attribute__((ext_vector_type(2)));

namespace cfg {
constexpr int B = 2, S = 4096, D = 2048, NTOK = B * S, H = 16, DH = 64, DA = 1024, DC = 1024;
constexpr int NIN = 10256, NMOD = 6 * D, E = 32, TOPK = 4, NASG = NTOK * TOPK;
constexpr int PLD = 10240;
constexpr int C_XC = 0, C_CB = 1024, C_CC = 2048, C_Q = 3072, C_K = 4096, C_V = 5120, C_GC = 6144, C_GA = 8192;
constexpr int W_F = 6144, W_GC = 6160, W_GA = 8208;
constexpr float EPS = 1e-6f, LOG2E = 1.4426950408889634f;
constexpr float QSCALE = 0.125f * LOG2E;
constexpr int ACT_ROWS = NASG + E * 256;
constexpr size_t al(size_t x) { return (x + 255) & ~(size_t)255; }
constexpr size_t OFF_CTRL = 0;
constexpr size_t OFF_MOD = 65536;
constexpr size_t OFF_LOGF = OFF_MOD + al((size_t)B * NMOD * 4);
constexpr size_t OFF_FCUM = OFF_LOGF + al((size_t)B * H * S * 4);
constexpr size_t OFF_HA = OFF_FCUM + al((size_t)B * H * S * 4);
constexpr size_t OFF_PROJ = OFF_HA + al((size_t)NTOK * D * 2);
constexpr size_t OFF_UA = OFF_PROJ + al((size_t)NTOK * PLD * 2);
constexpr size_t OFF_MRG = OFF_UA + al((size_t)NTOK * 2048 * 2);
constexpr size_t OFF_X1 = OFF_MRG + al((size_t)NTOK * D * 2);
constexpr size_t OFF_TMP = OFF_X1 + al((size_t)NTOK * D * 4);
constexpr size_t OFF_GATE = OFF_TMP + al((size_t)NTOK * D * 4);
constexpr size_t OFF_LIST = OFF_GATE + al((size_t)NASG * 4);
constexpr size_t OFF_ACT = OFF_LIST + al((size_t)E * NTOK * 4);
constexpr size_t OFF_Y = OFF_ACT + al((size_t)ACT_ROWS * D * 2);
constexpr size_t WS_END = OFF_Y + al((size_t)NASG * D * 2);
}
using namespace cfg;

__device__ __forceinline__ float bf2f(bf16_t v) { return __uint_as_float(((unsigned)v) << 16); }
__device__ __forceinline__ bf16_t f2bf(float f) { unsigned u = __float_as_uint(f); u += 0x7fffu + ((u >> 16) & 1u); return (bf16_t)(u >> 16); }
__device__ __forceinline__ float sigmoidf_(float x) { return __builtin_amdgcn_rcpf(1.0f + __builtin_amdgcn_exp2f(x * -1.4426950408889634f)); }

struct Ptrs {
    const float *x, *c, *ada_w, *ada_b, *norm_mix_g, *w_in, *b_forget, *conv_w, *w_conv_out, *w_attn_out, *w_out, *norm_ffn_g,
        *router_w, *router_b, *w_gate, *b_gate, *w_up, *b_up, *w_down, *b_down, *final_g;
    float* out; unsigned char* ws;
};

#define LAS __attribute__((address_space(3)))
typedef short bf16x8 __attribute__((ext_vector_type(8)));
typedef float f32x2_t __attribute__((ext_vector_type(2)));
typedef __bf16 bf16x2_t __attribute__((ext_vector_type(2)));
__device__ __forceinline__ unsigned cvtpk(float lo, float hi) { f32x2_t v = {lo, hi}; bf16x2_t b = __builtin_convertvector(v, bf16x2_t); return __builtin_bit_cast(unsigned, b); }
__device__ __forceinline__ float bflo(unsigned w) { return __uint_as_float(w << 16); }
__device__ __forceinline__ float bfhi(unsigned w) { return __uint_as_float(w & 0xffff0000u); }
__device__ __forceinline__ int tid_opaque() { int t = threadIdx.x; asm volatile("" : "+v"(t)); return t; }
constexpr int GEMM_LDS = 131072;

struct GemmT {
    int wr, wc, fr, fq;
    int aR, aC;
    unsigned a_w;
    int b_k, b_col, b_p, b_gucol;
    unsigned b_w, b_rot;
    unsigned a_r, b_r;
    __device__ __forceinline__ void init_epi() { const int tid = tid_opaque(), wid = tid >> 6, lane = tid & 63; wr = wid >> 2; wc = wid & 3; fr = lane & 15; fq = lane >> 4; }
    __device__ __forceinline__ void init() {
        const int tid = tid_opaque(), wid = tid >> 6, lane = tid & 63;
        wr = wid >> 2; wc = wid & 3; fr = lane & 15; fq = lane >> 4;
        aR = (wid >> 1) * 16 + (lane >> 2); aC = (wid & 1) * 32 + (((lane & 3) ^ ((lane >> 5) << 1)) * 8);
        a_w = (unsigned)(wid * 1024 + lane * 16);
        { const int l32 = lane & 31, kc8 = 2 * (wid >> 1) + (lane >> 5), wc_ = l32 >> 3, bfq = (l32 >> 1) & 3, nlo = l32 & 1; b_p = wid & 1;
          b_k = kc8 * 8; b_col = wc_ * 64 + b_p * 32 + bfq * 8 + nlo * 4; b_gucol = wc_ * 32 + bfq * 8 + nlo * 4;
          const int sub = wc_ * 4 + 2 * b_p + nlo;
          b_w = (unsigned)((sub * 2 + (kc8 >> 2)) * 1024 + (((4 * bfq) * 64 + (kc8 & 3) * 16) ^ ((bfq >> 1) << 5))); b_rot = (unsigned)(nlo * 64); }
        const unsigned lo = (unsigned)((fr * 64 + fq * 16) ^ ((fr >> 3) << 5));
        a_r = (unsigned)(wr * 16384) + lo; b_r = 32768u + (unsigned)(wc * 8192) + lo;
    }
};

__device__ __forceinline__ void gemm_kloop(f32x4 (&acc)[8][4], LAS unsigned char* lds, const GemmT& T,
                                           __amdgpu_buffer_rsrc_t ra, unsigned ao0, unsigned ao1, unsigned ao2, unsigned ao3,
                                           __amdgpu_buffer_rsrc_t rb, unsigned bo, unsigned ldbB, int nt) {
    f32x4 sb[8];
    const unsigned a_wu = (unsigned)__builtin_amdgcn_readfirstlane((int)(T.a_w & ~1023u));
#define G_DMA_A(buf, t, i_) __builtin_amdgcn_raw_ptr_buffer_load_lds(ra, (LAS void*)(lds + (buf) * 65536 + a_wu + (i_) * 8192), 16, ao##i_, (unsigned)(t) * 128u, 0, 0)
#define G_ISSUE_B(t) do { const unsigned so_ = (unsigned)(t) * 64u * ldbB; _Pragma("unroll") for (int i_ = 0; i_ < 8; ++i_) sb[i_] = __builtin_bit_cast(f32x4, __builtin_amdgcn_raw_buffer_load_b128(rb, bo, so_ + (unsigned)i_ * ldbB, 0)); } while (0)
#define G_RETIRE() asm volatile("s_waitcnt vmcnt(0)" : "+v"(sb[0]), "+v"(sb[1]), "+v"(sb[2]), "+v"(sb[3]), "+v"(sb[4]), "+v"(sb[5]), "+v"(sb[6]), "+v"(sb[7]) :: "memory")
#define G_WRITE_B(buf) do { LAS unsigned char* d_ = lds + (buf) * 65536; \
        _Pragma("unroll") for (int j_ = 0; j_ < 4; ++j_) { u32x4 w_; w_.x = cvtpk(sb[0][j_], sb[1][j_]); w_.y = cvtpk(sb[2][j_], sb[3][j_]); w_.z = cvtpk(sb[4][j_], sb[5][j_]); w_.w = cvtpk(sb[6][j_], sb[7][j_]); \
            *(LAS u32x4*)(d_ + 32768 + T.b_w + ((T.b_rot + 64u * j_) & 255u)) = w_; } } while (0)
#define G_LDB(dst, buf, ks) do { const LAS unsigned char* s_ = lds + (buf) * 65536 + (ks) * 1024; _Pragma("unroll") for (int n_ = 0; n_ < 4; ++n_) dst[n_] = *(const LAS bf16x8*)(s_ + T.b_r + n_ * 2048); } while (0)
#define G_LDA(dst, buf, ks, h_) do { const LAS unsigned char* s_ = lds + (buf) * 65536 + (ks) * 1024; _Pragma("unroll") for (int m_ = 0; m_ < 4; ++m_) dst[m_] = *(const LAS bf16x8*)(s_ + T.a_r + ((h_) * 4 + m_) * 2048); } while (0)
#define G_MMA(At_, Bf_, h_) do { _Pragma("unroll") for (int m_ = 0; m_ < 4; ++m_) _Pragma("unroll") for (int n_ = 0; n_ < 4; ++n_) \
        acc[(h_) * 4 + m_][n_] = __builtin_amdgcn_mfma_f32_16x16x32_bf16(Bf_[n_], At_[m_], acc[(h_) * 4 + m_][n_], 0, 0, 0); } while (0)
#define G_SB() __builtin_amdgcn_sched_barrier(0)
#define G_BAR() do { asm volatile("s_waitcnt lgkmcnt(0)" ::: "memory"); __builtin_amdgcn_s_barrier(); asm volatile("" ::: "memory"); } while (0)
    bf16x8 Bf0[4], Bf1[4], AtA[4], AtB[4];
    G_ISSUE_B(0); G_DMA_A(0, 0, 0); G_DMA_A(0, 0, 1); G_DMA_A(0, 0, 2); G_DMA_A(0, 0, 3); G_RETIRE(); G_WRITE_B(0);
    if (nt > 1) G_ISSUE_B(1);
    G_BAR();
    for (int t = 0; t < nt; ++t) { const int cur = t & 1; const bool w1 = t + 1 < nt, i2 = t + 2 < nt;
        G_LDB(Bf0, cur, 0); G_LDA(AtA, cur, 0, 0); G_SB();
        G_LDA(AtB, cur, 0, 1); if (w1) { G_DMA_A(cur ^ 1, t + 1, 0); G_DMA_A(cur ^ 1, t + 1, 1); G_DMA_A(cur ^ 1, t + 1, 2); G_DMA_A(cur ^ 1, t + 1, 3); } G_MMA(AtA, Bf0, 0); G_SB();
        G_LDB(Bf1, cur, 1); G_LDA(AtA, cur, 1, 0); G_MMA(AtB, Bf0, 1); G_SB();
        G_LDA(AtB, cur, 1, 1); if (w1) { G_RETIRE(); G_WRITE_B(cur ^ 1); } if (i2) G_ISSUE_B(t + 2); G_MMA(AtA, Bf1, 0); G_SB();
        G_MMA(AtB, Bf1, 1); G_SB();
        G_BAR(); }
#undef G_LDA
#undef G_MMA
#undef G_SB
#undef G_DMA_A
#undef G_ISSUE_B
#undef G_WRITE_B
#undef G_RETIRE
#undef G_LDB
}
__device__ __forceinline__ void gemm_kloop_light(f32x4 (&acc)[8][4], LAS unsigned char* lds, const GemmT& T,
                                                 __amdgpu_buffer_rsrc_t ra, unsigned ao0, unsigned ao1, unsigned ao2, unsigned ao3,
                                                 __amdgpu_buffer_rsrc_t rb, unsigned bo, unsigned ldbB, int nt, int mlim) {
    f32x4 sb[8];
    const unsigned a_wu = (unsigned)__builtin_amdgcn_readfirstlane((int)(T.a_w & ~1023u));
#define G_DMA_A(buf, t, i_) __builtin_amdgcn_raw_ptr_buffer_load_lds(ra, (LAS void*)(lds + (buf) * 65536 + a_wu + (i_) * 8192), 16, ao##i_, (unsigned)(t) * 128u, 0, 0)
#define G_ISSUE_B(t) do { const unsigned so_ = (unsigned)(t) * 64u * ldbB; _Pragma("unroll") for (int i_ = 0; i_ < 8; ++i_) sb[i_] = __builtin_bit_cast(f32x4, __builtin_amdgcn_raw_buffer_load_b128(rb, bo, so_ + (unsigned)i_ * ldbB, 0)); } while (0)
#define G_RETIRE() asm volatile("s_waitcnt vmcnt(0)" : "+v"(sb[0]), "+v"(sb[1]), "+v"(sb[2]), "+v"(sb[3]), "+v"(sb[4]), "+v"(sb[5]), "+v"(sb[6]), "+v"(sb[7]) :: "memory")
#define G_WRITE_B(buf) do { LAS unsigned char* d_ = lds + (buf) * 65536; \
        _Pragma("unroll") for (int j_ = 0; j_ < 4; ++j_) { u32x4 w_; w_.x = cvtpk(sb[0][j_], sb[1][j_]); w_.y = cvtpk(sb[2][j_], sb[3][j_]); w_.z = cvtpk(sb[4][j_], sb[5][j_]); w_.w = cvtpk(sb[6][j_], sb[7][j_]); \
            *(LAS u32x4*)(d_ + 32768 + T.b_w + ((T.b_rot + 64u * j_) & 255u)) = w_; } } while (0)
    G_ISSUE_B(0); G_DMA_A(0, 0, 0); G_DMA_A(0, 0, 1); G_DMA_A(0, 0, 2); G_DMA_A(0, 0, 3); G_RETIRE(); G_WRITE_B(0);
    if (nt > 1) G_ISSUE_B(1);
    G_BAR();
    for (int t = 0; t < nt; ++t) { const int cur = t & 1; const bool w1 = t + 1 < nt, i2 = t + 2 < nt;
        if (w1) { G_DMA_A(cur ^ 1, t + 1, 0); G_DMA_A(cur ^ 1, t + 1, 1); G_DMA_A(cur ^ 1, t + 1, 2); G_DMA_A(cur ^ 1, t + 1, 3); }
        if (mlim > 0) {
#pragma unroll
            for (int ks = 0; ks < 2; ++ks) { const LAS unsigned char* s_ = lds + cur * 65536 + ks * 1024; bf16x8 Bf_[4];
#pragma unroll
                for (int n_ = 0; n_ < 4; ++n_) Bf_[n_] = *(const LAS bf16x8*)(s_ + T.b_r + n_ * 2048);
#pragma unroll
                for (int m_ = 0; m_ < 8; ++m_) if (m_ < mlim) { const bf16x8 At_ = *(const LAS bf16x8*)(s_ + T.a_r + m_ * 2048);
#pragma unroll
                    for (int n_ = 0; n_ < 4; ++n_) acc[m_][n_] = __builtin_amdgcn_mfma_f32_16x16x32_bf16(Bf_[n_], At_, acc[m_][n_], 0, 0, 0); } } }
        if (w1) { G_RETIRE(); G_WRITE_B(cur ^ 1); }
        if (i2) G_ISSUE_B(t + 2);
        G_BAR(); }
#undef G_DMA_A
#undef G_ISSUE_B
#undef G_RETIRE
#undef G_WRITE_B
}
__device__ __forceinline__ __amdgpu_buffer_rsrc_t mk_rsrc(const void* p) { return __builtin_amdgcn_make_buffer_rsrc((void*)p, 0, 0x7ffffff0, 0x00020000); }
__device__ __forceinline__ void acc_zero(f32x4 (&acc)[8][4]) {
#pragma unroll
    for (int m = 0; m < 8; ++m)
#pragma unroll
        for (int n = 0; n < 4; ++n) acc[m][n] = (f32x4){0.f, 0.f, 0.f, 0.f};
}
__device__ __forceinline__ f32x4 rot1(const f32x4 a) { return (f32x4){a[1], a[2], a[3], a[0]}; }
__device__ __forceinline__ f32x4 rotinv(const f32x4 a) { return (f32x4){a[3], a[0], a[1], a[2]}; }
__device__ __forceinline__ u32x4 pack8(const f32x4 a, const f32x4 b) { u32x4 w; w.x = cvtpk(a[0], a[1]); w.y = cvtpk(a[2], a[3]); w.z = cvtpk(b[0], b[1]); w.w = cvtpk(b[2], b[3]); return w; }
__device__ __forceinline__ int vwg_id() { const int G = gridDim.x; return (G % 8 == 0) ? (int)((blockIdx.x % 8) * (G / 8) + blockIdx.x / 8) : (int)blockIdx.x; }

__device__ __forceinline__ void phase_gemm1(const Ptrs& p, LAS unsigned char* lds) {
    const bf16_t* ha = (const bf16_t*)(p.ws + OFF_HA); bf16_t* pr = (bf16_t*)(p.ws + OFF_PROJ);
    for (int u = vwg_id(); u < 32 * 40; u += gridDim.x) {
        GemmT T; T.init();
        const int pm = (u >> 3) & 31, pn = (u & 7) + 8 * (u >> 8);
        const int row0 = pm * 256, pcol0 = pn * 256, wcol0 = pcol0 < C_GC ? pcol0 : pcol0 + (W_GC - C_GC);
        const unsigned ao = (unsigned)((T.aR * D + T.aC) * 2), bo = (unsigned)((T.b_k * NIN + T.b_col) * 4);
        f32x4 acc[8][4]; acc_zero(acc);
        gemm_kloop(acc, lds, T, mk_rsrc(ha + (size_t)row0 * D), ao, ao + 64u * D * 2, ao + 128u * D * 2, ao + 192u * D * 2, mk_rsrc(p.w_in + wcol0), bo, NIN * 4u, D / 64);
T.init_epi();
        const int mode = (pcol0 >= C_GC) ? 2 : ((pcol0 >= C_Q && pcol0 < C_K) ? 1 : 0);
#pragma unroll
        for (int m = 0; m < 8; ++m) { const int row = row0 + T.wr * 128 + m * 16 + T.fr;
#pragma unroll
            for (int pp = 0; pp < 2; ++pp) { f32x4 v0 = acc[m][2 * pp], v1 = rot1(acc[m][2 * pp + 1]);
                if (mode == 1) { v0 *= QSCALE; v1 *= QSCALE; }
                else if (mode == 2) {
#pragma unroll
                    for (int j = 0; j < 4; ++j) { v0[j] = sigmoidf_(v0[j]); v1[j] = sigmoidf_(v1[j]); } }
                *(u32x4*)(pr + (size_t)row * PLD + pcol0 + T.wc * 64 + pp * 32 + T.fq * 8) = pack8(v0, v1); } }
    }
}
__device__ __forceinline__ void phase_merge(const Ptrs& p, LAS unsigned char* lds) {
    const bf16_t* ua = (const bf16_t*)(p.ws + OFF_UA); const bf16_t* pr = (const bf16_t*)(p.ws + OFF_PROJ); bf16_t* mg = (bf16_t*)(p.ws + OFF_MRG);
    for (int u = vwg_id(); u < 32 * 8; u += gridDim.x) {
        GemmT T; T.init();
        const int pm = u >> 3, pn = u & 7, row0 = pm * 256, col0 = pn * 256;
        const unsigned ao = (unsigned)((T.aR * 2048 + T.aC) * 2), bo = (unsigned)((T.b_k * D + T.b_col) * 4);
        f32x4 acc[8][4]; acc_zero(acc);
#pragma unroll 1
        for (int seg = 0; seg < 2; ++seg) {
            gemm_kloop(acc, lds, T, mk_rsrc(ua + (size_t)row0 * 2048 + seg * 1024), ao, ao + 64u * 4096, ao + 128u * 4096, ao + 192u * 4096,
                       mk_rsrc((seg ? p.w_attn_out : p.w_conv_out) + col0), bo, D * 4u, 1024 / 64);
            T.init_epi();
            int rowb = row0 + T.wr * 128 + T.fr; asm volatile("" : "+v"(rowb));
#pragma unroll
            for (int m = 0; m < 8; ++m) { const int row = rowb + m * 16;
#pragma unroll
                for (int pp = 0; pp < 2; ++pp) { const int c = col0 + T.wc * 64 + pp * 32 + T.fq * 8; const size_t o = (size_t)row * PLD + c;
                    const u32x4 sa = *(const u32x4*)(pr + o + C_GA); u32x4 sc = sa; if (seg == 0) sc = *(const u32x4*)(pr + o + C_GC);
                    f32x4 v0 = acc[m][2 * pp], v1 = rot1(acc[m][2 * pp + 1]);
#pragma unroll
                    for (int j = 0; j < 2; ++j) {
                        const float a0 = bflo(sa[j]), a1 = bfhi(sa[j]), a2 = bflo(sa[2 + j]), a3 = bfhi(sa[2 + j]);
                        if (seg == 0) { v0[2 * j] *= bflo(sc[j]) * __builtin_amdgcn_rcpf(a0); v0[2 * j + 1] *= bfhi(sc[j]) * __builtin_amdgcn_rcpf(a1); v1[2 * j] *= bflo(sc[2 + j]) * __builtin_amdgcn_rcpf(a2); v1[2 * j + 1] *= bfhi(sc[2 + j]) * __builtin_amdgcn_rcpf(a3); }
                        else { v0[2 * j] *= a0; v0[2 * j + 1] *= a1; v1[2 * j] *= a2; v1[2 * j + 1] *= a3; } }
                    acc[m][2 * pp] = v0; acc[m][2 * pp + 1] = rotinv(v1);
                    if (seg == 1) *(u32x4*)(mg + (size_t)row * D + c) = pack8(v0, v1); }
                asm volatile("" ::: "memory"); }
        }
    }
}
__device__ __forceinline__ void phase_out(const Ptrs& p, LAS unsigned char* lds) {
    const bf16_t* mg = (const bf16_t*)(p.ws + OFF_MRG); float* x1 = (float*)(p.ws + OFF_X1); const float* mod = (const float*)(p.ws + OFF_MOD);
    for (int u = vwg_id(); u < 32 * 8; u += gridDim.x) {
        GemmT T; T.init();
        const int pm = u >> 3, pn = u & 7, row0 = pm * 256, col0 = pn * 256;
        const unsigned ao = (unsigned)((T.aR * D + T.aC) * 2), bo = (unsigned)((T.b_k * D + T.b_col) * 4);
        f32x4 acc[8][4]; acc_zero(acc);
        gemm_kloop(acc, lds, T, mk_rsrc(mg + (size_t)row0 * D), ao, ao + 64u * 4096, ao + 128u * 4096, ao + 192u * 4096, mk_rsrc(p.w_out + col0), bo, D * 4u, D / 64);
T.init_epi();
        const float* gm = mod + (size_t)(row0 / S) * NMOD + 2 * D;
#pragma unroll
        for (int m = 0; m < 8; ++m) { const int row = row0 + T.wr * 128 + m * 16 + T.fr;
#pragma unroll
            for (int pp = 0; pp < 2; ++pp) { const int c = col0 + T.wc * 64 + pp * 32 + T.fq * 8; const size_t o = (size_t)row * D + c;
                const f32x4 g0 = *(const f32x4*)(gm + c), g1 = *(const f32x4*)(gm + c + 4), x0 = *(const f32x4*)(p.x + o), x1v = *(const f32x4*)(p.x + o + 4);
                *(f32x4*)(x1 + o) = x0 + g0 * acc[m][2 * pp]; *(f32x4*)(x1 + o + 4) = x1v + g1 * rot1(acc[m][2 * pp + 1]); } }
    }
}
constexpr size_t OFF_GUTOT = OFF_CTRL + 1024;
constexpr size_t OFF_GUDONE = OFF_CTRL + 2048;
struct MoeUnit { int e, mt, nt, cnt, base, light; };
__device__ __forceinline__ bool moe_unit(int cv, int u, int ntiles_n, MoeUnit& mu) {
    int base = 0;
#pragma unroll
    for (int e = 0; e < E; ++e) { const int c = __builtin_amdgcn_readlane(cv, e), tm = (c + 255) >> 8, nu = tm * ntiles_n;
        if (u < nu) { mu.e = e; mu.cnt = c; mu.base = base; mu.nt = u / tm; mu.mt = u - mu.nt * tm; mu.light = (mu.mt == tm - 1 && c - mu.mt * 256 <= 128) ? 1 : 0; return true; }
        u -= nu; base += tm * 256; }
    return false;
}
__device__ __forceinline__ void phase_moe_gu(const Ptrs& p, LAS unsigned char* lds) {
    const int* counts = (const int*)(p.ws + OFF_CTRL); const bf16_t* h2 = (const bf16_t*)(p.ws + OFF_HA); bf16_t* act = (bf16_t*)(p.ws + OFF_ACT);
    const __amdgpu_buffer_rsrc_t ract = __builtin_amdgcn_make_buffer_rsrc((void*)act, 0, 0x7ffffff0, 0x00020000);
    MoeUnit mu; const int cv = counts[tid_opaque() & 31];
    for (int u = vwg_id(); moe_unit(cv, u, 16, mu); u += gridDim.x) {
        GemmT T; T.init();
        const int* list = (const int*)(p.ws + OFF_LIST) + (size_t)mu.e * NTOK; const int i0 = mu.mt * 256, n0 = mu.nt * 128;
        unsigned ao[4];
#pragma unroll
        for (int i = 0; i < 4; ++i) { const int r = i0 + T.aR + 64 * i; const int tok = (r < mu.cnt) ? (list[r] >> 2) : 0; ao[i] = (unsigned)((tok * D + T.aC) * 2); }
        const float* wsel = ((__builtin_amdgcn_readfirstlane(T.b_p) & 1) ? p.w_up : p.w_gate) + (size_t)mu.e * D * D + n0;
        const unsigned bo = (unsigned)((T.b_k * D + T.b_gucol) * 4);
        f32x4 acc[8][4]; acc_zero(acc);
        const int mlim = __builtin_amdgcn_readfirstlane(T.wr) ? 0 : ((mu.cnt - i0 + 15) >> 4);
        if (mu.light) gemm_kloop_light(acc, lds, T, mk_rsrc(h2), ao[0], ao[1], ao[2], ao[3], mk_rsrc(wsel), bo, D * 4u, D / 64, mlim);
        else gemm_kloop(acc, lds, T, mk_rsrc(h2), ao[0], ao[1], ao[2], ao[3], mk_rsrc(wsel), bo, D * 4u, D / 64);
T.init_epi();
        const int c = n0 + T.wc * 32 + T.fq * 8;
        const float* bg = p.b_gate + (size_t)mu.e * D + c; const float* bu = p.b_up + (size_t)mu.e * D + c;
        const f32x4 bg0 = *(const f32x4*)bg, bg1 = *(const f32x4*)(bg + 4), bu0 = *(const f32x4*)bu, bu1 = *(const f32x4*)(bu + 4);
#pragma unroll
        for (int m = 0; m < 8; ++m) { const int r = i0 + T.wr * 128 + m * 16 + T.fr;
            f32x4 g0 = acc[m][0] + bg0, g1 = rot1(acc[m][1]) + bg1, u0 = acc[m][2] + bu0, u1 = rot1(acc[m][3]) + bu1;
#pragma unroll
            for (int j = 0; j < 4; ++j) { float g = fminf(g0[j], 7.0f), uu = fminf(fmaxf(u0[j], -7.0f), 7.0f); g0[j] = (uu + 1.0f) * g * sigmoidf_(1.702f * g);
                g = fminf(g1[j], 7.0f); uu = fminf(fmaxf(u1[j], -7.0f), 7.0f); g1[j] = (uu + 1.0f) * g * sigmoidf_(1.702f * g); }
            if (r < mu.cnt) __builtin_amdgcn_raw_buffer_store_b128(pack8(g0, g1), ract, (unsigned)(((mu.base + r) * D + c) * 2), 0, 16); }
        asm volatile("s_waitcnt vmcnt(0)" ::: "memory");
        __syncthreads();
        if (threadIdx.x == 0) { __hip_atomic_fetch_add((unsigned*)(p.ws + OFF_GUDONE) + mu.e * 16, 1u, __ATOMIC_RELAXED, __HIP_MEMORY_SCOPE_AGENT);
                                __hip_atomic_fetch_add((unsigned*)(p.ws + OFF_GUTOT), 1u, __ATOMIC_RELAXED, __HIP_MEMORY_SCOPE_AGENT); }
    }
}
__device__ __forceinline__ void phase_moe_down(const Ptrs& p, LAS unsigned char* lds) {
    const int* counts = (const int*)(p.ws + OFF_CTRL); const bf16_t* act = (const bf16_t*)(p.ws + OFF_ACT); bf16_t* y = (bf16_t*)(p.ws + OFF_Y); const float* gate = (const float*)(p.ws + OFF_GATE);
    MoeUnit mu; const int cv = counts[tid_opaque() & 31];
    int Ttot = 0;
#pragma unroll
    for (int e = 0; e < E; ++e) Ttot += (__builtin_amdgcn_readlane(cv, e) + 255) >> 8;
    const int G = (int)gridDim.x, Ugu = Ttot * 16, u0 = ((vwg_id() - Ugu % G) % G + G) % G;
    LAS int* wslot = (LAS int*)(lds + GEMM_LDS + 4096);
    int all_done = 0;
    for (int u = u0; moe_unit(cv, u, 8, mu); u += G) {
        if (!all_done) {
            if (threadIdx.x == 0) {
                unsigned* tot = (unsigned*)(p.ws + OFF_GUTOT); unsigned* de = (unsigned*)(p.ws + OFF_GUDONE) + mu.e * 16;
                const unsigned need = (unsigned)(((mu.cnt + 255) >> 8) * 16); int all = 0;
                for (unsigned sp = 0; sp < (1u << 22); ++sp) {
                    if (__hip_atomic_load(tot, __ATOMIC_RELAXED, __HIP_MEMORY_SCOPE_AGENT) >= (unsigned)Ugu) { all = 1; break; }
                    if (__hip_atomic_load(de, __ATOMIC_RELAXED, __HIP_MEMORY_SCOPE_AGENT) >= need) break;
                    __builtin_amdgcn_s_sleep(8); }
                __builtin_amdgcn_fence(__ATOMIC_ACQUIRE, "agent");
                *wslot = all; }
            asm volatile("s_waitcnt vmcnt(0)" ::: "memory");
            __syncthreads();
            all_done = __builtin_amdgcn_readfirstlane(*wslot);
            __syncthreads(); }
        GemmT T; T.init();
        const int* list = (const int*)(p.ws + OFF_LIST) + (size_t)mu.e * NTOK; const int i0 = mu.mt * 256, col0 = mu.nt * 256;
        const unsigned ao = (unsigned)((T.aR * D + T.aC) * 2), bo = (unsigned)((T.b_k * D + T.b_col) * 4);
        int pa = -1; float pg = 0.f;
        { const int t_ = tid_opaque(); if (t_ < 256 && i0 + t_ < mu.cnt) { pa = list[i0 + t_]; pg = gate[pa]; } }
        f32x4 acc[8][4]; acc_zero(acc);
        const int mlim = __builtin_amdgcn_readfirstlane(T.wr) ? 0 : ((mu.cnt - i0 + 15) >> 4);
        if (mu.light) gemm_kloop_light(acc, lds, T, mk_rsrc(act + (size_t)(mu.base + i0) * D), ao, ao + 64u * 4096, ao + 128u * 4096, ao + 192u * 4096,
                                       mk_rsrc(p.w_down + (size_t)mu.e * D * D + col0), bo, D * 4u, D / 64, mlim);
        else gemm_kloop(acc, lds, T, mk_rsrc(act + (size_t)(mu.base + i0) * D), ao, ao + 64u * 4096, ao + 128u * 4096, ao + 192u * 4096,
                        mk_rsrc(p.w_down + (size_t)mu.e * D * D + col0), bo, D * 4u, D / 64);
T.init_epi();
        LAS int* tab = (LAS int*)(lds + GEMM_LDS);
        { const int t_ = tid_opaque(); if (t_ < 256) { tab[2 * t_] = pa; tab[2 * t_ + 1] = __float_as_int(pg); } }
        __syncthreads();
        const float* bd = p.b_down + (size_t)mu.e * D;
#pragma unroll
        for (int m = 0; m < 8; ++m) { const int rl = T.wr * 128 + m * 16 + T.fr, r = i0 + rl;
            if (r < mu.cnt) { const int a = tab[2 * rl]; const float gt = __int_as_float(tab[2 * rl + 1]);
#pragma unroll
                for (int pp = 0; pp < 2; ++pp) { const int c = col0 + T.wc * 64 + pp * 32 + T.fq * 8;
                    const f32x4 v0 = (acc[m][2 * pp] + *(const f32x4*)(bd + c)) * gt, v1 = (rot1(acc[m][2 * pp + 1]) + *(const f32x4*)(bd + c + 4)) * gt;
                    *(u32x4*)(y + (size_t)a * D + c) = pack8(v0, v1); } } }
        __syncthreads();
    }
}
extern __shared__ __attribute__((aligned(1024))) unsigned char dyn_lds[];
typedef float f32x16 __attribute__((ext_vector_type(16)));
typedef short v4i16_t __attribute__((ext_vector_type(4)));
__device__ __forceinline__ float xhalf_max(float v) { const auto rr = __builtin_amdgcn_permlane32_swap(__float_as_uint(v), __float_as_uint(v), false, false); return fmaxf(__uint_as_float(rr[0]), __uint_as_float(rr[1])); }
__device__ __forceinline__ float xhalf_sum(float v) { const auto rr = __builtin_amdgcn_permlane32_swap(__float_as_uint(v), __float_as_uint(v), false, false); return __uint_as_float(rr[0]) + __uint_as_float(rr[1]); }
template <int CTRL> __device__ __forceinline__ float dppf(float x) { return __builtin_bit_cast(float, __builtin_amdgcn_mov_dpp(__builtin_bit_cast(int, x), CTRL, 0xf, 0xf, true)); }
constexpr int DPP_XOR1 = 0xB1, DPP_XOR2 = 0x4E, DPP_XOR7 = 0x141, DPP_XOR8 = 0x128;
__device__ __forceinline__ float xrow_sum(float x) { const auto s = __builtin_amdgcn_permlane16_swap(__float_as_uint(x), __float_as_uint(x), false, false); x = __uint_as_float(s[0]) + __uint_as_float(s[1]); return xhalf_sum(x); }
__device__ __forceinline__ float xrow_max(float x) { const auto s = __builtin_amdgcn_permlane16_swap(__float_as_uint(x), __float_as_uint(x), false, false); x = fmaxf(__uint_as_float(s[0]), __uint_as_float(s[1])); return xhalf_max(x); }
__device__ __forceinline__ float wave_sum(float v) { v += dppf<DPP_XOR1>(v); v += dppf<DPP_XOR2>(v); v += dppf<DPP_XOR7>(v); v += dppf<DPP_XOR8>(v); return xrow_sum(v); }
__device__ __forceinline__ float wave_max(float v) { v = fmaxf(v, dppf<DPP_XOR1>(v)); v = fmaxf(v, dppf<DPP_XOR2>(v)); v = fmaxf(v, dppf<DPP_XOR7>(v)); v = fmaxf(v, dppf<DPP_XOR8>(v)); return xrow_max(v); }
__device__ __forceinline__ float reduce16(float (&v)[16], int lane) {
    float a[8], b[4], c[2];
#pragma unroll
    for (int i = 0; i < 8; ++i) { const auto r = __builtin_amdgcn_permlane32_swap(__float_as_uint(v[i]), __float_as_uint(v[i + 8]), false, false); a[i] = __uint_as_float(r[0]) + __uint_as_float(r[1]); }
#pragma unroll
    for (int i = 0; i < 4; ++i) { const auto r = __builtin_amdgcn_permlane16_swap(__float_as_uint(a[i]), __float_as_uint(a[i + 4]), false, false); b[i] = __uint_as_float(r[0]) + __uint_as_float(r[1]); }
#pragma unroll
    for (int i = 0; i < 2; ++i) { const float t1 = b[i] + dppf<DPP_XOR8>(b[i]), t2 = b[i + 2] + dppf<DPP_XOR8>(b[i + 2]); c[i] = (lane & 8) ? t2 : t1; }
    float d; { const float t1 = c[0] + dppf<DPP_XOR7>(c[0]), t2 = c[1] + dppf<DPP_XOR7>(c[1]); d = (lane & 4) ? t2 : t1; }
    d += dppf<DPP_XOR1>(d); d += dppf<DPP_XOR2>(d);
    return d;
}
constexpr int WT_LDS = 16 * 2048 * 4;
constexpr int AUX_LDS = 160 * 1024 - 64;

__device__ __forceinline__ void phase_mod(const Ptrs& p, LAS unsigned char* lds) {
    LAS float* sc = (LAS float*)lds;
    LAS float* red = (LAS float*)(lds + 16384);
    const int tid = tid_opaque();
    for (int i = tid; i < B * D; i += 512) { const float v = p.c[i]; sc[i] = v / (1.0f + __expf(-v)); }
    __syncthreads();
    float* mod = (float*)(p.ws + OFF_MOD);
    for (int ch = vwg_id(); ch < NMOD / 48; ch += gridDim.x) {
        const int cq = tid % 12, kg = tid / 12;
        if (kg < 42) {
            f32x4 a0 = {0.f, 0.f, 0.f, 0.f}, a1 = {0.f, 0.f, 0.f, 0.f};
            const float* wp = p.ada_w + (size_t)ch * 48 + cq * 4;
#pragma unroll 7
            for (int k = kg; k < D; k += 42) { const f32x4 w = *(const f32x4*)(wp + (size_t)k * NMOD); a0 += w * sc[k]; a1 += w * sc[D + k]; }
#pragma unroll
            for (int j = 0; j < 4; ++j) { red[kg * 96 + cq * 4 + j] = a0[j]; red[kg * 96 + 48 + cq * 4 + j] = a1[j]; }
        }
        __syncthreads();
        if (tid < 96) { float s = 0.f; for (int g = 0; g < 42; ++g) s += red[g * 96 + tid]; const int b = tid / 48, c = ch * 48 + tid % 48; mod[(size_t)b * NMOD + c] = s + p.ada_b[c]; }
        __syncthreads();
    }
}
__device__ __forceinline__ void stage_wt16(LAS float* wt, const float* w, size_t ldw) {
    const int tid = tid_opaque();
    for (int i = tid; i < 2048 * 4; i += 512) { const int k = i >> 2, q = i & 3; const f32x4 v = *(const f32x4*)(w + (size_t)k * ldw + q * 4);
#pragma unroll
        for (int j = 0; j < 4; ++j) wt[(q * 4 + j) * 2048 + k] = v[j]; }
}
constexpr int N1_PITCH = 2048 * 2 + 16;
constexpr int N1_WT = 0, N1_HS = 16 * N1_PITCH, N1_GS = 2 * 16 * N1_PITCH, N1_PS = N1_GS + 16384, N1_END = N1_PS + 8 * 256 * 4;
__device__ __forceinline__ void phase_norm1(const Ptrs& p, LAS unsigned char* lds) {
    LAS float* gs = (LAS float*)(lds + N1_GS); LAS float* sh = gs + 2048; LAS float* ps = (LAS float*)(lds + N1_PS);
    const int tid = tid_opaque(), lane = tid & 63, wid = tid >> 6;
    for (int i = tid; i < 1024 * 4; i += 512) { const int kp = i >> 2, q = i & 3; const float* w = p.w_in + (size_t)(2 * kp) * NIN + W_F + q * 4;
        const f32x4 v0 = *(const f32x4*)w, v1 = *(const f32x4*)(w + NIN);
#pragma unroll
        for (int j = 0; j < 4; ++j) *(LAS unsigned*)(lds + N1_WT + (q * 4 + j) * N1_PITCH + kp * 4) = cvtpk(v0[j], v1[j]); }
    bf16_t* ha = (bf16_t*)(p.ws + OFF_HA); float* logf = (float*)(p.ws + OFF_LOGF);
    for (int blk = vwg_id(); blk < NTOK / 32; blk += gridDim.x) {
        const int b = (blk * 32) / S; const float* mod = (const float*)(p.ws + OFF_MOD) + (size_t)b * NMOD;
        __syncthreads();
        for (int i = tid; i < 2048; i += 512) { gs[i] = p.norm_mix_g[i] * (1.0f + mod[D + i]); sh[i] = mod[i]; }
        __syncthreads();
#pragma unroll 1
        for (int half = 0; half < 2; ++half) {
#pragma unroll 1
            for (int rr = 0; rr < 2; ++rr) {
                const int r16 = wid * 2 + rr, row = blk * 32 + half * 16 + r16; const float* xr = p.x + (size_t)row * D;
                f32x4 v[8]; float ss = 0.f;
#pragma unroll
                for (int c = 0; c < 8; ++c) { v[c] = *(const f32x4*)(xr + c * 256 + lane * 4); ss += v[c][0] * v[c][0] + v[c][1] * v[c][1] + v[c][2] * v[c][2] + v[c][3] * v[c][3]; }
                ss = wave_sum(ss); const float r = rsqrtf(ss * (1.0f / D) + EPS);
#pragma unroll
                for (int c = 0; c < 8; ++c) { const int k = c * 256 + lane * 4; const f32x4 g4 = *(const LAS f32x4*)(gs + k), s4 = *(const LAS f32x4*)(sh + k);
                    const f32x4 h4 = (v[c] * r) * g4 + s4; u32x2 w; w.x = cvtpk(h4[0], h4[1]); w.y = cvtpk(h4[2], h4[3]);
                    *(u32x2*)(ha + (size_t)row * D + k) = w; *(LAS u32x2*)(lds + N1_HS + r16 * N1_PITCH + k * 2) = w; }
            }
            __syncthreads();
            {
                f32x4 acc = {0.f, 0.f, 0.f, 0.f};
                const LAS unsigned char* ap = lds + N1_HS + (lane & 15) * N1_PITCH + wid * 512 + (lane >> 4) * 16;
                const LAS unsigned char* bp = lds + N1_WT + (lane & 15) * N1_PITCH + wid * 512 + (lane >> 4) * 16;
#pragma unroll
                for (int ks = 0; ks < 8; ++ks) acc = __builtin_amdgcn_mfma_f32_16x16x32_bf16(*(const LAS bf16x8*)(ap + ks * 64), *(const LAS bf16x8*)(bp + ks * 64), acc, 0, 0, 0);
#pragma unroll
                for (int i = 0; i < 4; ++i) ps[wid * 256 + (4 * (lane >> 4) + i) * 16 + (lane & 15)] = acc[i];
            }
            __syncthreads();
            if (tid < 256) { float z = p.b_forget[tid & 15];
#pragma unroll
                for (int w = 0; w < 8; ++w) z += ps[w * 256 + tid];
                const int row = blk * 32 + half * 16 + (tid >> 4);
                logf[((size_t)b * H + (tid & 15)) * S + (row % S)] = fminf(z, 0.f) - log1pf(__expf(-fabsf(z))); }
        }
    }
}
__device__ __forceinline__ void phase_scan_conv(const Ptrs& p, LAS unsigned char* lds) {
    const int tid = tid_opaque(), lane = tid & 63, wid = tid >> 6; LAS float* wtot = (LAS float*)lds;
    for (int sq = vwg_id(); sq < B * H; sq += gridDim.x) {
        const float* lf = (const float*)(p.ws + OFF_LOGF) + (size_t)sq * S; float* fc = (float*)(p.ws + OFF_FCUM) + (size_t)sq * S;
        f32x4 a = *(const f32x4*)(lf + tid * 8), b4 = *(const f32x4*)(lf + tid * 8 + 4);
        a[1] += a[0]; a[2] += a[1]; a[3] += a[2]; b4[0] += a[3]; b4[1] += b4[0]; b4[2] += b4[1]; b4[3] += b4[2];
        const float tot = b4[3]; float inc = tot;
#pragma unroll
        for (int o = 1; o < 64; o <<= 1) { const float n = __shfl_up(inc, o); if (lane >= o) inc += n; }
        __syncthreads();
        if (lane == 63) wtot[wid] = inc;
        __syncthreads();
        float off = inc - tot; for (int w = 0; w < wid; ++w) off += wtot[w];
        *(f32x4*)(fc + tid * 8) = (a + off) * -LOG2E; *(f32x4*)(fc + tid * 8 + 4) = (b4 + off) * -LOG2E;
    }
    const bf16_t* pr = (const bf16_t*)(p.ws + OFF_PROJ); bf16_t* ua = (bf16_t*)(p.ws + OFF_UA);
    for (int item = vwg_id() * 512 + tid; item < (NTOK / 8) * (DC / 8); item += gridDim.x * 512) {
        const int cg = item & 127, rc = item >> 7, r0 = rc * 8, c = cg * 8;
        float w0[8], w1[8], w2[8], pm2[8], pm1[8];
#pragma unroll
        for (int j = 0; j < 8; ++j) { w0[j] = p.conv_w[c + j]; w1[j] = p.conv_w[DC + c + j]; w2[j] = p.conv_w[2 * DC + c + j]; pm2[j] = 0.f; pm1[j] = 0.f; }
        if ((r0 % S) != 0) {
#pragma unroll
            for (int d = 0; d < 2; ++d) { const bf16_t* q = pr + (size_t)(r0 - 2 + d) * PLD; const u32x4 xc = *(const u32x4*)(q + C_XC + c), cc = *(const u32x4*)(q + C_CC + c);
#pragma unroll
                for (int j = 0; j < 4; ++j) { const float e0 = bflo(xc[j]) * bflo(cc[j]), e1 = bfhi(xc[j]) * bfhi(cc[j]); if (d == 0) { pm2[2 * j] = e0; pm2[2 * j + 1] = e1; } else { pm1[2 * j] = e0; pm1[2 * j + 1] = e1; } } }
        }
#pragma unroll
        for (int i = 0; i < 8; ++i) { const bf16_t* q = pr + (size_t)(r0 + i) * PLD; const u32x4 xc = *(const u32x4*)(q + C_XC + c), cc = *(const u32x4*)(q + C_CC + c), cb = *(const u32x4*)(q + C_CB + c);
            float o[8];
#pragma unroll
            for (int j = 0; j < 4; ++j) { const float e0 = bflo(xc[j]) * bflo(cc[j]), e1 = bfhi(xc[j]) * bfhi(cc[j]);
                o[2 * j] = bflo(cb[j]) * (w0[2 * j] * pm2[2 * j] + w1[2 * j] * pm1[2 * j] + w2[2 * j] * e0); o[2 * j + 1] = bfhi(cb[j]) * (w0[2 * j + 1] * pm2[2 * j + 1] + w1[2 * j + 1] * pm1[2 * j + 1] + w2[2 * j + 1] * e1);
                pm2[2 * j] = pm1[2 * j]; pm2[2 * j + 1] = pm1[2 * j + 1]; pm1[2 * j] = e0; pm1[2 * j + 1] = e1; }
            u32x4 w; w.x = cvtpk(o[0], o[1]); w.y = cvtpk(o[2], o[3]); w.z = cvtpk(o[4], o[5]); w.w = cvtpk(o[6], o[7]);
            *(u32x4*)(ua + (size_t)(r0 + i) * 2048 + c) = w; }
    }
}
typedef short s16x4 __attribute__((ext_vector_type(4)));
constexpr int A_SLOTB = 8192, A_LDS_K = 0, A_LDS_V = 3 * A_SLOTB, A_LDS_WS = 6 * A_SLOTB, A_LDS_OST = A_LDS_WS + 8 * 256, A_LDS_F = A_LDS_OST + 8 * 4096, ATT_LDS = A_LDS_F + S * 4;
#define A_THR 32.0f
#define A_SBAR() __builtin_amdgcn_sched_barrier(0)
#define A_PIN(x) asm volatile("" : "+v"(x))
#define A_MFMA(a, b, c) __builtin_amdgcn_mfma_f32_32x32x16_bf16(a, b, c, 0, 0, 0)
#define A_WAIT_BAR(N) asm volatile("s_waitcnt vmcnt(" #N ") lgkmcnt(0)\n\ts_barrier" ::: "memory")
__device__ __forceinline__ int crow(int r, int hi) { return (r & 3) + 8 * (r >> 2) + 4 * hi; }
__device__ __forceinline__ unsigned a_cvtpk(float lo, float hi) { unsigned r; asm("v_cvt_pk_bf16_f32 %0, %1, %2" : "=v"(r) : "v"(lo), "v"(hi)); return r; }
__device__ __forceinline__ void a_glds16(const void* g, unsigned lds_base) {
    unsigned sv; asm volatile("s_mov_b32 %0, m0\n\ts_mov_b32 m0, %2\n\ts_nop 0\n\tglobal_load_lds_dwordx4 %1, off\n\ts_mov_b32 m0, %0" : "=&s"(sv) : "v"(g), "s"(lds_base) : "memory"); }
typedef __attribute__((address_space(3))) const char* a_lds_cptr;
__device__ __forceinline__ void a_kload2(bf16x8* kf, a_lds_cptr kp, int d0) { kf[2 * d0] = *(const __attribute__((address_space(3))) bf16x8*)(kp + d0 * 2048); kf[2 * d0 + 1] = *(const __attribute__((address_space(3))) bf16x8*)(kp + d0 * 2048 + 512); }
__device__ __forceinline__ s16x4 a_vtr(a_lds_cptr p) { return __builtin_bit_cast(s16x4, __builtin_amdgcn_ds_read_tr16_b64_v4i16((__attribute__((address_space(3))) v4i16_t*)p)); }
#define A_MX3(a, b, c) __builtin_fmaxf(__builtin_fmaxf((a), (b)), (c))
__device__ __forceinline__ float a_rowmax(const f32x16& p0, const f32x16& p1) {
    float a = A_MX3(p0[0], p0[1], p1[0]), b = A_MX3(p0[2], p0[3], p1[1]); a = A_MX3(a, p1[2], p1[3]);
#pragma unroll
    for (int r = 4; r < 16; r += 4) { a = A_MX3(a, p0[r], p0[r + 1]); b = A_MX3(b, p0[r + 2], p0[r + 3]); a = A_MX3(a, p1[r], p1[r + 1]); b = A_MX3(b, p1[r + 2], p1[r + 3]); }
    float m = __builtin_fmaxf(a, b); auto rr = __builtin_amdgcn_permlane32_swap(__float_as_uint(m), __float_as_uint(m), false, false);
    return __builtin_fmaxf(__uint_as_float(rr[0]), __uint_as_float(rr[1])); }
__device__ __forceinline__ void a_cmask(f32x16& p0, f32x16& p1, int jb, int qrel, int hi) {
    const int kb = 64 * jb + 4 * hi;
#pragma unroll
    for (int r = 0; r < 16; ++r) { const int kv = kb + (r & 3) + 8 * (r >> 2); if (kv > qrel) p0[r] = -INFINITY; if (kv + 32 > qrel) p1[r] = -INFINITY; } }
#define A_FLD(X0, X1, fp_) do { _Pragma("unroll") for (int g_ = 0; g_ < 4; ++g_) { const f32x4 fa_ = *(const __attribute__((address_space(3))) f32x4*)((fp_) + g_ * 32), fb_ = *(const __attribute__((address_space(3))) f32x4*)((fp_) + 128 + g_ * 32); \
        _Pragma("unroll") for (int i_ = 0; i_ < 4; ++i_) { X0[4 * g_ + i_] = fa_[i_]; X1[4 * g_ + i_] = fb_[i_]; } } } while (0)
#define A_FRD2(G, X, fp_, g_) do { if (G) { const f32x4 fa_ = *(const __attribute__((address_space(3))) f32x4*)((fp_) + (g_) * 32), fb_ = *(const __attribute__((address_space(3))) f32x4*)((fp_) + (g_) * 32 + 32); \
        _Pragma("unroll") for (int i_ = 0; i_ < 4; ++i_) { X[4 * (g_) + i_] = fa_[i_]; X[4 * (g_) + 4 + i_] = fb_[i_]; } A_SBAR(); } } while (0)

__device__ __forceinline__ void attn64_unit(int b, int h, int qb, const bf16_t* Q, const bf16_t* __restrict__ K, const bf16_t* __restrict__ V, bf16_t* O, const float* __restrict__ nf, char* lds) {
    const int tid = tid_opaque(), lane = tid & 63, r32 = lane & 31, hi = lane >> 5; const int wid = __builtin_amdgcn_readfirstlane(tid >> 6);
    const long rowbase = (long)b * S; const int q0 = qb * 256, NT = (q0 + 256) / 64;
    const bf16_t* Qw = Q + (rowbase + q0 + wid * 32) * PLD + h * 64;
    const unsigned lds0 = (unsigned)(size_t)lds; float* wsf = (float*)(lds + A_LDS_WS) + wid * 64;
    const bf16_t* ksrc = K + rowbase * PLD + h * 64 + (long)lane * PLD + wid * 8;
    const bf16_t* vsrc = V + rowbase * PLD + h * 64 + (long)(16 * (wid & 3) + (lane >> 2)) * PLD + (wid >> 2) * 32 + (lane & 3) * 8;
    const unsigned kdst = lds0 + A_LDS_K + wid * 1024, vdst = lds0 + A_LDS_V + wid * 1024;
#define DMA_K(t, slot) a_glds16(ksrc + (long)(t) * 64 * PLD, (unsigned)__builtin_amdgcn_readfirstlane(kdst + (slot)))
#define DMA_V(t, slot) a_glds16(vsrc + (long)(t) * 64 * PLD, (unsigned)__builtin_amdgcn_readfirstlane(vdst + (slot)))
    const a_lds_cptr vp0 = (a_lds_cptr)lds + A_LDS_V + ((lane >> 4) & 1) * 32 + (lane & 3) * 8 + (4 * hi + ((lane & 15) >> 2)) * 64;
    const a_lds_cptr kp0 = (a_lds_cptr)lds + A_LDS_K + hi * 1024 + r32 * 16;
    const a_lds_cptr fp0 = (a_lds_cptr)lds + A_LDS_F + hi * 16;
    a_glds16(nf + 512 * wid + 4 * lane, (unsigned)__builtin_amdgcn_readfirstlane(lds0 + A_LDS_F + wid * 2048));
    a_glds16(nf + 512 * wid + 256 + 4 * lane, (unsigned)__builtin_amdgcn_readfirstlane(lds0 + A_LDS_F + wid * 2048 + 1024));
    DMA_K(0, 0); DMA_V(0, 0); DMA_K(1, A_SLOTB);
    bf16x8 qr[4];
#pragma unroll
    for (int d0 = 0; d0 < 4; ++d0) qr[d0] = *reinterpret_cast<const bf16x8*>(&Qw[(long)r32 * PLD + d0 * 16 + hi * 8]);
    float mhat = 0.f, l_reg = 0.f; f32x16 o[2];
#pragma unroll
    for (int r = 0; r < 16; ++r) { o[0][r] = 0.f; o[1][r] = 0.f; }
    const int qrel = wid * 32 + r32; bool resc = false;
    f32x16 pA0, pA1, pB0, pB1; bf16x8 kf[8]; s16x4 vlo[8], vhi[8]; u32x4 pw0, pw1, pw2, pw3;
    int sl_prev = 0, sl_cur = 0, sl_next = A_SLOTB;
#define ROT() do { sl_prev = sl_cur; sl_cur = sl_next; sl_next = (sl_next == 2 * A_SLOTB) ? 0 : sl_next + A_SLOTB; } while (0)
#define EX(v) __builtin_amdgcn_exp2f((v) + nmh)
#define RESC() do { if (resc) { _Pragma("unroll") for (int d_ = 0; d_ < 2; ++d_) _Pragma("unroll") for (int r = 0; r < 16; ++r) o[d_][r] *= wsf[crow(r, hi)]; } } while (0)
    DMA_K(2, 2 * A_SLOTB);
    A_WAIT_BAR(0);
    _Pragma("unroll") for (int d0 = 0; d0 < 4; ++d0) a_kload2(kf, kp0, d0);
    A_FLD(pA0, pA1, fp0);
    pA0 = A_MFMA(kf[0], qr[0], pA0); pA1 = A_MFMA(kf[1], qr[0], pA1); pA0 = A_MFMA(kf[2], qr[1], pA0); pA1 = A_MFMA(kf[3], qr[1], pA1);
    pA0 = A_MFMA(kf[4], qr[2], pA0); pA1 = A_MFMA(kf[5], qr[2], pA1); pA0 = A_MFMA(kf[6], qr[3], pA0); pA1 = A_MFMA(kf[7], qr[3], pA1);
    if (NT == 4) a_cmask(pA0, pA1, 0, qrel, hi);
    { const float rm = a_rowmax(pA0, pA1); mhat = rm; const float nmh = -mhat;
#pragma unroll
      for (int r = 0; r < 16; ++r) { pA0[r] = EX(pA0[r]); pA1[r] = EX(pA1[r]); } }
    A_FLD(pB0, pB1, fp0 + 256);
    A_WAIT_BAR(0);
    DMA_K(3, 0); DMA_V(1, A_SLOTB); ROT();
    _Pragma("unroll") for (int d0 = 0; d0 < 4; ++d0) a_kload2(kf, kp0 + sl_cur, d0);
    A_WAIT_BAR(2);
#define PKW(P, i) a_cvtpk(P[i], P[i + 1])
#define PAF(k) __builtin_bit_cast(bf16x8, pw##k)
#define VFR(i) (bf16x8){vlo[i][0], vlo[i][1], vlo[i][2], vlo[i][3], vhi[i][0], vhi[i][1], vhi[i][2], vhi[i][3]}
#define VRD(i) do { vlo[i] = a_vtr(vp_ + (((i) >> 2) * 4096 + ((i) & 3) * 1024)); vhi[i] = a_vtr(vp_ + (((i) >> 2) * 4096 + ((i) & 3) * 1024 + 512)); } while (0)
#define KRD(G, d0) do { if (G) { a_kload2(kf, kp0 + sl_next, d0); A_SBAR(); } } while (0)
#define GAPA(MF, a0, a1, a2, a3, W0, W1, PW) do { MF; sacc += a0; sacc += a1; sacc += a2; sacc += a3; W0; W1; A_PIN(PW); A_PIN(sacc); A_SBAR(); } while (0)
#define GAPB(MF, X, i) do { MF; X[i] = EX(X[i]); X[i + 1] = EX(X[i + 1]); X[i + 2] = EX(X[i + 2]); X[i + 3] = EX(X[i + 3]); A_PIN(X); A_SBAR(); } while (0)
#define STEP(C0, C1, P0, P1, t, MASK, GK, GV, GL) do { A_SBAR(); \
    const a_lds_cptr vp_ = vp0 + sl_prev; const a_lds_cptr fn_ = fp0 + ((t) + 1) * 256; \
    VRD(0); A_SBAR(); float sacc = P0[0] + P0[1]; \
                    GAPA(C0 = A_MFMA(kf[0], qr[0], C0), P0[2], P0[3], P0[4], P0[5],     pw0[0] = PKW(P0, 0),  pw0[1] = PKW(P0, 2),  pw0); \
    VRD(4); A_SBAR(); GAPA(C1 = A_MFMA(kf[1], qr[0], C1), P0[6], P0[7], P0[8], P0[9],     pw0[2] = PKW(P0, 4),  pw0[3] = PKW(P0, 6),  pw0); \
    VRD(1); A_SBAR(); GAPA(C0 = A_MFMA(kf[2], qr[1], C0),    P0[10], P0[11], P0[12], P0[13], pw1[0] = PKW(P0, 8),  pw1[1] = PKW(P0, 10), pw1); \
    VRD(5); A_SBAR(); GAPA(C1 = A_MFMA(kf[3], qr[1], C1),    P0[14], P0[15], P1[0], P1[1],   pw1[2] = PKW(P0, 12), pw1[3] = PKW(P0, 14), pw1); \
    VRD(2); A_SBAR(); GAPA(C0 = A_MFMA(kf[4], qr[2], C0),    P1[2], P1[3], P1[4], P1[5],     pw2[0] = PKW(P1, 0),  pw2[1] = PKW(P1, 2),  pw2); \
    VRD(6); A_SBAR(); GAPA(C1 = A_MFMA(kf[5], qr[2], C1),    P1[6], P1[7], P1[8], P1[9],     pw2[2] = PKW(P1, 4),  pw2[3] = PKW(P1, 6),  pw2); \
    VRD(3); A_SBAR(); GAPA(C0 = A_MFMA(kf[6], qr[3], C0),    P1[10], P1[11], P1[12], P1[13], pw3[0] = PKW(P1, 8),  pw3[1] = PKW(P1, 10), pw3); \
    VRD(7); A_SBAR(); GAPA(C1 = A_MFMA(kf[7], qr[3], C1),    P1[14], P1[15], 0.f, 0.f,       pw3[2] = PKW(P1, 12), pw3[3] = PKW(P1, 14), pw3); \
    l_reg += sacc; \
    if (GK) DMA_K((t) + 3, sl_cur); if (GV) DMA_V((t) + 1, sl_next); \
    if (MASK) a_cmask(C0, C1, (t) - (NT - 4), qrel, hi); \
    { const float rm = a_rowmax(C0, C1) - mhat; resc = false; \
      if (__builtin_expect(__any(rm > A_THR), 0)) { const float dl = __builtin_fmaxf(rm, 0.f); mhat += dl; \
          const float f = __builtin_amdgcn_exp2f(-dl); l_reg *= f; if (hi == 0) wsf[r32] = f; resc = true; } } \
    const float nmh = -mhat; A_SBAR(); \
    A_FRD2(GL, P0, fn_, 0); GAPB(o[0] = A_MFMA(PAF(0), VFR(0), o[0]), C0, 0);  A_FRD2(GL, P0, fn_, 2); GAPB(o[1] = A_MFMA(PAF(0), VFR(4), o[1]), C0, 4); \
    KRD(GL, 0); GAPB(o[0] = A_MFMA(PAF(1), VFR(1), o[0]), C0, 8);  KRD(GL, 1); GAPB(o[1] = A_MFMA(PAF(1), VFR(5), o[1]), C0, 12); \
    KRD(GL, 2); GAPB(o[0] = A_MFMA(PAF(2), VFR(2), o[0]), C1, 0);  KRD(GL, 3); GAPB(o[1] = A_MFMA(PAF(2), VFR(6), o[1]), C1, 4); \
    A_FRD2(GL, P1, fn_ + 128, 0); GAPB(o[0] = A_MFMA(PAF(3), VFR(3), o[0]), C1, 8);  A_FRD2(GL, P1, fn_ + 128, 2); GAPB(o[1] = A_MFMA(PAF(3), VFR(7), o[1]), C1, 12); \
    } while (0)
    int t = 1;
    for (; t + 5 < NT; t += 2) {
        STEP(pB0, pB1, pA0, pA1, t, false, true, true, true);     A_WAIT_BAR(2); RESC(); ROT();
        STEP(pA0, pA1, pB0, pB1, t + 1, false, true, true, true); A_WAIT_BAR(2); RESC(); ROT();
    }
#define ENDW(tt) do { if ((tt) + 3 < NT) { A_WAIT_BAR(2); } else if ((tt) + 2 < NT) { A_WAIT_BAR(1); } else { A_WAIT_BAR(0); } } while (0)
    for (; t + 1 < NT; t += 2) {
        STEP(pB0, pB1, pA0, pA1, t, true, (t + 3 < NT), (t + 1 < NT), (t + 1 < NT));         ENDW(t);     RESC(); ROT();
        STEP(pA0, pA1, pB0, pB1, t + 1, true, (t + 4 < NT), (t + 2 < NT), (t + 2 < NT));     ENDW(t + 1); RESC(); ROT();
    }
    STEP(pB0, pB1, pA0, pA1, NT - 1, true, false, false, false); RESC();
    { float sacc = pB0[0] + pB0[1];
#pragma unroll
      for (int r = 2; r < 16; ++r) sacc += pB0[r];
#pragma unroll
      for (int r = 0; r < 16; ++r) sacc += pB1[r];
      l_reg += sacc;
      pw0 = (u32x4){PKW(pB0, 0), PKW(pB0, 2), PKW(pB0, 4), PKW(pB0, 6)}; pw1 = (u32x4){PKW(pB0, 8), PKW(pB0, 10), PKW(pB0, 12), PKW(pB0, 14)};
      pw2 = (u32x4){PKW(pB1, 0), PKW(pB1, 2), PKW(pB1, 4), PKW(pB1, 6)}; pw3 = (u32x4){PKW(pB1, 8), PKW(pB1, 10), PKW(pB1, 12), PKW(pB1, 14)};
      const a_lds_cptr vp_ = vp0 + sl_cur; _Pragma("unroll") for (int i = 0; i < 8; ++i) VRD(i);
      o[0] = A_MFMA(PAF(0), VFR(0), o[0]); o[1] = A_MFMA(PAF(0), VFR(4), o[1]); o[0] = A_MFMA(PAF(1), VFR(1), o[0]); o[1] = A_MFMA(PAF(1), VFR(5), o[1]);
      o[0] = A_MFMA(PAF(2), VFR(2), o[0]); o[1] = A_MFMA(PAF(2), VFR(6), o[1]); o[0] = A_MFMA(PAF(3), VFR(3), o[0]); o[1] = A_MFMA(PAF(3), VFR(7), o[1]); }
    { auto rr = __builtin_amdgcn_permlane32_swap(__float_as_uint(l_reg), __float_as_uint(l_reg), false, false); l_reg = __uint_as_float(rr[0]) + __uint_as_float(rr[1]); }
    if (hi == 0) wsf[32 + r32] = l_reg; asm volatile("s_waitcnt lgkmcnt(0)" ::: "memory");
    float rli[16];
#pragma unroll
    for (int r = 0; r < 16; ++r) rli[r] = __builtin_amdgcn_rcpf(wsf[32 + crow(r, hi)]);
    bf16_t* Ow = O + (rowbase + q0 + wid * 32) * 2048 + h * 64; bf16_t* stg = (bf16_t*)(lds + A_LDS_OST) + wid * 2048;
#pragma unroll
    for (int r = 0; r < 16; ++r) { const int orow = crow(r, hi);
#pragma unroll
        for (int d0 = 0; d0 < 2; ++d0) stg[orow * 64 + d0 * 32 + r32] = (bf16_t)(a_cvtpk(o[d0][r] * rli[r], 0.f) & 0xffffu); }
    asm volatile("s_waitcnt lgkmcnt(0)" ::: "memory");
#pragma unroll
    for (int i = 0; i < 4; ++i) { const int row = i * 8 + (lane >> 3), ch = lane & 7; *(u32x4*)(Ow + (long)row * 2048 + ch * 8) = *(const u32x4*)(stg + row * 64 + ch * 8); }
    asm volatile("s_waitcnt lgkmcnt(0)\n\ts_barrier" ::: "memory");
#undef DMA_K
#undef DMA_V
#undef ROT
#undef EX
#undef RESC
#undef PKW
#undef PAF
#undef VFR
#undef VRD
#undef KRD
#undef ENDW
#undef GAPA
#undef GAPB
#undef STEP
}
__device__ __forceinline__ void phase_attn(const Ptrs& p, LAS unsigned char* lds) {
    const bf16_t* pr = (const bf16_t*)(p.ws + OFF_PROJ); bf16_t* ua = (bf16_t*)(p.ws + OFF_UA);
    for (int pi = vwg_id(); pi < 256; pi += gridDim.x) {
        const int s_ = pi & 7, bh = pi >> 3; const float* nf = (const float*)(p.ws + OFF_FCUM) + (size_t)bh * S;
#pragma unroll 1
        for (int half = 0; half < 2; ++half)
            attn64_unit(bh >> 4, bh & 15, half ? 15 - s_ : s_, pr + C_Q, pr + C_K, pr + C_V, ua + 1024, nf, (char*)lds);
    }
}
constexpr int R_PITCH = 512 * 2 + 16, R_WHI = 0, R_WLO = 32 * R_PITCH, R_HHI = 64 * R_PITCH, R_HLO = 96 * R_PITCH, R_GS = 128 * R_PITCH, R_LG = R_GS + 16384, R_TAB = R_LG + 4096, R_END = R_TAB + 2048;
__device__ __forceinline__ void phase_norm2_route(const Ptrs& p, LAS unsigned char* lds) {
    LAS float* gs = (LAS float*)(lds + R_GS); LAS float* sh = gs + 2048; LAS float* lg = (LAS float*)(lds + R_LG); LAS float* ps = (LAS float*)lds;
    const int tid = tid_opaque(), lane = tid & 63, wid = tid >> 6;
    bf16_t* ha = (bf16_t*)(p.ws + OFF_HA); const float* x1 = (const float*)(p.ws + OFF_X1);
    int* counts = (int*)(p.ws + OFF_CTRL); int* list = (int*)(p.ws + OFF_LIST); float* gate = (float*)(p.ws + OFF_GATE);
    for (int blk = vwg_id(); blk < NTOK / 32; blk += gridDim.x) {
        const int b = (blk * 32) / S; const float* mod = (const float*)(p.ws + OFF_MOD) + (size_t)b * NMOD;
        __syncthreads();
        for (int i = tid; i < 2048; i += 512) { gs[i] = p.norm_ffn_g[i] * (1.0f + mod[4 * D + i]); sh[i] = mod[3 * D + i]; }
        __syncthreads();
#pragma unroll 1
        for (int half = 0; half < 2; ++half) {
            f32x4 v[2][8];
#pragma unroll
            for (int q = 0; q < 2; ++q) { const int row = blk * 32 + half * 16 + wid * 2 + q; const float* xr = x1 + (size_t)row * D; float ss = 0.f;
#pragma unroll
                for (int c = 0; c < 8; ++c) { v[q][c] = *(const f32x4*)(xr + c * 256 + lane * 4); ss += v[q][c][0] * v[q][c][0] + v[q][c][1] * v[q][c][1] + v[q][c][2] * v[q][c][2] + v[q][c][3] * v[q][c][3]; }
                ss = wave_sum(ss); const float r = rsqrtf(ss * (1.0f / D) + EPS);
#pragma unroll
                for (int c = 0; c < 8; ++c) { const int k = c * 256 + lane * 4; const f32x4 g4 = *(const LAS f32x4*)(gs + k), s4 = *(const LAS f32x4*)(sh + k);
                    v[q][c] = (v[q][c] * r) * g4 + s4; u32x2 w; w.x = cvtpk(v[q][c][0], v[q][c][1]); w.y = cvtpk(v[q][c][2], v[q][c][3]); *(u32x2*)(ha + (size_t)row * D + k) = w; } }
            f32x4 acc[2];
            acc[0] = (f32x4){0.f, 0.f, 0.f, 0.f}; acc[1] = (f32x4){0.f, 0.f, 0.f, 0.f};
#pragma unroll
            for (int ch = 0; ch < 4; ++ch) {
                __syncthreads();
                for (int i = tid; i < 2048; i += 512) { const int kp = i >> 3, cq = i & 7; const float* w = p.router_w + (size_t)(512 * ch + 2 * kp) * E + cq * 4;
                    const f32x4 w0 = *(const f32x4*)w, w1 = *(const f32x4*)(w + E);
#pragma unroll
                    for (int j = 0; j < 4; ++j) { const unsigned hi = cvtpk(w0[j], w1[j]), lo = cvtpk(w0[j] - bflo(hi), w1[j] - bfhi(hi));
                        *(LAS unsigned*)(lds + R_WHI + (cq * 4 + j) * R_PITCH + kp * 4) = hi; *(LAS unsigned*)(lds + R_WLO + (cq * 4 + j) * R_PITCH + kp * 4) = lo; } }
#pragma unroll
                for (int q = 0; q < 2; ++q)
#pragma unroll
                    for (int cc = 0; cc < 2; ++cc) { const f32x4 h4 = v[q][2 * ch + cc]; u32x2 hi, lo; hi.x = cvtpk(h4[0], h4[1]); hi.y = cvtpk(h4[2], h4[3]);
                        lo.x = cvtpk(h4[0] - bflo(hi.x), h4[1] - bfhi(hi.x)); lo.y = cvtpk(h4[2] - bflo(hi.y), h4[3] - bfhi(hi.y));
                        const int o = (wid * 2 + q) * R_PITCH + (cc * 256 + lane * 4) * 2;
                        *(LAS u32x2*)(lds + R_HHI + o) = hi; *(LAS u32x2*)(lds + R_HLO + o) = lo; }
                __syncthreads();
#pragma unroll
                for (int s2 = 0; s2 < 2; ++s2) { const int off = (lane & 15) * R_PITCH + (2 * wid + s2) * 64 + (lane >> 4) * 16;
                    const bf16x8 ahi = *(const LAS bf16x8*)(lds + R_HHI + off), alo = *(const LAS bf16x8*)(lds + R_HLO + off);
#pragma unroll
                    for (int ct = 0; ct < 2; ++ct) { const bf16x8 bhi = *(const LAS bf16x8*)(lds + R_WHI + ct * 16 * R_PITCH + off), blo = *(const LAS bf16x8*)(lds + R_WLO + ct * 16 * R_PITCH + off);
                        acc[ct] = __builtin_amdgcn_mfma_f32_16x16x32_bf16(ahi, bhi, acc[ct], 0, 0, 0); acc[ct] = __builtin_amdgcn_mfma_f32_16x16x32_bf16(alo, bhi, acc[ct], 0, 0, 0);
                        acc[ct] = __builtin_amdgcn_mfma_f32_16x16x32_bf16(ahi, blo, acc[ct], 0, 0, 0); } }
            }
            __syncthreads();
#pragma unroll
            for (int ct = 0; ct < 2; ++ct)
#pragma unroll
                for (int i = 0; i < 4; ++i) ps[wid * 512 + (4 * (lane >> 4) + i) * 32 + ct * 16 + (lane & 15)] = acc[ct][i];
            __syncthreads();
            { const int o = tid; float z = p.router_b[o & 31];
#pragma unroll
              for (int w = 0; w < 8; ++w) z += ps[w * 512 + o];
              lg[half * 512 + o] = z; }
        }
        LAS int* lcnt = (LAS int*)(lds + R_TAB);
        LAS int* lbase = lcnt + 32;
        LAS int* asg_e = lbase + 32;
        LAS int* asg_r = asg_e + 128;
        if (tid < 32) lcnt[tid] = 0;
        __syncthreads();
#pragma unroll 1
        for (int rr = 0; rr < 4; ++rr) {
            const int rl = wid * 4 + rr, row = blk * 32 + rl;
            float val = (lane < 32) ? lg[rl * 32 + lane] : -INFINITY;
            float tv[4]; int ti[4];
#pragma unroll
            for (int k = 0; k < 4; ++k) { const float m = wave_max(val);
                const unsigned long long bal = __ballot(val == m); const int idx = __ffsll((long long)bal) - 1;
                tv[k] = m; ti[k] = idx; if (lane == idx) val = -INFINITY; }
            if (lane < 4) { float pe[4], sum = 0.f;
#pragma unroll
                for (int k = 0; k < 4; ++k) { pe[k] = __expf(tv[k] - tv[0]); sum += pe[k]; }
                const int e = lane == 0 ? ti[0] : lane == 1 ? ti[1] : lane == 2 ? ti[2] : ti[3]; const float pk = (lane == 0 ? pe[0] : lane == 1 ? pe[1] : lane == 2 ? pe[2] : pe[3]) / sum;
                const int lr = __hip_atomic_fetch_add((int*)(lcnt + e), 1, __ATOMIC_RELAXED, __HIP_MEMORY_SCOPE_WORKGROUP); asg_e[rl * 4 + lane] = e; asg_r[rl * 4 + lane] = lr; gate[row * 4 + lane] = pk; }
        }
        __syncthreads();
        if (tid < 32) lbase[tid] = atomicAdd(&counts[tid], lcnt[tid]);
        __syncthreads();
        if (tid < 128) { const int e = asg_e[tid]; list[(size_t)e * NTOK + lbase[e] + asg_r[tid]] = (blk * 32) * 4 + tid; }
    }
}
__device__ __forceinline__ void phase_final(const Ptrs& p, LAS unsigned char* lds) {
    const int tid = tid_opaque(), lane = tid & 63, wid = tid >> 6;
    const float* x1 = (const float*)(p.ws + OFF_X1); const bf16_t* y = (const bf16_t*)(p.ws + OFF_Y);
    for (int row = vwg_id() * 8 + wid; row < NTOK; row += gridDim.x * 8) {
        const int b = row / S; const float* gf = (const float*)(p.ws + OFF_MOD) + (size_t)b * NMOD + 5 * D; const float* xr = x1 + (size_t)row * D; const bf16_t* yr = y + (size_t)row * 4 * D;
        f32x4 v[8]; float ss = 0.f;
#pragma unroll
        for (int c = 0; c < 8; ++c) { const int k = c * 256 + lane * 4; f32x4 s = {0.f, 0.f, 0.f, 0.f};
#pragma unroll
            for (int q = 0; q < 4; ++q) { const u32x2 w = *(const u32x2*)(yr + (size_t)q * D + k); s[0] += bflo(w.x); s[1] += bfhi(w.x); s[2] += bflo(w.y); s[3] += bfhi(w.y); }
            v[c] = *(const f32x4*)(xr + k) + *(const f32x4*)(gf + k) * s; ss += v[c][0] * v[c][0] + v[c][1] * v[c][1] + v[c][2] * v[c][2] + v[c][3] * v[c][3]; }
        ss = wave_sum(ss); const float r = rsqrtf(ss * (1.0f / D) + EPS);
#pragma unroll
        for (int c = 0; c < 8; ++c) { const int k = c * 256 + lane * 4; *(f32x4*)(p.out + (size_t)row * D + k) = (v[c] * r) * *(const f32x4*)(p.final_g + k); }
    }
}

#define XB_TMO      128
#define XB_XCNT(j)  (256  + 64 * (j))
#define XB_XSUB(j)  (1280 + 64 * (j))
#define XB_XGEN(j)  (2304 + 64 * (j))
#define XB_TOP      3328
#define XB_TOPGEN   3392
#define XCD_BAR_WORDS 3456
#define XB_SPIN_CAP (1u << 18)

__device__ __forceinline__ unsigned xb_ld(unsigned* p)              { return __hip_atomic_load(p, __ATOMIC_RELAXED, __HIP_MEMORY_SCOPE_AGENT); }
__device__ __forceinline__ unsigned xb_add(unsigned* p, unsigned v) { return __hip_atomic_fetch_add(p, v, __ATOMIC_RELAXED, __HIP_MEMORY_SCOPE_AGENT); }
__device__ __forceinline__ unsigned xb_xcc_id() { return (unsigned)__builtin_amdgcn_s_getreg((3 << 11) | 20) & 0xFu; }
#define XB_SPIN(cond, bar) do { unsigned _sp = 0; while (cond) { __builtin_amdgcn_s_sleep(1); \
    if ((++_sp & 255u) == 0u) { if (xb_ld(&(bar)[XB_TMO])) break; if (_sp > XB_SPIN_CAP) { atomicAdd(&(bar)[XB_TMO], 1u); break; } } } } while (0)

struct XcdBarrier {
    unsigned* bar; unsigned x;
    volatile LAS unsigned* st;
};

__device__ __forceinline__ XcdBarrier xcd_barrier_post(unsigned* bar, volatile LAS unsigned* st) {
    XcdBarrier b; b.bar = bar; b.x = xb_xcc_id(); b.st = st;
    if (threadIdx.x == 0) (void)xb_add(&bar[XB_XCNT(b.x)], 1u);
    return b;
}
__device__ __forceinline__ void xcd_barrier_complete(unsigned* bar, unsigned x, unsigned& nloc, unsigned& nx) {
    const unsigned G = gridDim.x * gridDim.y * gridDim.z;
    unsigned sum, cnt, mine, sp = 0u;
    for (;;) {
        sum = 0u; cnt = 0u; mine = 0u;
#pragma unroll
        for (unsigned j = 0; j < 16; ++j) { const unsigned c = xb_ld(&bar[XB_XCNT(j)]); sum += c; cnt += (c > 0u) ? 1u : 0u; mine = (j == x) ? c : mine; }
        if (sum == G) break;
        __builtin_amdgcn_s_sleep(1);
        if ((++sp & 255u) == 0u) { if (xb_ld(&bar[XB_TMO])) break; if (sp > XB_SPIN_CAP) { atomicAdd(&bar[XB_TMO], 1u); break; } }
    }
    nloc = mine > 0u ? mine : 1u; nx = cnt > 0u ? cnt : 1u;
}

__device__ __forceinline__ void xcd_barrier(const XcdBarrier& b) {
    asm volatile("s_waitcnt vmcnt(0)" ::: "memory");
    __syncthreads();
    if (threadIdx.x == 0) {
        unsigned* bar = b.bar;
        __builtin_amdgcn_s_waitcnt(0);
        unsigned nloc = b.st[0], nx = b.st[1];
        if (nloc == 0u) { xcd_barrier_complete(bar, b.x, nloc, nx); b.st[0] = nloc; b.st[1] = nx; }
        const unsigned old = xb_add(&bar[XB_XSUB(b.x)], 1u);
        const unsigned gen = old / nloc;
        if (old + 1u == (gen + 1u) * nloc) {
            __builtin_amdgcn_fence(__ATOMIC_RELEASE, "agent");
            asm volatile("s_waitcnt vmcnt(0)" ::: "memory");
            const unsigned og = xb_add(&bar[XB_TOP], 1u);
            const unsigned tg = og / nx;
            if (og + 1u == (tg + 1u) * nx) xb_add(&bar[XB_TOPGEN], 1u);
            else XB_SPIN(xb_ld(&bar[XB_TOPGEN]) == tg, bar);
            __builtin_amdgcn_fence(__ATOMIC_ACQUIRE, "agent");
            xb_add(&bar[XB_XGEN(b.x)], 1u);
            asm volatile("s_waitcnt vmcnt(0)" ::: "memory");
        } else {
            XB_SPIN(xb_ld(&bar[XB_XGEN(b.x)]) == gen, bar);
            __builtin_amdgcn_fence(__ATOMIC_ACQUIRE, "agent");
            asm volatile("s_waitcnt vmcnt(0)" ::: "memory");
        }
    }
    __syncthreads();
}


constexpr int LDS_TOTAL = AUX_LDS + 16;
constexpr size_t OFF_BAR = OFF_CTRL + 4096;
static_assert(GEMM_LDS <= AUX_LDS && ATT_LDS <= AUX_LDS && N1_END <= AUX_LDS && R_END <= AUX_LDS, "LDS");
static_assert(4096 + XCD_BAR_WORDS * 4 <= 65536, "ctrl");
__global__ void __launch_bounds__(512, 2) mega_fwd(Ptrs p) {
    LAS unsigned char* lds = (LAS unsigned char*)dyn_lds;
    volatile LAS unsigned* st = (volatile LAS unsigned*)(lds + AUX_LDS);
    if (threadIdx.x == 0) { st[0] = 0u; st[1] = 0u; st[2] = 0u; st[3] = 0u; }
    __syncthreads();
    XcdBarrier bar = xcd_barrier_post((unsigned*)(p.ws + OFF_BAR), st);
    phase_mod(p, lds);          xcd_barrier(bar);
    phase_norm1(p, lds);        xcd_barrier(bar);
    phase_gemm1(p, lds);        xcd_barrier(bar);
    phase_scan_conv(p, lds);    xcd_barrier(bar);
    phase_attn(p, lds);         xcd_barrier(bar);
    phase_merge(p, lds);        xcd_barrier(bar);
    phase_out(p, lds);          xcd_barrier(bar);
    phase_norm2_route(p, lds);  xcd_barrier(bar);
    phase_moe_gu(p, lds);
    phase_moe_down(p, lds);     xcd_barrier(bar);
    phase_final(p, lds);
}

extern "C" void kernel_launch(void* const* d_in, const int* in_sizes, int n_in, void* d_out, int out_size, void* d_ws, size_t ws_size, hipStream_t stream) {
    Ptrs p{};
    const float** f = (const float**)&p;
    for (int i = 0; i < 21; ++i) f[i] = (const float*)d_in[i];
    p.out = (float*)d_out; p.ws = (unsigned char*)d_ws;
    static int grid = 0;
    if (!grid) {
        (void)hipFuncSetAttribute((const void*)mega_fwd, hipFuncAttributeMaxDynamicSharedMemorySize, LDS_TOTAL);
        int dev = 0, cus = 0, per_cu = 0;
        (void)hipGetDevice(&dev);
        (void)hipDeviceGetAttribute(&cus, hipDeviceAttributeMultiprocessorCount, dev);
        (void)hipOccupancyMaxActiveBlocksPerMultiprocessor(&per_cu, mega_fwd, 512, LDS_TOTAL);
        grid = cus * (per_cu < 1 ? per_cu : 1);
        if (grid <= 0) grid = cus > 0 ? cus : 256;
    }
    (void)hipMemsetAsync(p.ws + OFF_CTRL, 0, 65536, stream);
    mega_fwd<<<grid, 512, LDS_TOTAL, stream>>>(p);
}
```

```cpp
#include <hip/hip_runtime.h>
#include <stdint.h>

typedef unsigned short bf16_t;
typedef float f32x4 __attribute__((ext_vector_type(4)));
typedef unsigned u32x4 __attribute__((ext_vector_type(4)));
typedef unsigned u32x2 __attribute__((ext_vector_type(2)));

namespace cfg {
constexpr int B = 2, S = 4096, D = 2048, NTOK = B * S, H = 16, DH = 64, DA = 1024, DC = 1024;
constexpr int NIN = 10256, NMOD = 6 * D, E = 32, TOPK = 4, NASG = NTOK * TOPK;
constexpr int PLD = 10240;
constexpr int C_XC = 0, C_CB = 1024, C_CC = 2048, C_Q = 3072, C_K = 4096, C_V = 5120, C_GC = 6144, C_GA = 8192;
constexpr int W_F = 6144, W_GC = 6160, W_GA = 8208;
constexpr float EPS = 1e-6f, LOG2E = 1.4426950408889634f;
constexpr float QSCALE = 0.125f * LOG2E;
constexpr int ACT_ROWS = NASG + E * 256;
constexpr size_t al(size_t x) { return (x + 255) & ~(size_t)255; }
constexpr size_t OFF_CTRL = 0;
constexpr size_t OFF_MOD = 65536;
constexpr size_t OFF_LOGF = OFF_MOD + al((size_t)B * NMOD * 4);
constexpr size_t OFF_FCUM = OFF_LOGF + al((size_t)B * H * S * 4);
constexpr size_t OFF_HA = OFF_FCUM + al((size_t)B * H * S * 4);
constexpr size_t OFF_PROJ = OFF_HA + al((size_t)NTOK * D * 2);
constexpr size_t OFF_UA = OFF_PROJ + al((size_t)NTOK * PLD * 2);
constexpr size_t OFF_MRG = OFF_UA + al((size_t)NTOK * 2048 * 2);
constexpr size_t OFF_X1 = OFF_MRG + al((size_t)NTOK * D * 2);
constexpr size_t OFF_TMP = OFF_X1 + al((size_t)NTOK * D * 4);
constexpr size_t OFF_GATE = OFF_TMP + al((size_t)NTOK * D * 4);
constexpr size_t OFF_LIST = OFF_GATE + al((size_t)NASG * 4);
constexpr size_t OFF_ACT = OFF_LIST + al((size_t)E * NTOK * 4);
constexpr size_t OFF_Y = OFF_ACT + al((size_t)ACT_ROWS * D * 2);
constexpr size_t WS_END = OFF_Y + al((size_t)NASG * D * 2);
constexpr size_t OFF_WTIN = WS_END;
constexpr size_t OFF_WTCO = OFF_WTIN + al((size_t)PLD * D * 2);
constexpr size_t OFF_WTAO = OFF_WTCO + al((size_t)D * DC * 2);
constexpr size_t OFF_WTO = OFF_WTAO + al((size_t)D * DA * 2);
constexpr size_t WS_END2 = OFF_WTO + al((size_t)D * D * 2);
}
using namespace cfg;

__device__ __forceinline__ float bf2f(bf16_t v) { return __uint_as_float(((unsigned)v) << 16); }
__device__ __forceinline__ bf16_t f2bf(float f) { unsigned u = __float_as_uint(f); u += 0x7fffu + ((u >> 16) & 1u); return (bf16_t)(u >> 16); }
__device__ __forceinline__ float sigmoidf_(float x) { return __builtin_amdgcn_rcpf(1.0f + __builtin_amdgcn_exp2f(x * -1.4426950408889634f)); }

struct Ptrs {
    const float *x, *c, *ada_w, *ada_b, *norm_mix_g, *w_in, *b_forget, *conv_w, *w_conv_out, *w_attn_out, *w_out, *norm_ffn_g,
        *router_w, *router_b, *w_gate, *b_gate, *w_up, *b_up, *w_down, *b_down, *final_g;
    float* out; unsigned char* ws;
};

#define LAS __attribute__((address_space(3)))
typedef short bf16x8 __attribute__((ext_vector_type(8)));
typedef float f32x2_t __attribute__((ext_vector_type(2)));
typedef __bf16 bf16x2_t __attribute__((ext_vector_type(2)));
__device__ __forceinline__ unsigned cvtpk(float lo, float hi) { f32x2_t v = {lo, hi}; bf16x2_t b = __builtin_convertvector(v, bf16x2_t); return __builtin_bit_cast(unsigned, b); }
__device__ __forceinline__ float bflo(unsigned w) { return __uint_as_float(w << 16); }
__device__ __forceinline__ float bfhi(unsigned w) { return __uint_as_float(w & 0xffff0000u); }
__device__ __forceinline__ int tid_opaque() { int t = threadIdx.x; asm volatile("" : "+v"(t)); return t; }
constexpr int GEMM_LDS = 131072;

struct GemmT {
    int wr, wc, fr, fq;
    int aR, aC;
    unsigned a_w;
    int b_k, b_col, b_p, b_gucol;
    unsigned b_w, b_rot;
    unsigned a_r, b_r;
    __device__ __forceinline__ void init_epi() { const int tid = tid_opaque(), wid = tid >> 6, lane = tid & 63; wr = wid >> 2; wc = wid & 3; fr = lane & 15; fq = lane >> 4; }
    __device__ __forceinline__ void init() {
        const int tid = tid_opaque(), wid = tid >> 6, lane = tid & 63;
        wr = wid >> 2; wc = wid & 3; fr = lane & 15; fq = lane >> 4;
        aR = (wid >> 1) * 16 + (lane >> 2); aC = (wid & 1) * 32 + (((lane & 3) ^ ((lane >> 5) << 1)) * 8);
        a_w = (unsigned)(wid * 1024 + lane * 16);
        { const int l32 = lane & 31, kc8 = 2 * (wid >> 1) + (lane >> 5), wc_ = l32 >> 3, bfq = (l32 >> 1) & 3, nlo = l32 & 1; b_p = wid & 1;
          b_k = kc8 * 8; b_col = wc_ * 64 + b_p * 32 + bfq * 8 + nlo * 4; b_gucol = wc_ * 32 + bfq * 8 + nlo * 4;
          const int sub = wc_ * 4 + 2 * b_p + nlo;
          b_w = (unsigned)((sub * 2 + (kc8 >> 2)) * 1024 + (((4 * bfq) * 64 + (kc8 & 3) * 16) ^ ((bfq >> 1) << 5))); b_rot = (unsigned)(nlo * 64); }
        const unsigned lo = (unsigned)((fr * 64 + fq * 16) ^ ((fr >> 3) << 5));
        a_r = (unsigned)(wr * 16384) + lo; b_r = 32768u + (unsigned)(wc * 8192) + lo;
    }
};

__device__ __forceinline__ void gemm_kloop(f32x4 (&acc)[8][4], LAS unsigned char* lds, const GemmT& T,
                                           __amdgpu_buffer_rsrc_t ra, unsigned ao0, unsigned ao1, unsigned ao2, unsigned ao3,
                                           __amdgpu_buffer_rsrc_t rb, unsigned bo, unsigned ldbB, int nt) {
    f32x4 sb[8];
    const unsigned a_wu = (unsigned)__builtin_amdgcn_readfirstlane((int)(T.a_w & ~1023u));
#define G_DMA_A(buf, t, i_) __builtin_amdgcn_raw_ptr_buffer_load_lds(ra, (LAS void*)(lds + (buf) * 65536 + a_wu + (i_) * 8192), 16, ao##i_, (unsigned)(t) * 128u, 0, 0)
#define G_ISSUE_B(t) do { const unsigned so_ = (unsigned)(t) * 64u * ldbB; _Pragma("unroll") for (int i_ = 0; i_ < 8; ++i_) sb[i_] = __builtin_bit_cast(f32x4, __builtin_amdgcn_raw_buffer_load_b128(rb, bo, so_ + (unsigned)i_ * ldbB, 0)); } while (0)
#define G_RETIRE() asm volatile("s_waitcnt vmcnt(0)" : "+v"(sb[0]), "+v"(sb[1]), "+v"(sb[2]), "+v"(sb[3]), "+v"(sb[4]), "+v"(sb[5]), "+v"(sb[6]), "+v"(sb[7]) :: "memory")
#define G_WRITE_B(buf) do { LAS unsigned char* d_ = lds + (buf) * 65536; \
        _Pragma("unroll") for (int j_ = 0; j_ < 4; ++j_) { u32x4 w_; w_.x = cvtpk(sb[0][j_], sb[1][j_]); w_.y = cvtpk(sb[2][j_], sb[3][j_]); w_.z = cvtpk(sb[4][j_], sb[5][j_]); w_.w = cvtpk(sb[6][j_], sb[7][j_]); \
            *(LAS u32x4*)(d_ + 32768 + T.b_w + ((T.b_rot + 64u * j_) & 255u)) = w_; } } while (0)
#define G_LDB(dst, buf, ks) do { const LAS unsigned char* s_ = lds + (buf) * 65536 + (ks) * 1024; _Pragma("unroll") for (int n_ = 0; n_ < 4; ++n_) dst[n_] = *(const LAS bf16x8*)(s_ + T.b_r + n_ * 2048); } while (0)
#define G_LDA(dst, buf, ks, h_) do { const LAS unsigned char* s_ = lds + (buf) * 65536 + (ks) * 1024; _Pragma("unroll") for (int m_ = 0; m_ < 4; ++m_) dst[m_] = *(const LAS bf16x8*)(s_ + T.a_r + ((h_) * 4 + m_) * 2048); } while (0)
#define G_MMA(At_, Bf_, h_) do { _Pragma("unroll") for (int m_ = 0; m_ < 4; ++m_) _Pragma("unroll") for (int n_ = 0; n_ < 4; ++n_) \
        acc[(h_) * 4 + m_][n_] = __builtin_amdgcn_mfma_f32_16x16x32_bf16(Bf_[n_], At_[m_], acc[(h_) * 4 + m_][n_], 0, 0, 0); } while (0)
#define G_SB() __builtin_amdgcn_sched_barrier(0)
#define G_BAR() do { asm volatile("s_waitcnt lgkmcnt(0)" ::: "memory"); __builtin_amdgcn_s_barrier(); asm volatile("" ::: "memory"); } while (0)
    bf16x8 Bf0[4], Bf1[4], AtA[4], AtB[4];
    G_ISSUE_B(0); G_DMA_A(0, 0, 0); G_DMA_A(0, 0, 1); G_DMA_A(0, 0, 2); G_DMA_A(0, 0, 3); G_RETIRE(); G_WRITE_B(0);
    if (nt > 1) G_ISSUE_B(1);
    G_BAR();
    for (int t = 0; t < nt; ++t) { const int cur = t & 1; const bool w1 = t + 1 < nt, i2 = t + 2 < nt;
        G_LDB(Bf0, cur, 0); G_LDA(AtA, cur, 0, 0); G_SB();
        G_LDA(AtB, cur, 0, 1); if (w1) { G_DMA_A(cur ^ 1, t + 1, 0); G_DMA_A(cur ^ 1, t + 1, 1); G_DMA_A(cur ^ 1, t + 1, 2); G_DMA_A(cur ^ 1, t + 1, 3); } G_MMA(AtA, Bf0, 0); G_SB();
        G_LDB(Bf1, cur, 1); G_LDA(AtA, cur, 1, 0); G_MMA(AtB, Bf0, 1); G_SB();
        G_LDA(AtB, cur, 1, 1); if (w1) { G_RETIRE(); G_WRITE_B(cur ^ 1); } if (i2) G_ISSUE_B(t + 2); G_MMA(AtA, Bf1, 0); G_SB();
        G_MMA(AtB, Bf1, 1); G_SB();
        G_BAR(); }
#undef G_LDA
#undef G_MMA
#undef G_SB
#undef G_DMA_A
#undef G_ISSUE_B
#undef G_WRITE_B
#undef G_RETIRE
#undef G_LDB
}
__device__ __forceinline__ void gemm_kloop_light(f32x4 (&acc)[8][4], LAS unsigned char* lds, const GemmT& T,
                                                 __amdgpu_buffer_rsrc_t ra, unsigned ao0, unsigned ao1, unsigned ao2, unsigned ao3,
                                                 __amdgpu_buffer_rsrc_t rb, unsigned bo, unsigned ldbB, int nt, int mlim) {
    f32x4 sb[8];
    const unsigned a_wu = (unsigned)__builtin_amdgcn_readfirstlane((int)(T.a_w & ~1023u));
#define G_DMA_A(buf, t, i_) __builtin_amdgcn_raw_ptr_buffer_load_lds(ra, (LAS void*)(lds + (buf) * 65536 + a_wu + (i_) * 8192), 16, ao##i_, (unsigned)(t) * 128u, 0, 0)
#define G_ISSUE_B(t) do { const unsigned so_ = (unsigned)(t) * 64u * ldbB; _Pragma("unroll") for (int i_ = 0; i_ < 8; ++i_) sb[i_] = __builtin_bit_cast(f32x4, __builtin_amdgcn_raw_buffer_load_b128(rb, bo, so_ + (unsigned)i_ * ldbB, 0)); } while (0)
#define G_RETIRE() asm volatile("s_waitcnt vmcnt(0)" : "+v"(sb[0]), "+v"(sb[1]), "+v"(sb[2]), "+v"(sb[3]), "+v"(sb[4]), "+v"(sb[5]), "+v"(sb[6]), "+v"(sb[7]) :: "memory")
#define G_WRITE_B(buf) do { LAS unsigned char* d_ = lds + (buf) * 65536; \
        _Pragma("unroll") for (int j_ = 0; j_ < 4; ++j_) { u32x4 w_; w_.x = cvtpk(sb[0][j_], sb[1][j_]); w_.y = cvtpk(sb[2][j_], sb[3][j_]); w_.z = cvtpk(sb[4][j_], sb[5][j_]); w_.w = cvtpk(sb[6][j_], sb[7][j_]); \
            *(LAS u32x4*)(d_ + 32768 + T.b_w + ((T.b_rot + 64u * j_) & 255u)) = w_; } } while (0)
    G_ISSUE_B(0); G_DMA_A(0, 0, 0); G_DMA_A(0, 0, 1); G_DMA_A(0, 0, 2); G_DMA_A(0, 0, 3); G_RETIRE(); G_WRITE_B(0);
    if (nt > 1) G_ISSUE_B(1);
    G_BAR();
    for (int t = 0; t < nt; ++t) { const int cur = t & 1; const bool w1 = t + 1 < nt, i2 = t + 2 < nt;
        if (w1) { G_DMA_A(cur ^ 1, t + 1, 0); G_DMA_A(cur ^ 1, t + 1, 1); G_DMA_A(cur ^ 1, t + 1, 2); G_DMA_A(cur ^ 1, t + 1, 3); }
        if (mlim > 0) {
#pragma unroll
            for (int ks = 0; ks < 2; ++ks) { const LAS unsigned char* s_ = lds + cur * 65536 + ks * 1024; bf16x8 Bf_[4];
#pragma unroll
                for (int n_ = 0; n_ < 4; ++n_) Bf_[n_] = *(const LAS bf16x8*)(s_ + T.b_r + n_ * 2048);
#pragma unroll
                for (int m_ = 0; m_ < 8; ++m_) if (m_ < mlim) { const bf16x8 At_ = *(const LAS bf16x8*)(s_ + T.a_r + m_ * 2048);
#pragma unroll
                    for (int n_ = 0; n_ < 4; ++n_) acc[m_][n_] = __builtin_amdgcn_mfma_f32_16x16x32_bf16(Bf_[n_], At_, acc[m_][n_], 0, 0, 0); } } }
        if (w1) { G_RETIRE(); G_WRITE_B(cur ^ 1); }
        if (i2) G_ISSUE_B(t + 2);
        G_BAR(); }
#undef G_DMA_A
#undef G_ISSUE_B
#undef G_RETIRE
#undef G_WRITE_B
}
__device__ __forceinline__ __amdgpu_buffer_rsrc_t mk_rsrc(const void* p) { return __builtin_amdgcn_make_buffer_rsrc((void*)p, 0, 0x7ffffff0, 0x00020000); }
__device__ __forceinline__ void acc_zero(f32x4 (&acc)[8][4]) {
#pragma unroll
    for (int m = 0; m < 8; ++m)
#pragma unroll
        for (int n = 0; n < 4; ++n) acc[m][n] = (f32x4){0.f, 0.f, 0.f, 0.f};
}
__device__ __forceinline__ f32x4 rot1(const f32x4 a) { return (f32x4){a[1], a[2], a[3], a[0]}; }
__device__ __forceinline__ f32x4 rotinv(const f32x4 a) { return (f32x4){a[3], a[0], a[1], a[2]}; }
__device__ __forceinline__ u32x4 pack8(const f32x4 a, const f32x4 b) { u32x4 w; w.x = cvtpk(a[0], a[1]); w.y = cvtpk(a[2], a[3]); w.z = cvtpk(b[0], b[1]); w.w = cvtpk(b[2], b[3]); return w; }
__device__ __forceinline__ int vwg_id() { const int G = gridDim.x; return (G % 8 == 0) ? (int)((blockIdx.x % 8) * (G / 8) + blockIdx.x / 8) : (int)blockIdx.x; }

__device__ __forceinline__ void g8_stage_rc(int b, int& R, int& C) { const int st = b / 1024, sb = b % 1024, swz = sb ^ (((sb >> 9) & 1) << 5); R = (st >> 1) * 16 + swz / 64; C = (st & 1) * 32 + (swz % 64) / 2; }
__device__ __forceinline__ int g8_lds_byte(int r, int c) { const int st = (r >> 4) * 2 + (c >> 5), rr = r & 15, cc = c & 31, ob = rr * 64 + cc * 2; return st * 1024 + (ob ^ (((ob >> 9) & 1) << 5)); }
__device__ __forceinline__ void gemm8_kloop(f32x4 (&acc)[2][2][4][2], char* shm_, const bf16_t* A, long lda, const bf16_t* Bt, long ldb, int nt) {
    constexpr int HT = 128 * 64;
    bf16_t* shm = (bf16_t*)shm_;
#define G8_SA(b, h) (shm + ((b) * 2 + (h)) * HT)
#define G8_SB(b, h) (shm + (4 + (b) * 2 + (h)) * HT)
#define G8_STAGE_X(T_, P, BASE, LD, br, kt) do { const long g_ = (long)(br) * (LD) + (long)(kt) * 64; \
    for (int i_ = 0; i_ < 2; ++i_) { const int b_ = (T_) * 16 + i_ * 8192; int r_, c_; g8_stage_rc(b_, r_, c_); \
      __builtin_amdgcn_global_load_lds((const unsigned*)((BASE) + g_ + (long)r_ * (LD) + c_), (__attribute__((address_space(3))) unsigned*)((__attribute__((address_space(3))) char*)(P) + b_), 16, 0, 0); } } while (0)
#define G8_STAGE(P, BASE, LD, br, kt) G8_STAGE_X(tid, P, BASE, LD, br, kt)
#define G8_LDA(dst, b, h) for (int m = 0; m < 4; ++m) for (int k = 0; k < 2; ++k) dst[m][k] = *reinterpret_cast<const bf16x8*>((char*)G8_SA(b, h) + g8_lds_byte(wr * 64 + m * 16 + fr, k * 32 + fq * 8))
#define G8_LDB(dst, b, h) for (int n = 0; n < 2; ++n) for (int k = 0; k < 2; ++k) dst[n][k] = *reinterpret_cast<const bf16x8*>((char*)G8_SB(b, h) + g8_lds_byte(wc * 32 + n * 16 + fr, k * 32 + fq * 8))
#define G8_MMA(ai, bj, At, Bt_) do { __builtin_amdgcn_s_setprio(1); \
    for (int m = 0; m < 4; ++m) for (int n = 0; n < 2; ++n) for (int k = 0; k < 2; ++k) \
      acc[ai][bj][m][n] = __builtin_amdgcn_mfma_f32_16x16x32_bf16(Bt_[n][k], At[m][k], acc[ai][bj][m][n], 0, 0, 0); \
    __builtin_amdgcn_s_setprio(0); } while (0)
#define G8_WAIT_V(n) asm volatile("s_waitcnt vmcnt(" #n ")" ::: "memory")
#define G8_WAIT_L(n) asm volatile("s_waitcnt lgkmcnt(" #n ")" ::: "memory")
#define G8_BAR __builtin_amdgcn_s_barrier()
#define G8_SCHED __builtin_amdgcn_sched_barrier(0)
    const int tid = tid_opaque(); int wid = tid >> 6, lane = tid & 63, wr = wid >> 2, wc = wid & 3, fr = lane & 15, fq = lane >> 4;
    bf16x8 At[4][2], B0[2][2], B1[2][2];
    G8_STAGE(G8_SB(0, 0), Bt, ldb, 0, 0); G8_STAGE(G8_SA(0, 0), A, lda, 0, 0);
    G8_STAGE(G8_SB(0, 1), Bt, ldb, 128, 0); G8_STAGE(G8_SA(0, 1), A, lda, 128, 0);
    if (wr == 1) G8_BAR;
    G8_WAIT_V(4); G8_BAR;
    G8_STAGE(G8_SB(1, 0), Bt, ldb, 0, 1); G8_STAGE(G8_SA(1, 0), A, lda, 0, 1); G8_STAGE(G8_SB(1, 1), Bt, ldb, 128, 1);
    G8_WAIT_V(6); G8_BAR;
    for (int t = 0; t < nt - 2; t += 2) {
        G8_LDB(B0, 0, 0); G8_SCHED; G8_LDA(At, 0, 0); G8_STAGE(G8_SA(1, 1), A, lda, 128, t + 1);
        G8_WAIT_L(8); G8_BAR; G8_WAIT_L(0); G8_MMA(0, 0, At, B0); G8_BAR; G8_SCHED;
        G8_LDB(B1, 0, 1); G8_STAGE(G8_SB(0, 0), Bt, ldb, 0, t + 2);
        G8_BAR; G8_WAIT_L(0); G8_MMA(0, 1, At, B1); G8_BAR;
        G8_LDA(At, 0, 1); G8_STAGE(G8_SA(0, 0), A, lda, 0, t + 2);
        G8_BAR; G8_WAIT_L(0); G8_MMA(1, 0, At, B0); G8_BAR; G8_SCHED;
        G8_STAGE(G8_SB(0, 1), Bt, ldb, 128, t + 2);
        G8_WAIT_V(6); G8_BAR; G8_MMA(1, 1, At, B1); G8_BAR;
        G8_LDB(B0, 1, 0); G8_SCHED; G8_LDA(At, 1, 0); G8_STAGE(G8_SA(0, 1), A, lda, 128, t + 2);
        G8_WAIT_L(8); G8_BAR; G8_WAIT_L(0); G8_MMA(0, 0, At, B0); G8_BAR; G8_SCHED;
        G8_LDB(B1, 1, 1); G8_STAGE(G8_SB(1, 0), Bt, ldb, 0, t + 3);
        G8_BAR; G8_WAIT_L(0); G8_MMA(0, 1, At, B1); G8_BAR;
        G8_LDA(At, 1, 1); G8_STAGE(G8_SA(1, 0), A, lda, 0, t + 3);
        G8_BAR; G8_WAIT_L(0); G8_MMA(1, 0, At, B0); G8_BAR; G8_SCHED;
        G8_STAGE(G8_SB(1, 1), Bt, ldb, 128, t + 3);
        G8_WAIT_V(6); G8_BAR; G8_MMA(1, 1, At, B1); G8_BAR;
    }
    int tz = tid_opaque(); wid = tz >> 6; lane = tz & 63; wr = wid >> 2; wc = wid & 3; fr = lane & 15; fq = lane >> 4;
    { G8_LDB(B0, 0, 0); G8_WAIT_V(0); G8_LDA(At, 0, 0); G8_STAGE_X(tz, G8_SA(1, 1), A, lda, 128, nt - 1);
      G8_BAR; G8_WAIT_L(0); G8_MMA(0, 0, At, B0); G8_BAR;
      G8_LDB(B1, 0, 1); G8_BAR; G8_WAIT_L(0); G8_MMA(0, 1, At, B1); G8_BAR;
      G8_LDA(At, 0, 1); G8_WAIT_V(4); G8_BAR; G8_WAIT_L(0); G8_MMA(1, 0, At, B0); G8_MMA(1, 1, At, B1); G8_BAR; }
    { G8_LDB(B0, 1, 0); G8_LDA(At, 1, 0); G8_WAIT_V(2); G8_BAR; G8_WAIT_L(0); G8_MMA(0, 0, At, B0); G8_BAR;
      G8_LDB(B1, 1, 1); G8_WAIT_V(0); G8_BAR; G8_WAIT_L(0); G8_MMA(0, 1, At, B1); G8_BAR;
      G8_LDA(At, 1, 1); G8_BAR; G8_WAIT_L(0); G8_MMA(1, 0, At, B0); G8_MMA(1, 1, At, B1); G8_BAR; }
    if (wr == 0) G8_BAR;
}
#define G8_ZERO(acc) do { _Pragma("unroll") for (int a_ = 0; a_ < 2; ++a_) _Pragma("unroll") for (int b_ = 0; b_ < 2; ++b_) _Pragma("unroll") for (int m_ = 0; m_ < 4; ++m_) _Pragma("unroll") for (int n_ = 0; n_ < 2; ++n_) acc[a_][b_][m_][n_] = (f32x4){0.f, 0.f, 0.f, 0.f}; } while (0)
__device__ __forceinline__ void prep_tile(const float* W, size_t ldw, int k0, int nsrc0, bf16_t* WT, size_t ldt, int ndst0, LAS unsigned char* lds) {
    LAS unsigned* T = (LAS unsigned*)lds;
    const int tid = tid_opaque();
#pragma unroll
    for (int i = 0; i < 4; ++i) { const int it = tid + 512 * i, nq = (it & 15) + 16 * ((it >> 6) & 3), kp = ((it >> 4) & 3) + 4 * (it >> 8);
        const float* w = W + (size_t)(k0 + 2 * kp) * ldw + nsrc0 + 4 * nq; const f32x4 w0 = *(const f32x4*)w, w1 = *(const f32x4*)(w + ldw);
#pragma unroll
        for (int j = 0; j < 4; ++j) T[(4 * nq + j) * 33 + kp] = cvtpk(w0[j], w1[j]); }
    __syncthreads();
    { const int n = tid >> 1, hh = tid & 1; u32x4 o[4];
#pragma unroll
      for (int q = 0; q < 4; ++q)
#pragma unroll
          for (int j = 0; j < 4; ++j) o[q][j] = T[n * 33 + hh * 16 + q * 4 + j];
      bf16_t* d = WT + (size_t)(ndst0 + n) * ldt + k0 + hh * 32;
#pragma unroll
      for (int q = 0; q < 4; ++q) *(u32x4*)(d + q * 8) = o[q]; }
    __syncthreads();
}
__device__ __forceinline__ void phase_prep(const Ptrs& p, LAS unsigned char* lds) {
    bf16_t* wtin = (bf16_t*)(p.ws + OFF_WTIN); bf16_t* wtco = (bf16_t*)(p.ws + OFF_WTCO); bf16_t* wtao = (bf16_t*)(p.ws + OFF_WTAO); bf16_t* wto = (bf16_t*)(p.ws + OFF_WTO);
    for (int t = vwg_id(); t < 1792; t += gridDim.x) {
        if (t < 1280) { const int kb = t & 31, nb = t >> 5, pc = nb * 256; prep_tile(p.w_in, NIN, kb * 64, pc < C_GC ? pc : pc + (W_GC - C_GC), wtin, D, pc, lds); }
        else if (t < 1408) { const int q = t - 1280, kb = q & 15, nb = q >> 4; prep_tile(p.w_conv_out, D, kb * 64, nb * 256, wtco, DC, nb * 256, lds); }
        else if (t < 1536) { const int q = t - 1408, kb = q & 15, nb = q >> 4; prep_tile(p.w_attn_out, D, kb * 64, nb * 256, wtao, DA, nb * 256, lds); }
        else { const int q = t - 1536, kb = q & 31, nb = q >> 5; prep_tile(p.w_out, D, kb * 64, nb * 256, wto, D, nb * 256, lds); }
    }
}
__device__ __forceinline__ void phase_gemm1(const Ptrs& p, LAS unsigned char* lds) {
    const bf16_t* ha = (const bf16_t*)(p.ws + OFF_HA); bf16_t* pr = (bf16_t*)(p.ws + OFF_PROJ); const bf16_t* wtin = (const bf16_t*)(p.ws + OFF_WTIN);
    for (int u = vwg_id(); u < 32 * 40; u += gridDim.x) {
        const int pm = (u >> 3) & 31, pn = (u & 7) + 8 * (u >> 8);
        const int row0 = pm * 256, pcol0 = pn * 256;
        f32x4 acc[2][2][4][2]; G8_ZERO(acc);
        gemm8_kloop(acc, (char*)lds, ha + (size_t)row0 * D, D, wtin + (size_t)pcol0 * D, D, D / 64);
        const int tid = tid_opaque(), wid = tid >> 6, lane = tid & 63, wr = wid >> 2, wc = wid & 3, fr = lane & 15, fq = lane >> 4;
        const int mode = (pcol0 >= C_GC) ? 2 : ((pcol0 >= C_Q && pcol0 < C_K) ? 1 : 0);
#pragma unroll
        for (int ai = 0; ai < 2; ++ai)
#pragma unroll
            for (int m = 0; m < 4; ++m) { bf16_t* prow = pr + (size_t)(row0 + ai * 128 + wr * 64 + m * 16 + fr) * PLD + pcol0 + wc * 32 + fq * 4;
#pragma unroll
                for (int bj = 0; bj < 2; ++bj)
#pragma unroll
                    for (int n = 0; n < 2; ++n) { f32x4 v = acc[ai][bj][m][n];
                        if (mode == 1) v *= QSCALE;
                        else if (mode == 2) {
#pragma unroll
                            for (int j = 0; j < 4; ++j) v[j] = sigmoidf_(v[j]); }
                        u32x2 w; w.x = cvtpk(v[0], v[1]); w.y = cvtpk(v[2], v[3]); *(u32x2*)(prow + bj * 128 + n * 16) = w; } }
        asm volatile("s_waitcnt vmcnt(0)" ::: "memory");
    }
}
__device__ __forceinline__ void phase_merge(const Ptrs& p, LAS unsigned char* lds) {
    const bf16_t* ua = (const bf16_t*)(p.ws + OFF_UA); const bf16_t* pr = (const bf16_t*)(p.ws + OFF_PROJ); bf16_t* mg = (bf16_t*)(p.ws + OFF_MRG);
    const bf16_t* wtco = (const bf16_t*)(p.ws + OFF_WTCO); const bf16_t* wtao = (const bf16_t*)(p.ws + OFF_WTAO);
    for (int u = vwg_id(); u < 32 * 8; u += gridDim.x) {
        const int pm = u >> 3, pn = u & 7, row0 = pm * 256, col0 = pn * 256;
        f32x4 acc[2][2][4][2]; G8_ZERO(acc);
#pragma unroll 1
        for (int seg = 0; seg < 2; ++seg) {
            gemm8_kloop(acc, (char*)lds, ua + (size_t)row0 * 2048 + seg * 1024, 2048, (seg ? wtao : wtco) + (size_t)col0 * 1024, 1024, 1024 / 64);
            const int tid = tid_opaque(), wid = tid >> 6, lane = tid & 63, wr = wid >> 2, wc = wid & 3, fr = lane & 15, fq = lane >> 4;
#pragma unroll
            for (int ai = 0; ai < 2; ++ai)
#pragma unroll
                for (int m = 0; m < 4; ++m) { const int row = row0 + ai * 128 + wr * 64 + m * 16 + fr;
#pragma unroll
                    for (int bj = 0; bj < 2; ++bj)
#pragma unroll
                        for (int n = 0; n < 2; ++n) { const int c = col0 + bj * 128 + wc * 32 + n * 16 + fq * 4; const size_t o = (size_t)row * PLD + c;
                            const u32x2 sa = *(const u32x2*)(pr + o + C_GA); u32x2 sc = sa; if (seg == 0) sc = *(const u32x2*)(pr + o + C_GC);
                            f32x4 v = acc[ai][bj][m][n];
                            const float a0 = bflo(sa.x), a1 = bfhi(sa.x), a2 = bflo(sa.y), a3 = bfhi(sa.y);
                            if (seg == 0) { v[0] *= bflo(sc.x) * __builtin_amdgcn_rcpf(a0); v[1] *= bfhi(sc.x) * __builtin_amdgcn_rcpf(a1); v[2] *= bflo(sc.y) * __builtin_amdgcn_rcpf(a2); v[3] *= bfhi(sc.y) * __builtin_amdgcn_rcpf(a3); }
                            else { v[0] *= a0; v[1] *= a1; v[2] *= a2; v[3] *= a3; }
                            acc[ai][bj][m][n] = v;
                            if (seg == 1) { u32x2 w; w.x = cvtpk(v[0], v[1]); w.y = cvtpk(v[2], v[3]); *(u32x2*)(mg + (size_t)row * D + c) = w; } }
                    asm volatile("" ::: "memory"); }
            asm volatile("s_waitcnt vmcnt(0)" ::: "memory");
        }
    }
}
__device__ __forceinline__ void phase_out(const Ptrs& p, LAS unsigned char* lds) {
    const bf16_t* mg = (const bf16_t*)(p.ws + OFF_MRG); float* x1 = (float*)(p.ws + OFF_X1); const float* mod = (const float*)(p.ws + OFF_MOD); const bf16_t* wto = (const bf16_t*)(p.ws + OFF_WTO);
    for (int u = vwg_id(); u < 32 * 8; u += gridDim.x) {
        const int pm = u >> 3, pn = u & 7, row0 = pm * 256, col0 = pn * 256;
        f32x4 acc[2][2][4][2]; G8_ZERO(acc);
        gemm8_kloop(acc, (char*)lds, mg + (size_t)row0 * D, D, wto + (size_t)col0 * D, D, D / 64);
        const int tid = tid_opaque(), wid = tid >> 6, lane = tid & 63, wr = wid >> 2, wc = wid & 3, fr = lane & 15, fq = lane >> 4;
        const float* gm = mod + (size_t)(row0 / S) * NMOD + 2 * D;
#pragma unroll
        for (int ai = 0; ai < 2; ++ai)
#pragma unroll
            for (int m = 0; m < 4; ++m) { const int row = row0 + ai * 128 + wr * 64 + m * 16 + fr;
#pragma unroll
                for (int bj = 0; bj < 2; ++bj)
#pragma unroll
                    for (int n = 0; n < 2; ++n) { const int c = col0 + bj * 128 + wc * 32 + n * 16 + fq * 4; const size_t o = (size_t)row * D + c;
                        *(f32x4*)(x1 + o) = *(const f32x4*)(p.x + o) + *(const f32x4*)(gm + c) * acc[ai][bj][m][n]; } }
        asm volatile("s_waitcnt vmcnt(0)" ::: "memory");
    }
}
constexpr size_t OFF_GUTOT = OFF_CTRL + 1024;
constexpr size_t OFF_GUDONE = OFF_CTRL + 2048;
struct MoeUnit { int e, mt, nt, cnt, base, light; };
__device__ __forceinline__ bool moe_unit(int cv, int u, int ntiles_n, MoeUnit& mu) {
    int base = 0;
#pragma unroll
    for (int e = 0; e < E; ++e) { const int c = __builtin_amdgcn_readlane(cv, e), tm = (c + 255) >> 8, nu = tm * ntiles_n;
        if (u < nu) { mu.e = e; mu.cnt = c; mu.base = base; mu.nt = u / tm; mu.mt = u - mu.nt * tm; mu.light = (mu.mt == tm - 1 && c - mu.mt * 256 <= 128) ? 1 : 0; return true; }
        u -= nu; base += tm * 256; }
    return false;
}
__device__ __forceinline__ void phase_moe_gu(const Ptrs& p, LAS unsigned char* lds) {
    const int* counts = (const int*)(p.ws + OFF_CTRL); const bf16_t* h2 = (const bf16_t*)(p.ws + OFF_HA); bf16_t* act = (bf16_t*)(p.ws + OFF_ACT);
    const __amdgpu_buffer_rsrc_t ract = __builtin_amdgcn_make_buffer_rsrc((void*)act, 0, 0x7ffffff0, 0x00020000);
    MoeUnit mu; const int cv = counts[tid_opaque() & 31];
    for (int u = vwg_id(); moe_unit(cv, u, 16, mu); u += gridDim.x) {
        GemmT T; T.init();
        const int* list = (const int*)(p.ws + OFF_LIST) + (size_t)mu.e * NTOK; const int i0 = mu.mt * 256, n0 = mu.nt * 128;
        unsigned ao[4];
#pragma unroll
        for (int i = 0; i < 4; ++i) { const int r = i0 + T.aR + 64 * i; const int tok = (r < mu.cnt) ? (list[r] >> 2) : 0; ao[i] = (unsigned)((tok * D + T.aC) * 2); }
        const float* wsel = ((__builtin_amdgcn_readfirstlane(T.b_p) & 1) ? p.w_up : p.w_gate) + (size_t)mu.e * D * D + n0;
        const unsigned bo = (unsigned)((T.b_k * D + T.b_gucol) * 4);
        f32x4 acc[8][4]; acc_zero(acc);
        const int mlim = __builtin_amdgcn_readfirstlane(T.wr) ? 0 : ((mu.cnt - i0 + 15) >> 4);
        if (mu.light) gemm_kloop_light(acc, lds, T, mk_rsrc(h2), ao[0], ao[1], ao[2], ao[3], mk_rsrc(wsel), bo, D * 4u, D / 64, mlim);
        else gemm_kloop(acc, lds, T, mk_rsrc(h2), ao[0], ao[1], ao[2], ao[3], mk_rsrc(wsel), bo, D * 4u, D / 64);
T.init_epi();
        const int c = n0 + T.wc * 32 + T.fq * 8;
        const float* bg = p.b_gate + (size_t)mu.e * D + c; const float* bu = p.b_up + (size_t)mu.e * D + c;
        const f32x4 bg0 = *(const f32x4*)bg, bg1 = *(const f32x4*)(bg + 4), bu0 = *(const f32x4*)bu, bu1 = *(const f32x4*)(bu + 4);
#pragma unroll
        for (int m = 0; m < 8; ++m) { const int r = i0 + T.wr * 128 + m * 16 + T.fr;
            f32x4 g0 = acc[m][0] + bg0, g1 = rot1(acc[m][1]) + bg1, u0 = acc[m][2] + bu0, u1 = rot1(acc[m][3]) + bu1;
#pragma unroll
            for (int j = 0; j < 4; ++j) { float g = fminf(g0[j], 7.0f), uu = fminf(fmaxf(u0[j], -7.0f), 7.0f); g0[j] = (uu + 1.0f) * g * sigmoidf_(1.702f * g);
                g = fminf(g1[j], 7.0f); uu = fminf(fmaxf(u1[j], -7.0f), 7.0f); g1[j] = (uu + 1.0f) * g * sigmoidf_(1.702f * g); }
            if (r < mu.cnt) __builtin_amdgcn_raw_buffer_store_b128(pack8(g0, g1), ract, (unsigned)(((mu.base + r) * D + c) * 2), 0, 16); }
        asm volatile("s_waitcnt vmcnt(0)" ::: "memory");
        __syncthreads();
        if (threadIdx.x == 0) { __hip_atomic_fetch_add((unsigned*)(p.ws + OFF_GUDONE) + mu.e * 16, 1u, __ATOMIC_RELAXED, __HIP_MEMORY_SCOPE_AGENT);
                                __hip_atomic_fetch_add((unsigned*)(p.ws + OFF_GUTOT), 1u, __ATOMIC_RELAXED, __HIP_MEMORY_SCOPE_AGENT); }
    }
}
__device__ __forceinline__ void phase_moe_down(const Ptrs& p, LAS unsigned char* lds) {
    const int* counts = (const int*)(p.ws + OFF_CTRL); const bf16_t* act = (const bf16_t*)(p.ws + OFF_ACT); bf16_t* y = (bf16_t*)(p.ws + OFF_Y); const float* gate = (const float*)(p.ws + OFF_GATE);
    MoeUnit mu; const int cv = counts[tid_opaque() & 31];
    int Ttot = 0;
#pragma unroll
    for (int e = 0; e < E; ++e) Ttot += (__builtin_amdgcn_readlane(cv, e) + 255) >> 8;
    const int G = (int)gridDim.x, Ugu = Ttot * 16, u0 = ((vwg_id() - Ugu % G) % G + G) % G;
    LAS int* wslot = (LAS int*)(lds + GEMM_LDS + 4096);
    int all_done = 0;
    for (int u = u0; moe_unit(cv, u, 8, mu); u += G) {
        if (!all_done) {
            if (threadIdx.x == 0) {
                unsigned* tot = (unsigned*)(p.ws + OFF_GUTOT); unsigned* de = (unsigned*)(p.ws + OFF_GUDONE) + mu.e * 16;
                const unsigned need = (unsigned)(((mu.cnt + 255) >> 8) * 16); int all = 0;
                for (unsigned sp = 0; sp < (1u << 22); ++sp) {
                    if (__hip_atomic_load(tot, __ATOMIC_RELAXED, __HIP_MEMORY_SCOPE_AGENT) >= (unsigned)Ugu) { all = 1; break; }
                    if (__hip_atomic_load(de, __ATOMIC_RELAXED, __HIP_MEMORY_SCOPE_AGENT) >= need) break;
                    __builtin_amdgcn_s_sleep(8); }
                __builtin_amdgcn_fence(__ATOMIC_ACQUIRE, "agent");
                *wslot = all; }
            asm volatile("s_waitcnt vmcnt(0)" ::: "memory");
            __syncthreads();
            all_done = __builtin_amdgcn_readfirstlane(*wslot);
            __syncthreads(); }
        GemmT T; T.init();
        const int* list = (const int*)(p.ws + OFF_LIST) + (size_t)mu.e * NTOK; const int i0 = mu.mt * 256, col0 = mu.nt * 256;
        const unsigned ao = (unsigned)((T.aR * D + T.aC) * 2), bo = (unsigned)((T.b_k * D + T.b_col) * 4);
        int pa = -1; float pg = 0.f;
        { const int t_ = tid_opaque(); if (t_ < 256 && i0 + t_ < mu.cnt) { pa = list[i0 + t_]; pg = gate[pa]; } }
        f32x4 acc[8][4]; acc_zero(acc);
        const int mlim = __builtin_amdgcn_readfirstlane(T.wr) ? 0 : ((mu.cnt - i0 + 15) >> 4);
        if (mu.light) gemm_kloop_light(acc, lds, T, mk_rsrc(act + (size_t)(mu.base + i0) * D), ao, ao + 64u * 4096, ao + 128u * 4096, ao + 192u * 4096,
                                       mk_rsrc(p.w_down + (size_t)mu.e * D * D + col0), bo, D * 4u, D / 64, mlim);
        else gemm_kloop(acc, lds, T, mk_rsrc(act + (size_t)(mu.base + i0) * D), ao, ao + 64u * 4096, ao + 128u * 4096, ao + 192u * 4096,
                        mk_rsrc(p.w_down + (size_t)mu.e * D * D + col0), bo, D * 4u, D / 64);
T.init_epi();
        LAS int* tab = (LAS int*)(lds + GEMM_LDS);
        { const int t_ = tid_opaque(); if (t_ < 256) { tab[2 * t_] = pa; tab[2 * t_ + 1] = __float_as_int(pg); } }
        __syncthreads();
        const float* bd = p.b_down + (size_t)mu.e * D;
#pragma unroll
        for (int m = 0; m < 8; ++m) { const int rl = T.wr * 128 + m * 16 + T.fr, r = i0 + rl;
            if (r < mu.cnt) { const int a = tab[2 * rl]; const float gt = __int_as_float(tab[2 * rl + 1]);
#pragma unroll
                for (int pp = 0; pp < 2; ++pp) { const int c = col0 + T.wc * 64 + pp * 32 + T.fq * 8;
                    const f32x4 v0 = (acc[m][2 * pp] + *(const f32x4*)(bd + c)) * gt, v1 = (rot1(acc[m][2 * pp + 1]) + *(const f32x4*)(bd + c + 4)) * gt;
                    *(u32x4*)(y + (size_t)a * D + c) = pack8(v0, v1); } } }
        __syncthreads();
    }
}
extern __shared__ __attribute__((aligned(1024))) unsigned char dyn_lds[];
typedef float f32x16 __attribute__((ext_vector_type(16)));
typedef short v4i16_t __attribute__((ext_vector_type(4)));
__device__ __forceinline__ float xhalf_max(float v) { const auto rr = __builtin_amdgcn_permlane32_swap(__float_as_uint(v), __float_as_uint(v), false, false); return fmaxf(__uint_as_float(rr[0]), __uint_as_float(rr[1])); }
__device__ __forceinline__ float xhalf_sum(float v) { const auto rr = __builtin_amdgcn_permlane32_swap(__float_as_uint(v), __float_as_uint(v), false, false); return __uint_as_float(rr[0]) + __uint_as_float(rr[1]); }
template <int CTRL> __device__ __forceinline__ float dppf(float x) { return __builtin_bit_cast(float, __builtin_amdgcn_mov_dpp(__builtin_bit_cast(int, x), CTRL, 0xf, 0xf, true)); }
constexpr int DPP_XOR1 = 0xB1, DPP_XOR2 = 0x4E, DPP_XOR7 = 0x141, DPP_XOR8 = 0x128;
__device__ __forceinline__ float xrow_sum(float x) { const auto s = __builtin_amdgcn_permlane16_swap(__float_as_uint(x), __float_as_uint(x), false, false); x = __uint_as_float(s[0]) + __uint_as_float(s[1]); return xhalf_sum(x); }
__device__ __forceinline__ float xrow_max(float x) { const auto s = __builtin_amdgcn_permlane16_swap(__float_as_uint(x), __float_as_uint(x), false, false); x = fmaxf(__uint_as_float(s[0]), __uint_as_float(s[1])); return xhalf_max(x); }
__device__ __forceinline__ float wave_sum(float v) { v += dppf<DPP_XOR1>(v); v += dppf<DPP_XOR2>(v); v += dppf<DPP_XOR7>(v); v += dppf<DPP_XOR8>(v); return xrow_sum(v); }
__device__ __forceinline__ float wave_max(float v) { v = fmaxf(v, dppf<DPP_XOR1>(v)); v = fmaxf(v, dppf<DPP_XOR2>(v)); v = fmaxf(v, dppf<DPP_XOR7>(v)); v = fmaxf(v, dppf<DPP_XOR8>(v)); return xrow_max(v); }
__device__ __forceinline__ float reduce16(float (&v)[16], int lane) {
    float a[8], b[4], c[2];
#pragma unroll
    for (int i = 0; i < 8; ++i) { const auto r = __builtin_amdgcn_permlane32_swap(__float_as_uint(v[i]), __float_as_uint(v[i + 8]), false, false); a[i] = __uint_as_float(r[0]) + __uint_as_float(r[1]); }
#pragma unroll
    for (int i = 0; i < 4; ++i) { const auto r = __builtin_amdgcn_permlane16_swap(__float_as_uint(a[i]), __float_as_uint(a[i + 4]), false, false); b[i] = __uint_as_float(r[0]) + __uint_as_float(r[1]); }
#pragma unroll
    for (int i = 0; i < 2; ++i) { const float t1 = b[i] + dppf<DPP_XOR8>(b[i]), t2 = b[i + 2] + dppf<DPP_XOR8>(b[i + 2]); c[i] = (lane & 8) ? t2 : t1; }
    float d; { const float t1 = c[0] + dppf<DPP_XOR7>(c[0]), t2 = c[1] + dppf<DPP_XOR7>(c[1]); d = (lane & 4) ? t2 : t1; }
    d += dppf<DPP_XOR1>(d); d += dppf<DPP_XOR2>(d);
    return d;
}
constexpr int WT_LDS = 16 * 2048 * 4;
constexpr int AUX_LDS = 160 * 1024 - 64;

__device__ __forceinline__ void phase_mod(const Ptrs& p, LAS unsigned char* lds) {
    LAS float* sc = (LAS float*)lds;
    LAS float* red = (LAS float*)(lds + 16384);
    const int tid = tid_opaque();
    for (int i = tid; i < B * D; i += 512) { const float v = p.c[i]; sc[i] = v / (1.0f + __expf(-v)); }
    __syncthreads();
    float* mod = (float*)(p.ws + OFF_MOD);
    for (int ch = vwg_id(); ch < NMOD / 48; ch += gridDim.x) {
        const int cq = tid % 12, kg = tid / 12;
        if (kg < 42) {
            f32x4 a0 = {0.f, 0.f, 0.f, 0.f}, a1 = {0.f, 0.f, 0.f, 0.f};
            const float* wp = p.ada_w + (size_t)ch * 48 + cq * 4;
#pragma unroll 7
            for (int k = kg; k < D; k += 42) { const f32x4 w = *(const f32x4*)(wp + (size_t)k * NMOD); a0 += w * sc[k]; a1 += w * sc[D + k]; }
#pragma unroll
            for (int j = 0; j < 4; ++j) { red[kg * 96 + cq * 4 + j] = a0[j]; red[kg * 96 + 48 + cq * 4 + j] = a1[j]; }
        }
        __syncthreads();
        if (tid < 96) { float s = 0.f; for (int g = 0; g < 42; ++g) s += red[g * 96 + tid]; const int b = tid / 48, c = ch * 48 + tid % 48; mod[(size_t)b * NMOD + c] = s + p.ada_b[c]; }
        __syncthreads();
    }
}
__device__ __forceinline__ void stage_wt16(LAS float* wt, const float* w, size_t ldw) {
    const int tid = tid_opaque();
    for (int i = tid; i < 2048 * 4; i += 512) { const int k = i >> 2, q = i & 3; const f32x4 v = *(const f32x4*)(w + (size_t)k * ldw + q * 4);
#pragma unroll
        for (int j = 0; j < 4; ++j) wt[(q * 4 + j) * 2048 + k] = v[j]; }
}
constexpr int N1_PITCH = 2048 * 2 + 16;
constexpr int N1_WT = 0, N1_HS = 16 * N1_PITCH, N1_GS = 2 * 16 * N1_PITCH, N1_PS = N1_GS + 16384, N1_END = N1_PS + 8 * 256 * 4;
__device__ __forceinline__ void phase_norm1(const Ptrs& p, LAS unsigned char* lds) {
    LAS float* gs = (LAS float*)(lds + N1_GS); LAS float* sh = gs + 2048; LAS float* ps = (LAS float*)(lds + N1_PS);
    const int tid = tid_opaque(), lane = tid & 63, wid = tid >> 6;
    for (int i = tid; i < 1024 * 4; i += 512) { const int kp = i >> 2, q = i & 3; const float* w = p.w_in + (size_t)(2 * kp) * NIN + W_F + q * 4;
        const f32x4 v0 = *(const f32x4*)w, v1 = *(const f32x4*)(w + NIN);
#pragma unroll
        for (int j = 0; j < 4; ++j) *(LAS unsigned*)(lds + N1_WT + (q * 4 + j) * N1_PITCH + kp * 4) = cvtpk(v0[j], v1[j]); }
    bf16_t* ha = (bf16_t*)(p.ws + OFF_HA); float* logf = (float*)(p.ws + OFF_LOGF);
    for (int blk = vwg_id(); blk < NTOK / 32; blk += gridDim.x) {
        const int b = (blk * 32) / S; const float* mod = (const float*)(p.ws + OFF_MOD) + (size_t)b * NMOD;
        __syncthreads();
        for (int i = tid; i < 2048; i += 512) { gs[i] = p.norm_mix_g[i] * (1.0f + mod[D + i]); sh[i] = mod[i]; }
        __syncthreads();
#pragma unroll 1
        for (int half = 0; half < 2; ++half) {
#pragma unroll 1
            for (int rr = 0; rr < 2; ++rr) {
                const int r16 = wid * 2 + rr, row = blk * 32 + half * 16 + r16; const float* xr = p.x + (size_t)row * D;
                f32x4 v[8]; float ss = 0.f;
#pragma unroll
                for (int c = 0; c < 8; ++c) { v[c] = *(const f32x4*)(xr + c * 256 + lane * 4); ss += v[c][0] * v[c][0] + v[c][1] * v[c][1] + v[c][2] * v[c][2] + v[c][3] * v[c][3]; }
                ss = wave_sum(ss); const float r = rsqrtf(ss * (1.0f / D) + EPS);
#pragma unroll
                for (int c = 0; c < 8; ++c) { const int k = c * 256 + lane * 4; const f32x4 g4 = *(const LAS f32x4*)(gs + k), s4 = *(const LAS f32x4*)(sh + k);
                    const f32x4 h4 = (v[c] * r) * g4 + s4; u32x2 w; w.x = cvtpk(h4[0], h4[1]); w.y = cvtpk(h4[2], h4[3]);
                    *(u32x2*)(ha + (size_t)row * D + k) = w; *(LAS u32x2*)(lds + N1_HS + r16 * N1_PITCH + k * 2) = w; }
            }
            __syncthreads();
            {
                f32x4 acc = {0.f, 0.f, 0.f, 0.f};
                const LAS unsigned char* ap = lds + N1_HS + (lane & 15) * N1_PITCH + wid * 512 + (lane >> 4) * 16;
                const LAS unsigned char* bp = lds + N1_WT + (lane & 15) * N1_PITCH + wid * 512 + (lane >> 4) * 16;
#pragma unroll
                for (int ks = 0; ks < 8; ++ks) acc = __builtin_amdgcn_mfma_f32_16x16x32_bf16(*(const LAS bf16x8*)(ap + ks * 64), *(const LAS bf16x8*)(bp + ks * 64), acc, 0, 0, 0);
#pragma unroll
                for (int i = 0; i < 4; ++i) ps[wid * 256 + (4 * (lane >> 4) + i) * 16 + (lane & 15)] = acc[i];
            }
            __syncthreads();
            if (tid < 256) { float z = p.b_forget[tid & 15];
#pragma unroll
                for (int w = 0; w < 8; ++w) z += ps[w * 256 + tid];
                const int row = blk * 32 + half * 16 + (tid >> 4);
                logf[((size_t)b * H + (tid & 15)) * S + (row % S)] = fminf(z, 0.f) - log1pf(__expf(-fabsf(z))); }
        }
    }
}
__device__ __forceinline__ void phase_scan_conv(const Ptrs& p, LAS unsigned char* lds) {
    const int tid = tid_opaque(), lane = tid & 63, wid = tid >> 6; LAS float* wtot = (LAS float*)lds;
    for (int sq = vwg_id(); sq < B * H; sq += gridDim.x) {
        const float* lf = (const float*)(p.ws + OFF_LOGF) + (size_t)sq * S; float* fc = (float*)(p.ws + OFF_FCUM) + (size_t)sq * S;
        f32x4 a = *(const f32x4*)(lf + tid * 8), b4 = *(const f32x4*)(lf + tid * 8 + 4);
        a[1] += a[0]; a[2] += a[1]; a[3] += a[2]; b4[0] += a[3]; b4[1] += b4[0]; b4[2] += b4[1]; b4[3] += b4[2];
        const float tot = b4[3]; float inc = tot;
#pragma unroll
        for (int o = 1; o < 64; o <<= 1) { const float n = __shfl_up(inc, o); if (lane >= o) inc += n; }
        __syncthreads();
        if (lane == 63) wtot[wid] = inc;
        __syncthreads();
        float off = inc - tot; for (int w = 0; w < wid; ++w) off += wtot[w];
        *(f32x4*)(fc + tid * 8) = (a + off) * -LOG2E; *(f32x4*)(fc + tid * 8 + 4) = (b4 + off) * -LOG2E;
    }
    const bf16_t* pr = (const bf16_t*)(p.ws + OFF_PROJ); bf16_t* ua = (bf16_t*)(p.ws + OFF_UA);
    for (int item = vwg_id() * 512 + tid; item < (NTOK / 8) * (DC / 8); item += gridDim.x * 512) {
        const int cg = item & 127, rc = item >> 7, r0 = rc * 8, c = cg * 8;
        float w0[8], w1[8], w2[8], pm2[8], pm1[8];
#pragma unroll
        for (int j = 0; j < 8; ++j) { w0[j] = p.conv_w[c + j]; w1[j] = p.conv_w[DC + c + j]; w2[j] = p.conv_w[2 * DC + c + j]; pm2[j] = 0.f; pm1[j] = 0.f; }
        if ((r0 % S) != 0) {
#pragma unroll
            for (int d = 0; d < 2; ++d) { const bf16_t* q = pr + (size_t)(r0 - 2 + d) * PLD; const u32x4 xc = *(const u32x4*)(q + C_XC + c), cc = *(const u32x4*)(q + C_CC + c);
#pragma unroll
                for (int j = 0; j < 4; ++j) { const float e0 = bflo(xc[j]) * bflo(cc[j]), e1 = bfhi(xc[j]) * bfhi(cc[j]); if (d == 0) { pm2[2 * j] = e0; pm2[2 * j + 1] = e1; } else { pm1[2 * j] = e0; pm1[2 * j + 1] = e1; } } }
        }
#pragma unroll
        for (int i = 0; i < 8; ++i) { const bf16_t* q = pr + (size_t)(r0 + i) * PLD; const u32x4 xc = *(const u32x4*)(q + C_XC + c), cc = *(const u32x4*)(q + C_CC + c), cb = *(const u32x4*)(q + C_CB + c);
            float o[8];
#pragma unroll
            for (int j = 0; j < 4; ++j) { const float e0 = bflo(xc[j]) * bflo(cc[j]), e1 = bfhi(xc[j]) * bfhi(cc[j]);
                o[2 * j] = bflo(cb[j]) * (w0[2 * j] * pm2[2 * j] + w1[2 * j] * pm1[2 * j] + w2[2 * j] * e0); o[2 * j + 1] = bfhi(cb[j]) * (w0[2 * j + 1] * pm2[2 * j + 1] + w1[2 * j + 1] * pm1[2 * j + 1] + w2[2 * j + 1] * e1);
                pm2[2 * j] = pm1[2 * j]; pm2[2 * j + 1] = pm1[2 * j + 1]; pm1[2 * j] = e0; pm1[2 * j + 1] = e1; }
            u32x4 w; w.x = cvtpk(o[0], o[1]); w.y = cvtpk(o[2], o[3]); w.z = cvtpk(o[4], o[5]); w.w = cvtpk(o[6], o[7]);
            *(u32x4*)(ua + (size_t)(r0 + i) * 2048 + c) = w; }
    }
}
typedef short s16x4 __attribute__((ext_vector_type(4)));
constexpr int A_SLOTB = 8192, A_LDS_K = 0, A_LDS_V = 3 * A_SLOTB, A_LDS_WS = 6 * A_SLOTB, A_LDS_OST = A_LDS_WS + 8 * 256, A_LDS_F = A_LDS_OST + 8 * 4096, ATT_LDS = A_LDS_F + S * 4;
#define A_THR 32.0f
#define A_SBAR() __builtin_amdgcn_sched_barrier(0)
#define A_PIN(x) asm volatile("" : "+v"(x))
#define A_MFMA(a, b, c) __builtin_amdgcn_mfma_f32_32x32x16_bf16(a, b, c, 0, 0, 0)
#define A_WAIT_BAR(N) asm volatile("s_waitcnt vmcnt(" #N ") lgkmcnt(0)\n\ts_barrier" ::: "memory")
__device__ __forceinline__ int crow(int r, int hi) { return (r & 3) + 8 * (r >> 2) + 4 * hi; }
__device__ __forceinline__ unsigned a_cvtpk(float lo, float hi) { unsigned r; asm("v_cvt_pk_bf16_f32 %0, %1, %2" : "=v"(r) : "v"(lo), "v"(hi)); return r; }
__device__ __forceinline__ void a_glds16(const void* g, unsigned lds_base) {
    unsigned sv; asm volatile("s_mov_b32 %0, m0\n\ts_mov_b32 m0, %2\n\ts_nop 0\n\tglobal_load_lds_dwordx4 %1, off\n\ts_mov_b32 m0, %0" : "=&s"(sv) : "v"(g), "s"(lds_base) : "memory"); }
typedef __attribute__((address_space(3))) const char* a_lds_cptr;
__device__ __forceinline__ void a_kload2(bf16x8* kf, a_lds_cptr kp, int d0) { kf[2 * d0] = *(const __attribute__((address_space(3))) bf16x8*)(kp + d0 * 2048); kf[2 * d0 + 1] = *(const __attribute__((address_space(3))) bf16x8*)(kp + d0 * 2048 + 512); }
__device__ __forceinline__ s16x4 a_vtr(a_lds_cptr p) { return __builtin_bit_cast(s16x4, __builtin_amdgcn_ds_read_tr16_b64_v4i16((__attribute__((address_space(3))) v4i16_t*)p)); }
#define A_MX3(a, b, c) __builtin_fmaxf(__builtin_fmaxf((a), (b)), (c))
__device__ __forceinline__ float a_rowmax(const f32x16& p0, const f32x16& p1) {
    float a = A_MX3(p0[0], p0[1], p1[0]), b = A_MX3(p0[2], p0[3], p1[1]); a = A_MX3(a, p1[2], p1[3]);
#pragma unroll
    for (int r = 4; r < 16; r += 4) { a = A_MX3(a, p0[r], p0[r + 1]); b = A_MX3(b, p0[r + 2], p0[r + 3]); a = A_MX3(a, p1[r], p1[r + 1]); b = A_MX3(b, p1[r + 2], p1[r + 3]); }
    float m = __builtin_fmaxf(a, b); auto rr = __builtin_amdgcn_permlane32_swap(__float_as_uint(m), __float_as_uint(m), false, false);
    return __builtin_fmaxf(__uint_as_float(rr[0]), __uint_as_float(rr[1])); }
__device__ __forceinline__ void a_cmask(f32x16& p0, f32x16& p1, int jb, int qrel, int hi) {
    const int kb = 64 * jb + 4 * hi;
#pragma unroll
    for (int r = 0; r < 16; ++r) { const int kv = kb + (r & 3) + 8 * (r >> 2); if (kv > qrel) p0[r] = -INFINITY; if (kv + 32 > qrel) p1[r] = -INFINITY; } }
#define A_FLD(X0, X1, fp_) do { _Pragma("unroll") for (int g_ = 0; g_ < 4; ++g_) { const f32x4 fa_ = *(const __attribute__((address_space(3))) f32x4*)((fp_) + g_ * 32), fb_ = *(const __attribute__((address_space(3))) f32x4*)((fp_) + 128 + g_ * 32); \
        _Pragma("unroll") for (int i_ = 0; i_ < 4; ++i_) { X0[4 * g_ + i_] = fa_[i_]; X1[4 * g_ + i_] = fb_[i_]; } } } while (0)
#define A_FRD2(G, X, fp_, g_) do { if (G) { const f32x4 fa_ = *(const __attribute__((address_space(3))) f32x4*)((fp_) + (g_) * 32), fb_ = *(const __attribute__((address_space(3))) f32x4*)((fp_) + (g_) * 32 + 32); \
        _Pragma("unroll") for (int i_ = 0; i_ < 4; ++i_) { X[4 * (g_) + i_] = fa_[i_]; X[4 * (g_) + 4 + i_] = fb_[i_]; } A_SBAR(); } } while (0)

__device__ __forceinline__ void attn64_unit(int b, int h, int qb, const bf16_t* Q, const bf16_t* __restrict__ K, const bf16_t* __restrict__ V, bf16_t* O, const float* __restrict__ nf, char* lds) {
    const int tid = tid_opaque(), lane = tid & 63, r32 = lane & 31, hi = lane >> 5; const int wid = __builtin_amdgcn_readfirstlane(tid >> 6);
    const long rowbase = (long)b * S; const int q0 = qb * 256, NT = (q0 + 256) / 64;
    const bf16_t* Qw = Q + (rowbase + q0 + wid * 32) * PLD + h * 64;
    const unsigned lds0 = (unsigned)(size_t)lds; float* wsf = (float*)(lds + A_LDS_WS) + wid * 64;
    const bf16_t* ksrc = K + rowbase * PLD + h * 64 + (long)lane * PLD + wid * 8;
    const bf16_t* vsrc = V + rowbase * PLD + h * 64 + (long)(16 * (wid & 3) + (lane >> 2)) * PLD + (wid >> 2) * 32 + (lane & 3) * 8;
    const unsigned kdst = lds0 + A_LDS_K + wid * 1024, vdst = lds0 + A_LDS_V + wid * 1024;
#define DMA_K(t, slot) a_glds16(ksrc + (long)(t) * 64 * PLD, (unsigned)__builtin_amdgcn_readfirstlane(kdst + (slot)))
#define DMA_V(t, slot) a_glds16(vsrc + (long)(t) * 64 * PLD, (unsigned)__builtin_amdgcn_readfirstlane(vdst + (slot)))
    const a_lds_cptr vp0 = (a_lds_cptr)lds + A_LDS_V + ((lane >> 4) & 1) * 32 + (lane & 3) * 8 + (4 * hi + ((lane & 15) >> 2)) * 64;
    const a_lds_cptr kp0 = (a_lds_cptr)lds + A_LDS_K + hi * 1024 + r32 * 16;
    const a_lds_cptr fp0 = (a_lds_cptr)lds + A_LDS_F + hi * 16;
    a_glds16(nf + 512 * wid + 4 * lane, (unsigned)__builtin_amdgcn_readfirstlane(lds0 + A_LDS_F + wid * 2048));
    a_glds16(nf + 512 * wid + 256 + 4 * lane, (unsigned)__builtin_amdgcn_readfirstlane(lds0 + A_LDS_F + wid * 2048 + 1024));
    DMA_K(0, 0); DMA_V(0, 0); DMA_K(1, A_SLOTB);
    bf16x8 qr[4];
#pragma unroll
    for (int d0 = 0; d0 < 4; ++d0) qr[d0] = *reinterpret_cast<const bf16x8*>(&Qw[(long)r32 * PLD + d0 * 16 + hi * 8]);
    float mhat = 0.f, l_reg = 0.f; f32x16 o[2];
#pragma unroll
    for (int r = 0; r < 16; ++r) { o[0][r] = 0.f; o[1][r] = 0.f; }
    const int qrel = wid * 32 + r32; bool resc = false;
    f32x16 pA0, pA1, pB0, pB1; bf16x8 kf[8]; s16x4 vlo[8], vhi[8]; u32x4 pw0, pw1, pw2, pw3;
    int sl_prev = 0, sl_cur = 0, sl_next = A_SLOTB;
#define ROT() do { sl_prev = sl_cur; sl_cur = sl_next; sl_next = (sl_next == 2 * A_SLOTB) ? 0 : sl_next + A_SLOTB; } while (0)
#define EX(v) __builtin_amdgcn_exp2f((v) + nmh)
#define RESC() do { if (resc) { _Pragma("unroll") for (int d_ = 0; d_ < 2; ++d_) _Pragma("unroll") for (int r = 0; r < 16; ++r) o[d_][r] *= wsf[crow(r, hi)]; } } while (0)
    DMA_K(2, 2 * A_SLOTB);
    A_WAIT_BAR(0);
    _Pragma("unroll") for (int d0 = 0; d0 < 4; ++d0) a_kload2(kf, kp0, d0);
    A_FLD(pA0, pA1, fp0);
    pA0 = A_MFMA(kf[0], qr[0], pA0); pA1 = A_MFMA(kf[1], qr[0], pA1); pA0 = A_MFMA(kf[2], qr[1], pA0); pA1 = A_MFMA(kf[3], qr[1], pA1);
    pA0 = A_MFMA(kf[4], qr[2], pA0); pA1 = A_MFMA(kf[5], qr[2], pA1); pA0 = A_MFMA(kf[6], qr[3], pA0); pA1 = A_MFMA(kf[7], qr[3], pA1);
    if (NT == 4) a_cmask(pA0, pA1, 0, qrel, hi);
    { const float rm = a_rowmax(pA0, pA1); mhat = rm; const float nmh = -mhat;
#pragma unroll
      for (int r = 0; r < 16; ++r) { pA0[r] = EX(pA0[r]); pA1[r] = EX(pA1[r]); } }
    A_FLD(pB0, pB1, fp0 + 256);
    A_WAIT_BAR(0);
    DMA_K(3, 0); DMA_V(1, A_SLOTB); ROT();
    _Pragma("unroll") for (int d0 = 0; d0 < 4; ++d0) a_kload2(kf, kp0 + sl_cur, d0);
    A_WAIT_BAR(2);
#define PKW(P, i) a_cvtpk(P[i], P[i + 1])
#define PAF(k) __builtin_bit_cast(bf16x8, pw##k)
#define VFR(i) (bf16x8){vlo[i][0], vlo[i][1], vlo[i][2], vlo[i][3], vhi[i][0], vhi[i][1], vhi[i][2], vhi[i][3]}
#define VRD(i) do { vlo[i] = a_vtr(vp_ + (((i) >> 2) * 4096 + ((i) & 3) * 1024)); vhi[i] = a_vtr(vp_ + (((i) >> 2) * 4096 + ((i) & 3) * 1024 + 512)); } while (0)
#define KRD(G, d0) do { if (G) { a_kload2(kf, kp0 + sl_next, d0); A_SBAR(); } } while (0)
#define GAPA(MF, a0, a1, a2, a3, W0, W1, PW) do { MF; sacc += a0; sacc += a1; sacc += a2; sacc += a3; W0; W1; A_PIN(PW); A_PIN(sacc); A_SBAR(); } while (0)
#define GAPB(MF, X, i) do { MF; X[i] = EX(X[i]); X[i + 1] = EX(X[i + 1]); X[i + 2] = EX(X[i + 2]); X[i + 3] = EX(X[i + 3]); A_PIN(X); A_SBAR(); } while (0)
#define STEP(C0, C1, P0, P1, t, MASK, GK, GV, GL) do { A_SBAR(); \
    const a_lds_cptr vp_ = vp0 + sl_prev; const a_lds_cptr fn_ = fp0 + ((t) + 1) * 256; \
    VRD(0); A_SBAR(); float sacc = P0[0] + P0[1]; \
                    GAPA(C0 = A_MFMA(kf[0], qr[0], C0), P0[2], P0[3], P0[4], P0[5],     pw0[0] = PKW(P0, 0),  pw0[1] = PKW(P0, 2),  pw0); \
    VRD(4); A_SBAR(); GAPA(C1 = A_MFMA(kf[1], qr[0], C1), P0[6], P0[7], P0[8], P0[9],     pw0[2] = PKW(P0, 4),  pw0[3] = PKW(P0, 6),  pw0); \
    VRD(1); A_SBAR(); GAPA(C0 = A_MFMA(kf[2], qr[1], C0),    P0[10], P0[11], P0[12], P0[13], pw1[0] = PKW(P0, 8),  pw1[1] = PKW(P0, 10), pw1); \
    VRD(5); A_SBAR(); GAPA(C1 = A_MFMA(kf[3], qr[1], C1),    P0[14], P0[15], P1[0], P1[1],   pw1[2] = PKW(P0, 12), pw1[3] = PKW(P0, 14), pw1); \
    VRD(2); A_SBAR(); GAPA(C0 = A_MFMA(kf[4], qr[2], C0),    P1[2], P1[3], P1[4], P1[5],     pw2[0] = PKW(P1, 0),  pw2[1] = PKW(P1, 2),  pw2); \
    VRD(6); A_SBAR(); GAPA(C1 = A_MFMA(kf[5], qr[2], C1),    P1[6], P1[7], P1[8], P1[9],     pw2[2] = PKW(P1, 4),  pw2[3] = PKW(P1, 6),  pw2); \
    VRD(3); A_SBAR(); GAPA(C0 = A_MFMA(kf[6], qr[3], C0),    P1[10], P1[11], P1[12], P1[13], pw3[0] = PKW(P1, 8),  pw3[1] = PKW(P1, 10), pw3); \
    VRD(7); A_SBAR(); GAPA(C1 = A_MFMA(kf[7], qr[3], C1),    P1[14], P1[15], 0.f, 0.f,       pw3[2] = PKW(P1, 12), pw3[3] = PKW(P1, 14), pw3); \
    l_reg += sacc; \
    if (GK) DMA_K((t) + 3, sl_cur); if (GV) DMA_V((t) + 1, sl_next); \
    if (MASK) a_cmask(C0, C1, (t) - (NT - 4), qrel, hi); \
    { const float rm = a_rowmax(C0, C1) - mhat; resc = false; \
      if (__builtin_expect(__any(rm > A_THR), 0)) { const float dl = __builtin_fmaxf(rm, 0.f); mhat += dl; \
          const float f = __builtin_amdgcn_exp2f(-dl); l_reg *= f; if (hi == 0) wsf[r32] = f; resc = true; } } \
    const float nmh = -mhat; A_SBAR(); \
    A_FRD2(GL, P0, fn_, 0); GAPB(o[0] = A_MFMA(PAF(0), VFR(0), o[0]), C0, 0);  A_FRD2(GL, P0, fn_, 2); GAPB(o[1] = A_MFMA(PAF(0), VFR(4), o[1]), C0, 4); \
    KRD(GL, 0); GAPB(o[0] = A_MFMA(PAF(1), VFR(1), o[0]), C0, 8);  KRD(GL, 1); GAPB(o[1] = A_MFMA(PAF(1), VFR(5), o[1]), C0, 12); \
    KRD(GL, 2); GAPB(o[0] = A_MFMA(PAF(2), VFR(2), o[0]), C1, 0);  KRD(GL, 3); GAPB(o[1] = A_MFMA(PAF(2), VFR(6), o[1]), C1, 4); \
    A_FRD2(GL, P1, fn_ + 128, 0); GAPB(o[0] = A_MFMA(PAF(3), VFR(3), o[0]), C1, 8);  A_FRD2(GL, P1, fn_ + 128, 2); GAPB(o[1] = A_MFMA(PAF(3), VFR(7), o[1]), C1, 12); \
    } while (0)
    int t = 1;
    for (; t + 5 < NT; t += 2) {
        STEP(pB0, pB1, pA0, pA1, t, false, true, true, true);     A_WAIT_BAR(2); RESC(); ROT();
        STEP(pA0, pA1, pB0, pB1, t + 1, false, true, true, true); A_WAIT_BAR(2); RESC(); ROT();
    }
#define ENDW(tt) do { if ((tt) + 3 < NT) { A_WAIT_BAR(2); } else if ((tt) + 2 < NT) { A_WAIT_BAR(1); } else { A_WAIT_BAR(0); } } while (0)
    for (; t + 1 < NT; t += 2) {
        STEP(pB0, pB1, pA0, pA1, t, true, (t + 3 < NT), (t + 1 < NT), (t + 1 < NT));         ENDW(t);     RESC(); ROT();
        STEP(pA0, pA1, pB0, pB1, t + 1, true, (t + 4 < NT), (t + 2 < NT), (t + 2 < NT));     ENDW(t + 1); RESC(); ROT();
    }
    STEP(pB0, pB1, pA0, pA1, NT - 1, true, false, false, false); RESC();
    { float sacc = pB0[0] + pB0[1];
#pragma unroll
      for (int r = 2; r < 16; ++r) sacc += pB0[r];
#pragma unroll
      for (int r = 0; r < 16; ++r) sacc += pB1[r];
      l_reg += sacc;
      pw0 = (u32x4){PKW(pB0, 0), PKW(pB0, 2), PKW(pB0, 4), PKW(pB0, 6)}; pw1 = (u32x4){PKW(pB0, 8), PKW(pB0, 10), PKW(pB0, 12), PKW(pB0, 14)};
      pw2 = (u32x4){PKW(pB1, 0), PKW(pB1, 2), PKW(pB1, 4), PKW(pB1, 6)}; pw3 = (u32x4){PKW(pB1, 8), PKW(pB1, 10), PKW(pB1, 12), PKW(pB1, 14)};
      const a_lds_cptr vp_ = vp0 + sl_cur; _Pragma("unroll") for (int i = 0; i < 8; ++i) VRD(i);
      o[0] = A_MFMA(PAF(0), VFR(0), o[0]); o[1] = A_MFMA(PAF(0), VFR(4), o[1]); o[0] = A_MFMA(PAF(1), VFR(1), o[0]); o[1] = A_MFMA(PAF(1), VFR(5), o[1]);
      o[0] = A_MFMA(PAF(2), VFR(2), o[0]); o[1] = A_MFMA(PAF(2), VFR(6), o[1]); o[0] = A_MFMA(PAF(3), VFR(3), o[0]); o[1] = A_MFMA(PAF(3), VFR(7), o[1]); }
    { auto rr = __builtin_amdgcn_permlane32_swap(__float_as_uint(l_reg), __float_as_uint(l_reg), false, false); l_reg = __uint_as_float(rr[0]) + __uint_as_float(rr[1]); }
    if (hi == 0) wsf[32 + r32] = l_reg; asm volatile("s_waitcnt lgkmcnt(0)" ::: "memory");
    float rli[16];
#pragma unroll
    for (int r = 0; r < 16; ++r) rli[r] = __builtin_amdgcn_rcpf(wsf[32 + crow(r, hi)]);
    bf16_t* Ow = O + (rowbase + q0 + wid * 32) * 2048 + h * 64; bf16_t* stg = (bf16_t*)(lds + A_LDS_OST) + wid * 2048;
#pragma unroll
    for (int r = 0; r < 16; ++r) { const int orow = crow(r, hi);
#pragma unroll
        for (int d0 = 0; d0 < 2; ++d0) stg[orow * 64 + d0 * 32 + r32] = (bf16_t)(a_cvtpk(o[d0][r] * rli[r], 0.f) & 0xffffu); }
    asm volatile("s_waitcnt lgkmcnt(0)" ::: "memory");
#pragma unroll
    for (int i = 0; i < 4; ++i) { const int row = i * 8 + (lane >> 3), ch = lane & 7; *(u32x4*)(Ow + (long)row * 2048 + ch * 8) = *(const u32x4*)(stg + row * 64 + ch * 8); }
    asm volatile("s_waitcnt lgkmcnt(0)\n\ts_barrier" ::: "memory");
#undef DMA_K
#undef DMA_V
#undef ROT
#undef EX
#undef RESC
#undef PKW
#undef PAF
#undef VFR
#undef VRD
#undef KRD
#undef ENDW
#undef GAPA
#undef GAPB
#undef STEP
}
__device__ __forceinline__ void phase_attn(const Ptrs& p, LAS unsigned char* lds) {
    const bf16_t* pr = (const bf16_t*)(p.ws + OFF_PROJ); bf16_t* ua = (bf16_t*)(p.ws + OFF_UA);
    for (int pi = vwg_id(); pi < 256; pi += gridDim.x) {
        const int s_ = pi & 7, bh = pi >> 3; const float* nf = (const float*)(p.ws + OFF_FCUM) + (size_t)bh * S;
#pragma unroll 1
        for (int half = 0; half < 2; ++half)
            attn64_unit(bh >> 4, bh & 15, half ? 15 - s_ : s_, pr + C_Q, pr + C_K, pr + C_V, ua + 1024, nf, (char*)lds);
    }
}
constexpr int R_PITCH = 512 * 2 + 16, R_WHI = 0, R_WLO = 32 * R_PITCH, R_HHI = 64 * R_PITCH, R_HLO = 96 * R_PITCH, R_GS = 128 * R_PITCH, R_LG = R_GS + 16384, R_TAB = R_LG + 4096, R_END = R_TAB + 2048;
__device__ __forceinline__ void phase_norm2_route(const Ptrs& p, LAS unsigned char* lds) {
    LAS float* gs = (LAS float*)(lds + R_GS); LAS float* sh = gs + 2048; LAS float* lg = (LAS float*)(lds + R_LG); LAS float* ps = (LAS float*)lds;
    const int tid = tid_opaque(), lane = tid & 63, wid = tid >> 6;
    bf16_t* ha = (bf16_t*)(p.ws + OFF_HA); const float* x1 = (const float*)(p.ws + OFF_X1);
    int* counts = (int*)(p.ws + OFF_CTRL); int* list = (int*)(p.ws + OFF_LIST); float* gate = (float*)(p.ws + OFF_GATE);
    for (int blk = vwg_id(); blk < NTOK / 32; blk += gridDim.x) {
        const int b = (blk * 32) / S; const float* mod = (const float*)(p.ws + OFF_MOD) + (size_t)b * NMOD;
        __syncthreads();
        for (int i = tid; i < 2048; i += 512) { gs[i] = p.norm_ffn_g[i] * (1.0f + mod[4 * D + i]); sh[i] = mod[3 * D + i]; }
        __syncthreads();
#pragma unroll 1
        for (int half = 0; half < 2; ++half) {
            f32x4 v[2][8];
#pragma unroll
            for (int q = 0; q < 2; ++q) { const int row = blk * 32 + half * 16 + wid * 2 + q; const float* xr = x1 + (size_t)row * D; float ss = 0.f;
#pragma unroll
                for (int c = 0; c < 8; ++c) { v[q][c] = *(const f32x4*)(xr + c * 256 + lane * 4); ss += v[q][c][0] * v[q][c][0] + v[q][c][1] * v[q][c][1] + v[q][c][2] * v[q][c][2] + v[q][c][3] * v[q][c][3]; }
                ss = wave_sum(ss); const float r = rsqrtf(ss * (1.0f / D) + EPS);
#pragma unroll
                for (int c = 0; c < 8; ++c) { const int k = c * 256 + lane * 4; const f32x4 g4 = *(const LAS f32x4*)(gs + k), s4 = *(const LAS f32x4*)(sh + k);
                    v[q][c] = (v[q][c] * r) * g4 + s4; u32x2 w; w.x = cvtpk(v[q][c][0], v[q][c][1]); w.y = cvtpk(v[q][c][2], v[q][c][3]); *(u32x2*)(ha + (size_t)row * D + k) = w; } }
            f32x4 acc[2];
            acc[0] = (f32x4){0.f, 0.f, 0.f, 0.f}; acc[1] = (f32x4){0.f, 0.f, 0.f, 0.f};
#pragma unroll
            for (int ch = 0; ch < 4; ++ch) {
                __syncthreads();
                for (int i = tid; i < 2048; i += 512) { const int kp = i >> 3, cq = i & 7; const float* w = p.router_w + (size_t)(512 * ch + 2 * kp) * E + cq * 4;
                    const f32x4 w0 = *(const f32x4*)w, w1 = *(const f32x4*)(w + E);
#pragma unroll
                    for (int j = 0; j < 4; ++j) { const unsigned hi = cvtpk(w0[j], w1[j]), lo = cvtpk(w0[j] - bflo(hi), w1[j] - bfhi(hi));
                        *(LAS unsigned*)(lds + R_WHI + (cq * 4 + j) * R_PITCH + kp * 4) = hi; *(LAS unsigned*)(lds + R_WLO + (cq * 4 + j) * R_PITCH + kp * 4) = lo; } }
#pragma unroll
                for (int q = 0; q < 2; ++q)
#pragma unroll
                    for (int cc = 0; cc < 2; ++cc) { const f32x4 h4 = v[q][2 * ch + cc]; u32x2 hi, lo; hi.x = cvtpk(h4[0], h4[1]); hi.y = cvtpk(h4[2], h4[3]);
                        lo.x = cvtpk(h4[0] - bflo(hi.x), h4[1] - bfhi(hi.x)); lo.y = cvtpk(h4[2] - bflo(hi.y), h4[3] - bfhi(hi.y));
                        const int o = (wid * 2 + q) * R_PITCH + (cc * 256 + lane * 4) * 2;
                        *(LAS u32x2*)(lds + R_HHI + o) = hi; *(LAS u32x2*)(lds + R_HLO + o) = lo; }
                __syncthreads();
#pragma unroll
                for (int s2 = 0; s2 < 2; ++s2) { const int off = (lane & 15) * R_PITCH + (2 * wid + s2) * 64 + (lane >> 4) * 16;
                    const bf16x8 ahi = *(const LAS bf16x8*)(lds + R_HHI + off), alo = *(const LAS bf16x8*)(lds + R_HLO + off);
#pragma unroll
                    for (int ct = 0; ct < 2; ++ct) { const bf16x8 bhi = *(const LAS bf16x8*)(lds + R_WHI + ct * 16 * R_PITCH + off), blo = *(const LAS bf16x8*)(lds + R_WLO + ct * 16 * R_PITCH + off);
                        acc[ct] = __builtin_amdgcn_mfma_f32_16x16x32_bf16(ahi, bhi, acc[ct], 0, 0, 0); acc[ct] = __builtin_amdgcn_mfma_f32_16x16x32_bf16(alo, bhi, acc[ct], 0, 0, 0);
                        acc[ct] = __builtin_amdgcn_mfma_f32_16x16x32_bf16(ahi, blo, acc[ct], 0, 0, 0); } }
            }
            __syncthreads();
#pragma unroll
            for (int ct = 0; ct < 2; ++ct)
#pragma unroll
                for (int i = 0; i < 4; ++i) ps[wid * 512 + (4 * (lane >> 4) + i) * 32 + ct * 16 + (lane & 15)] = acc[ct][i];
            __syncthreads();
            { const int o = tid; float z = p.router_b[o & 31];
#pragma unroll
              for (int w = 0; w < 8; ++w) z += ps[w * 512 + o];
              lg[half * 512 + o] = z; }
        }
        LAS int* lcnt = (LAS int*)(lds + R_TAB);
        LAS int* lbase = lcnt + 32;
        LAS int* asg_e = lbase + 32;
        LAS int* asg_r = asg_e + 128;
        if (tid < 32) lcnt[tid] = 0;
        __syncthreads();
#pragma unroll 1
        for (int rr = 0; rr < 4; ++rr) {
            const int rl = wid * 4 + rr, row = blk * 32 + rl;
            float val = (lane < 32) ? lg[rl * 32 + lane] : -INFINITY;
            float tv[4]; int ti[4];
#pragma unroll
            for (int k = 0; k < 4; ++k) { const float m = wave_max(val);
                const unsigned long long bal = __ballot(val == m); const int idx = __ffsll((long long)bal) - 1;
                tv[k] = m; ti[k] = idx; if (lane == idx) val = -INFINITY; }
            if (lane < 4) { float pe[4], sum = 0.f;
#pragma unroll
                for (int k = 0; k < 4; ++k) { pe[k] = __expf(tv[k] - tv[0]); sum += pe[k]; }
                const int e = lane == 0 ? ti[0] : lane == 1 ? ti[1] : lane == 2 ? ti[2] : ti[3]; const float pk = (lane == 0 ? pe[0] : lane == 1 ? pe[1] : lane == 2 ? pe[2] : pe[3]) / sum;
                const int lr = __hip_atomic_fetch_add((int*)(lcnt + e), 1, __ATOMIC_RELAXED, __HIP_MEMORY_SCOPE_WORKGROUP); asg_e[rl * 4 + lane] = e; asg_r[rl * 4 + lane] = lr; gate[row * 4 + lane] = pk; }
        }
        __syncthreads();
        if (tid < 32) lbase[tid] = atomicAdd(&counts[tid], lcnt[tid]);
        __syncthreads();
        if (tid < 128) { const int e = asg_e[tid]; list[(size_t)e * NTOK + lbase[e] + asg_r[tid]] = (blk * 32) * 4 + tid; }
    }
}
__device__ __forceinline__ void phase_final(const Ptrs& p, LAS unsigned char* lds) {
    const int tid = tid_opaque(), lane = tid & 63, wid = tid >> 6;
    const float* x1 = (const float*)(p.ws + OFF_X1); const bf16_t* y = (const bf16_t*)(p.ws + OFF_Y);
    for (int row = vwg_id() * 8 + wid; row < NTOK; row += gridDim.x * 8) {
        const int b = row / S; const float* gf = (const float*)(p.ws + OFF_MOD) + (size_t)b * NMOD + 5 * D; const float* xr = x1 + (size_t)row * D; const bf16_t* yr = y + (size_t)row * 4 * D;
        f32x4 v[8]; float ss = 0.f;
#pragma unroll
        for (int c = 0; c < 8; ++c) { const int k = c * 256 + lane * 4; f32x4 s = {0.f, 0.f, 0.f, 0.f};
#pragma unroll
            for (int q = 0; q < 4; ++q) { const u32x2 w = *(const u32x2*)(yr + (size_t)q * D + k); s[0] += bflo(w.x); s[1] += bfhi(w.x); s[2] += bflo(w.y); s[3] += bfhi(w.y); }
            v[c] = *(const f32x4*)(xr + k) + *(const f32x4*)(gf + k) * s; ss += v[c][0] * v[c][0] + v[c][1] * v[c][1] + v[c][2] * v[c][2] + v[c][3] * v[c][3]; }
        ss = wave_sum(ss); const float r = rsqrtf(ss * (1.0f / D) + EPS);
#pragma unroll
        for (int c = 0; c < 8; ++c) { const int k = c * 256 + lane * 4; *(f32x4*)(p.out + (size_t)row * D + k) = (v[c] * r) * *(const f32x4*)(p.final_g + k); }
    }
}

#define XB_TMO      128
#define XB_XCNT(j)  (256  + 64 * (j))
#define XB_XSUB(j)  (1280 + 64 * (j))
#define XB_XGEN(j)  (2304 + 64 * (j))
#define XB_TOP      3328
#define XB_TOPGEN   3392
#define XCD_BAR_WORDS 3456
#define XB_SPIN_CAP (1u << 18)

__device__ __forceinline__ unsigned xb_ld(unsigned* p)              { return __hip_atomic_load(p, __ATOMIC_RELAXED, __HIP_MEMORY_SCOPE_AGENT); }
__device__ __forceinline__ unsigned xb_add(unsigned* p, unsigned v) { return __hip_atomic_fetch_add(p, v, __ATOMIC_RELAXED, __HIP_MEMORY_SCOPE_AGENT); }
__device__ __forceinline__ unsigned xb_xcc_id() { return (unsigned)__builtin_amdgcn_s_getreg((3 << 11) | 20) & 0xFu; }
#define XB_SPIN(cond, bar) do { unsigned _sp = 0; while (cond) { __builtin_amdgcn_s_sleep(1); \
    if ((++_sp & 255u) == 0u) { if (xb_ld(&(bar)[XB_TMO])) break; if (_sp > XB_SPIN_CAP) { atomicAdd(&(bar)[XB_TMO], 1u); break; } } } } while (0)

struct XcdBarrier {
    unsigned* bar; unsigned x;
    volatile LAS unsigned* st;
};

__device__ __forceinline__ XcdBarrier xcd_barrier_post(unsigned* bar, volatile LAS unsigned* st) {
    XcdBarrier b; b.bar = bar; b.x = xb_xcc_id(); b.st = st;
    if (threadIdx.x == 0) (void)xb_add(&bar[XB_XCNT(b.x)], 1u);
    return b;
}
__device__ __forceinline__ void xcd_barrier_complete(unsigned* bar, unsigned x, unsigned& nloc, unsigned& nx) {
    const unsigned G = gridDim.x * gridDim.y * gridDim.z;
    unsigned sum, cnt, mine, sp = 0u;
    for (;;) {
        sum = 0u; cnt = 0u; mine = 0u;
#pragma unroll
        for (unsigned j = 0; j < 16; ++j) { const unsigned c = xb_ld(&bar[XB_XCNT(j)]); sum += c; cnt += (c > 0u) ? 1u : 0u; mine = (j == x) ? c : mine; }
        if (sum == G) break;
        __builtin_amdgcn_s_sleep(1);
        if ((++sp & 255u) == 0u) { if (xb_ld(&bar[XB_TMO])) break; if (sp > XB_SPIN_CAP) { atomicAdd(&bar[XB_TMO], 1u); break; } }
    }
    nloc = mine > 0u ? mine : 1u; nx = cnt > 0u ? cnt : 1u;
}

__device__ __forceinline__ void xcd_barrier(const XcdBarrier& b) {
    asm volatile("s_waitcnt vmcnt(0)" ::: "memory");
    __syncthreads();
    if (threadIdx.x == 0) {
        unsigned* bar = b.bar;
        __builtin_amdgcn_s_waitcnt(0);
        unsigned nloc = b.st[0], nx = b.st[1];
        if (nloc == 0u) { xcd_barrier_complete(bar, b.x, nloc, nx); b.st[0] = nloc; b.st[1] = nx; }
        const unsigned old = xb_add(&bar[XB_XSUB(b.x)], 1u);
        const unsigned gen = old / nloc;
        if (old + 1u == (gen + 1u) * nloc) {
            __builtin_amdgcn_fence(__ATOMIC_RELEASE, "agent");
            asm volatile("s_waitcnt vmcnt(0)" ::: "memory");
            const unsigned og = xb_add(&bar[XB_TOP], 1u);
            const unsigned tg = og / nx;
            if (og + 1u == (tg + 1u) * nx) xb_add(&bar[XB_TOPGEN], 1u);
            else XB_SPIN(xb_ld(&bar[XB_TOPGEN]) == tg, bar);
            __builtin_amdgcn_fence(__ATOMIC_ACQUIRE, "agent");
            xb_add(&bar[XB_XGEN(b.x)], 1u);
            asm volatile("s_waitcnt vmcnt(0)" ::: "memory");
        } else {
            XB_SPIN(xb_ld(&bar[XB_XGEN(b.x)]) == gen, bar);
            __builtin_amdgcn_fence(__ATOMIC_ACQUIRE, "agent");
            asm volatile("s_waitcnt vmcnt(0)" ::: "memory");
        }
    }
    __syncthreads();
}


constexpr int LDS_TOTAL = AUX_LDS + 16;
constexpr size_t OFF_BAR = OFF_CTRL + 4096;
static_assert(GEMM_LDS <= AUX_LDS && ATT_LDS <= AUX_LDS && N1_END <= AUX_LDS && R_END <= AUX_LDS, "LDS");
static_assert(4096 + XCD_BAR_WORDS * 4 <= 65536, "ctrl");
__global__ void __launch_bounds__(512, 2) mega_fwd(Ptrs p) {
    LAS unsigned char* lds = (LAS unsigned char*)dyn_lds;
    volatile LAS unsigned* st = (volatile LAS unsigned*)(lds + AUX_LDS);
    if (threadIdx.x == 0) { st[0] = 0u; st[1] = 0u; st[2] = 0u; st[3] = 0u; }
    __syncthreads();
    XcdBarrier bar = xcd_barrier_post((unsigned*)(p.ws + OFF_BAR), st);
    phase_mod(p, lds);          phase_prep(p, lds);         xcd_barrier(bar);
    phase_norm1(p, lds);        xcd_barrier(bar);
    phase_gemm1(p, lds);        xcd_barrier(bar);
    phase_scan_conv(p, lds);    xcd_barrier(bar);
    phase_attn(p, lds);         xcd_barrier(bar);
    phase_merge(p, lds);        xcd_barrier(bar);
    phase_out(p, lds);          xcd_barrier(bar);
    phase_norm2_route(p, lds);  xcd_barrier(bar);
    phase_moe_gu(p, lds);
    phase_moe_down(p, lds);     xcd_barrier(bar);
    phase_final(p, lds);
}

extern "C" void kernel_launch(void* const* d_in, const int* in_sizes, int n_in, void* d_out, int out_size, void* d_ws, size_t ws_size, hipStream_t stream) {
    Ptrs p{};
    const float** f = (const float**)&p;
    for (int i = 0; i < 21; ++i) f[i] = (const float*)d_in[i];
    p.out = (float*)d_out; p.ws = (unsigned char*)d_ws;
    static int grid = 0;
    if (!grid) {
        (void)hipFuncSetAttribute((const void*)mega_fwd, hipFuncAttributeMaxDynamicSharedMemorySize, LDS_TOTAL);
        int dev = 0, cus = 0, per_cu = 0;
        (void)hipGetDevice(&dev);
        (void)hipDeviceGetAttribute(&cus, hipDeviceAttributeMultiprocessorCount, dev);
        (void)hipOccupancyMaxActiveBlocksPerMultiprocessor(&per_cu, mega_fwd, 512, LDS_TOTAL);
        grid = cus * (per_cu < 1 ? per_cu : 1);
        if (grid <= 0) grid = cus > 0 ? cus : 256;
    }
    (void)hipMemsetAsync(p.ws + OFF_CTRL, 0, 65536, stream);
    mega_fwd<<<grid, 512, LDS_TOTAL, stream>>>(p);
}
```

```cpp
#include <hip/hip_runtime.h>
#include <stdint.h>

typedef unsigned short bf16_t;
typedef float f32x4 __attribute__((ext_vector_type(4)));
typedef unsigned u32x4 __attribute__((ext_vector_type(4)));
typedef unsigned u32x2 __attribute__((ext_vector_type(2)));

namespace cfg {
constexpr int B = 2, S = 4096, D = 2048, NTOK = B * S, H = 16, DH = 64, DA = 1024, DC = 1024;
constexpr int NIN = 10256, NMOD = 6 * D, E = 32, TOPK = 4, NASG = NTOK * TOPK;
constexpr int PLD = 10240;
constexpr int C_XC = 0, C_CB = 1024, C_CC = 2048, C_Q = 3072, C_K = 4096, C_V = 5120, C_GC = 6144, C_GA = 8192;
constexpr int W_F = 6144, W_GC = 6160, W_GA = 8208;
constexpr float EPS = 1e-6f, LOG2E = 1.4426950408889634f;
constexpr float QSCALE = 0.125f * LOG2E;
constexpr int ACT_ROWS = NASG + E * 256;
constexpr size_t al(size_t x) { return (x + 255) & ~(size_t)255; }
constexpr size_t OFF_CTRL = 0;
constexpr size_t OFF_MOD = 65536;
constexpr size_t OFF_LOGF = OFF_MOD + al((size_t)B * NMOD * 4);
constexpr size_t OFF_FCUM = OFF_LOGF + al((size_t)B * H * S * 4);
constexpr size_t OFF_HA = OFF_FCUM + al((size_t)B * H * S * 4);
constexpr size_t OFF_PROJ = OFF_HA + al((size_t)NTOK * D * 2);
constexpr size_t OFF_UA = OFF_PROJ + al((size_t)NTOK * PLD * 2);
constexpr size_t OFF_MRG = OFF_UA + al((size_t)NTOK * 2048 * 2);
constexpr size_t OFF_X1 = OFF_MRG + al((size_t)NTOK * D * 2);
constexpr size_t OFF_TMP = OFF_X1 + al((size_t)NTOK * D * 4);
constexpr size_t OFF_GATE = OFF_TMP + al((size_t)NTOK * D * 4);
constexpr size_t OFF_LIST = OFF_GATE + al((size_t)NASG * 4);
constexpr size_t OFF_ACT = OFF_LIST + al((size_t)E * NTOK * 4);
constexpr size_t OFF_Y = OFF_ACT + al((size_t)ACT_ROWS * D * 2);
constexpr size_t WS_END = OFF_Y + al((size_t)NASG * D * 2);
constexpr int WTP2 = D + 64, WTP1 = 1024 + 64;
constexpr size_t OFF_WTIN = WS_END;
constexpr size_t OFF_WTCO = OFF_WTIN + al((size_t)PLD * WTP2 * 2);
constexpr size_t OFF_WTAO = OFF_WTCO + al((size_t)D * WTP1 * 2);
constexpr size_t OFF_WTO = OFF_WTAO + al((size_t)D * WTP1 * 2);
constexpr size_t WS_END2 = OFF_WTO + al((size_t)D * WTP2 * 2);
}
using namespace cfg;

__device__ __forceinline__ float bf2f(bf16_t v) { return __uint_as_float(((unsigned)v) << 16); }
__device__ __forceinline__ bf16_t f2bf(float f) { unsigned u = __float_as_uint(f); u += 0x7fffu + ((u >> 16) & 1u); return (bf16_t)(u >> 16); }
__device__ __forceinline__ float sigmoidf_(float x) { return __builtin_amdgcn_rcpf(1.0f + __builtin_amdgcn_exp2f(x * -1.4426950408889634f)); }

struct Ptrs {
    const float *x, *c, *ada_w, *ada_b, *norm_mix_g, *w_in, *b_forget, *conv_w, *w_conv_out, *w_attn_out, *w_out, *norm_ffn_g,
        *router_w, *router_b, *w_gate, *b_gate, *w_up, *b_up, *w_down, *b_down, *final_g;
    float* out; unsigned char* ws;
};

#define LAS __attribute__((address_space(3)))
typedef short bf16x8 __attribute__((ext_vector_type(8)));
typedef float f32x2_t __attribute__((ext_vector_type(2)));
typedef __bf16 bf16x2_t __attribute__((ext_vector_type(2)));
__device__ __forceinline__ unsigned cvtpk(float lo, float hi) { f32x2_t v = {lo, hi}; bf16x2_t b = __builtin_convertvector(v, bf16x2_t); return __builtin_bit_cast(unsigned, b); }
__device__ __forceinline__ float bflo(unsigned w) { return __uint_as_float(w << 16); }
__device__ __forceinline__ float bfhi(unsigned w) { return __uint_as_float(w & 0xffff0000u); }
__device__ __forceinline__ int tid_opaque() { int t = threadIdx.x; asm volatile("" : "+v"(t)); return t; }
constexpr int GEMM_LDS = 131072;

struct GemmT {
    int wr, wc, fr, fq;
    int aR, aC;
    unsigned a_w;
    int b_k, b_col, b_p, b_gucol;
    unsigned b_w, b_rot;
    unsigned a_r, b_r;
    __device__ __forceinline__ void init_epi() { const int tid = tid_opaque(), wid = tid >> 6, lane = tid & 63; wr = wid >> 2; wc = wid & 3; fr = lane & 15; fq = lane >> 4; }
    __device__ __forceinline__ void init() {
        const int tid = tid_opaque(), wid = tid >> 6, lane = tid & 63;
        wr = wid >> 2; wc = wid & 3; fr = lane & 15; fq = lane >> 4;
        aR = (wid >> 1) * 16 + (lane >> 2); aC = (wid & 1) * 32 + (((lane & 3) ^ ((lane >> 5) << 1)) * 8);
        a_w = (unsigned)(wid * 1024 + lane * 16);
        { const int l32 = lane & 31, kc8 = 2 * (wid >> 1) + (lane >> 5), wc_ = l32 >> 3, bfq = (l32 >> 1) & 3, nlo = l32 & 1; b_p = wid & 1;
          b_k = kc8 * 8; b_col = wc_ * 64 + b_p * 32 + bfq * 8 + nlo * 4; b_gucol = wc_ * 32 + bfq * 8 + nlo * 4;
          const int sub = wc_ * 4 + 2 * b_p + nlo;
          b_w = (unsigned)((sub * 2 + (kc8 >> 2)) * 1024 + (((4 * bfq) * 64 + (kc8 & 3) * 16) ^ ((bfq >> 1) << 5))); b_rot = (unsigned)(nlo * 64); }
        const unsigned lo = (unsigned)((fr * 64 + fq * 16) ^ ((fr >> 3) << 5));
        a_r = (unsigned)(wr * 16384) + lo; b_r = 32768u + (unsigned)(wc * 8192) + lo;
    }
};

__device__ __forceinline__ void gemm_kloop(f32x4 (&acc)[8][4], LAS unsigned char* lds, const GemmT& T,
                                           __amdgpu_buffer_rsrc_t ra, unsigned ao0, unsigned ao1, unsigned ao2, unsigned ao3,
                                           __amdgpu_buffer_rsrc_t rb, unsigned bo, unsigned ldbB, int nt) {
    f32x4 sb[8];
    const unsigned a_wu = (unsigned)__builtin_amdgcn_readfirstlane((int)(T.a_w & ~1023u));
#define G_DMA_A(buf, t, i_) __builtin_amdgcn_raw_ptr_buffer_load_lds(ra, (LAS void*)(lds + (buf) * 65536 + a_wu + (i_) * 8192), 16, ao##i_, (unsigned)(t) * 128u, 0, 0)
#define G_ISSUE_B(t) do { const unsigned so_ = (unsigned)(t) * 64u * ldbB; _Pragma("unroll") for (int i_ = 0; i_ < 8; ++i_) sb[i_] = __builtin_bit_cast(f32x4, __builtin_amdgcn_raw_buffer_load_b128(rb, bo, so_ + (unsigned)i_ * ldbB, 0)); } while (0)
#define G_RETIRE() asm volatile("s_waitcnt vmcnt(0)" : "+v"(sb[0]), "+v"(sb[1]), "+v"(sb[2]), "+v"(sb[3]), "+v"(sb[4]), "+v"(sb[5]), "+v"(sb[6]), "+v"(sb[7]) :: "memory")
#define G_WRITE_B(buf) do { LAS unsigned char* d_ = lds + (buf) * 65536; \
        _Pragma("unroll") for (int j_ = 0; j_ < 4; ++j_) { u32x4 w_; w_.x = cvtpk(sb[0][j_], sb[1][j_]); w_.y = cvtpk(sb[2][j_], sb[3][j_]); w_.z = cvtpk(sb[4][j_], sb[5][j_]); w_.w = cvtpk(sb[6][j_], sb[7][j_]); \
            *(LAS u32x4*)(d_ + 32768 + T.b_w + ((T.b_rot + 64u * j_) & 255u)) = w_; } } while (0)
#define G_LDB(dst, buf, ks) do { const LAS unsigned char* s_ = lds + (buf) * 65536 + (ks) * 1024; _Pragma("unroll") for (int n_ = 0; n_ < 4; ++n_) dst[n_] = *(const LAS bf16x8*)(s_ + T.b_r + n_ * 2048); } while (0)
#define G_LDA(dst, buf, ks, h_) do { const LAS unsigned char* s_ = lds + (buf) * 65536 + (ks) * 1024; _Pragma("unroll") for (int m_ = 0; m_ < 4; ++m_) dst[m_] = *(const LAS bf16x8*)(s_ + T.a_r + ((h_) * 4 + m_) * 2048); } while (0)
#define G_MMA(At_, Bf_, h_) do { _Pragma("unroll") for (int m_ = 0; m_ < 4; ++m_) _Pragma("unroll") for (int n_ = 0; n_ < 4; ++n_) \
        acc[(h_) * 4 + m_][n_] = __builtin_amdgcn_mfma_f32_16x16x32_bf16(Bf_[n_], At_[m_], acc[(h_) * 4 + m_][n_], 0, 0, 0); } while (0)
#define G_SB() __builtin_amdgcn_sched_barrier(0)
#define G_BAR() do { asm volatile("s_waitcnt lgkmcnt(0)" ::: "memory"); __builtin_amdgcn_s_barrier(); asm volatile("" ::: "memory"); } while (0)
    bf16x8 Bf0[4], Bf1[4], AtA[4], AtB[4];
    G_ISSUE_B(0); G_DMA_A(0, 0, 0); G_DMA_A(0, 0, 1); G_DMA_A(0, 0, 2); G_DMA_A(0, 0, 3); G_RETIRE(); G_WRITE_B(0);
    if (nt > 1) G_ISSUE_B(1);
    G_BAR();
    for (int t = 0; t < nt; ++t) { const int cur = t & 1; const bool w1 = t + 1 < nt, i2 = t + 2 < nt;
        G_LDB(Bf0, cur, 0); G_LDA(AtA, cur, 0, 0); G_SB();
        G_LDA(AtB, cur, 0, 1); if (w1) { G_DMA_A(cur ^ 1, t + 1, 0); G_DMA_A(cur ^ 1, t + 1, 1); G_DMA_A(cur ^ 1, t + 1, 2); G_DMA_A(cur ^ 1, t + 1, 3); } G_MMA(AtA, Bf0, 0); G_SB();
        G_LDB(Bf1, cur, 1); G_LDA(AtA, cur, 1, 0); G_MMA(AtB, Bf0, 1); G_SB();
        G_LDA(AtB, cur, 1, 1); if (w1) { G_RETIRE(); G_WRITE_B(cur ^ 1); } if (i2) G_ISSUE_B(t + 2); G_MMA(AtA, Bf1, 0); G_SB();
        G_MMA(AtB, Bf1, 1); G_SB();
        G_BAR(); }
#undef G_LDA
#undef G_MMA
#undef G_SB
#undef G_DMA_A
#undef G_ISSUE_B
#undef G_WRITE_B
#undef G_RETIRE
#undef G_LDB
}
__device__ __forceinline__ void gemm_kloop_light(f32x4 (&acc)[8][4], LAS unsigned char* lds, const GemmT& T,
                                                 __amdgpu_buffer_rsrc_t ra, unsigned ao0, unsigned ao1, unsigned ao2, unsigned ao3,
                                                 __amdgpu_buffer_rsrc_t rb, unsigned bo, unsigned ldbB, int nt, int mlim) {
    f32x4 sb[8];
    const unsigned a_wu = (unsigned)__builtin_amdgcn_readfirstlane((int)(T.a_w & ~1023u));
#define G_DMA_A(buf, t, i_) __builtin_amdgcn_raw_ptr_buffer_load_lds(ra, (LAS void*)(lds + (buf) * 65536 + a_wu + (i_) * 8192), 16, ao##i_, (unsigned)(t) * 128u, 0, 0)
#define G_ISSUE_B(t) do { const unsigned so_ = (unsigned)(t) * 64u * ldbB; _Pragma("unroll") for (int i_ = 0; i_ < 8; ++i_) sb[i_] = __builtin_bit_cast(f32x4, __builtin_amdgcn_raw_buffer_load_b128(rb, bo, so_ + (unsigned)i_ * ldbB, 0)); } while (0)
#define G_RETIRE() asm volatile("s_waitcnt vmcnt(0)" : "+v"(sb[0]), "+v"(sb[1]), "+v"(sb[2]), "+v"(sb[3]), "+v"(sb[4]), "+v"(sb[5]), "+v"(sb[6]), "+v"(sb[7]) :: "memory")
#define G_WRITE_B(buf) do { LAS unsigned char* d_ = lds + (buf) * 65536; \
        _Pragma("unroll") for (int j_ = 0; j_ < 4; ++j_) { u32x4 w_; w_.x = cvtpk(sb[0][j_], sb[1][j_]); w_.y = cvtpk(sb[2][j_], sb[3][j_]); w_.z = cvtpk(sb[4][j_], sb[5][j_]); w_.w = cvtpk(sb[6][j_], sb[7][j_]); \
            *(LAS u32x4*)(d_ + 32768 + T.b_w + ((T.b_rot + 64u * j_) & 255u)) = w_; } } while (0)
    G_ISSUE_B(0); G_DMA_A(0, 0, 0); G_DMA_A(0, 0, 1); G_DMA_A(0, 0, 2); G_DMA_A(0, 0, 3); G_RETIRE(); G_WRITE_B(0);
    if (nt > 1) G_ISSUE_B(1);
    G_BAR();
    for (int t = 0; t < nt; ++t) { const int cur = t & 1; const bool w1 = t + 1 < nt, i2 = t + 2 < nt;
        if (w1) { G_DMA_A(cur ^ 1, t + 1, 0); G_DMA_A(cur ^ 1, t + 1, 1); G_DMA_A(cur ^ 1, t + 1, 2); G_DMA_A(cur ^ 1, t + 1, 3); }
        if (mlim > 0) {
#pragma unroll
            for (int ks = 0; ks < 2; ++ks) { const LAS unsigned char* s_ = lds + cur * 65536 + ks * 1024; bf16x8 Bf_[4];
#pragma unroll
                for (int n_ = 0; n_ < 4; ++n_) Bf_[n_] = *(const LAS bf16x8*)(s_ + T.b_r + n_ * 2048);
#pragma unroll
                for (int m_ = 0; m_ < 8; ++m_) if (m_ < mlim) { const bf16x8 At_ = *(const LAS bf16x8*)(s_ + T.a_r + m_ * 2048);
#pragma unroll
                    for (int n_ = 0; n_ < 4; ++n_) acc[m_][n_] = __builtin_amdgcn_mfma_f32_16x16x32_bf16(Bf_[n_], At_, acc[m_][n_], 0, 0, 0); } } }
        if (w1) { G_RETIRE(); G_WRITE_B(cur ^ 1); }
        if (i2) G_ISSUE_B(t + 2);
        G_BAR(); }
#undef G_DMA_A
#undef G_ISSUE_B
#undef G_RETIRE
#undef G_WRITE_B
}
__device__ __forceinline__ __amdgpu_buffer_rsrc_t mk_rsrc(const void* p) { return __builtin_amdgcn_make_buffer_rsrc((void*)p, 0, 0x7ffffff0, 0x00020000); }
__device__ __forceinline__ void acc_zero(f32x4 (&acc)[8][4]) {
#pragma unroll
    for (int m = 0; m < 8; ++m)
#pragma unroll
        for (int n = 0; n < 4; ++n) acc[m][n] = (f32x4){0.f, 0.f, 0.f, 0.f};
}
__device__ __forceinline__ f32x4 rot1(const f32x4 a) { return (f32x4){a[1], a[2], a[3], a[0]}; }
__device__ __forceinline__ f32x4 rotinv(const f32x4 a) { return (f32x4){a[3], a[0], a[1], a[2]}; }
__device__ __forceinline__ u32x4 pack8(const f32x4 a, const f32x4 b) { u32x4 w; w.x = cvtpk(a[0], a[1]); w.y = cvtpk(a[2], a[3]); w.z = cvtpk(b[0], b[1]); w.w = cvtpk(b[2], b[3]); return w; }
__device__ __forceinline__ int vwg_id() { const int G = gridDim.x; return (G % 8 == 0) ? (int)((blockIdx.x % 8) * (G / 8) + blockIdx.x / 8) : (int)blockIdx.x; }

__device__ __forceinline__ void g8_stage_rc(int b, int& R, int& C) { const int st = b / 1024, sb = b % 1024, swz = sb ^ (((sb >> 9) & 1) << 5); R = (st >> 1) * 16 + swz / 64; C = (st & 1) * 32 + (swz % 64) / 2; }
__device__ __forceinline__ int g8_lds_byte(int r, int c) { const int st = (r >> 4) * 2 + (c >> 5), rr = r & 15, cc = c & 31, ob = rr * 64 + cc * 2; return st * 1024 + (ob ^ (((ob >> 9) & 1) << 5)); }
__device__ __forceinline__ void gemm8_issue0(char* shm_, const bf16_t* A, long lda, const bf16_t* Bt, long ldb) {
    constexpr int HT = 128 * 64; bf16_t* shm = (bf16_t*)shm_; const int tid = tid_opaque();
#define G8I_STAGE(P, BASE, LD, br) do { const long g_ = (long)(br) * (LD); \
    for (int i_ = 0; i_ < 2; ++i_) { const int b_ = tid * 16 + i_ * 8192; int r_, c_; g8_stage_rc(b_, r_, c_); \
      __builtin_amdgcn_global_load_lds((const unsigned*)((BASE) + g_ + (long)r_ * (LD) + c_), (__attribute__((address_space(3))) unsigned*)((__attribute__((address_space(3))) char*)(P) + b_), 16, 0, 0); } } while (0)
    G8I_STAGE(shm + 4 * HT, Bt, ldb, 0); G8I_STAGE(shm, A, lda, 0); G8I_STAGE(shm + 5 * HT, Bt, ldb, 128); G8I_STAGE(shm + HT, A, lda, 128);
#undef G8I_STAGE
}
__device__ __forceinline__ void gemm8_kloop(f32x4 (&acc)[2][2][4][2], char* shm_, const bf16_t* A, long lda, const bf16_t* Bt, long ldb, int nt) {
    constexpr int HT = 128 * 64;
    bf16_t* shm = (bf16_t*)shm_;
#define G8_SA(b, h) (shm + ((b) * 2 + (h)) * HT)
#define G8_SB(b, h) (shm + (4 + (b) * 2 + (h)) * HT)
#define G8_STAGE_X(T_, P, BASE, LD, br, kt) do { const long g_ = (long)(br) * (LD) + (long)(kt) * 64; \
    for (int i_ = 0; i_ < 2; ++i_) { const int b_ = (T_) * 16 + i_ * 8192; int r_, c_; g8_stage_rc(b_, r_, c_); \
      __builtin_amdgcn_global_load_lds((const unsigned*)((BASE) + g_ + (long)r_ * (LD) + c_), (__attribute__((address_space(3))) unsigned*)((__attribute__((address_space(3))) char*)(P) + b_), 16, 0, 0); } } while (0)
#define G8_STAGE(P, BASE, LD, br, kt) G8_STAGE_X(tid, P, BASE, LD, br, kt)
#define G8_LDA(dst, b, h) for (int m = 0; m < 4; ++m) for (int k = 0; k < 2; ++k) dst[m][k] = *reinterpret_cast<const bf16x8*>((char*)G8_SA(b, h) + g8_lds_byte(wr * 64 + m * 16 + fr, k * 32 + fq * 8))
#define G8_LDB(dst, b, h) for (int n = 0; n < 2; ++n) for (int k = 0; k < 2; ++k) dst[n][k] = *reinterpret_cast<const bf16x8*>((char*)G8_SB(b, h) + g8_lds_byte(wc * 32 + n * 16 + fr, k * 32 + fq * 8))
#define G8_MMA(ai, bj, At, Bt_) do { __builtin_amdgcn_s_setprio(1); \
    for (int m = 0; m < 4; ++m) for (int n = 0; n < 2; ++n) for (int k = 0; k < 2; ++k) \
      acc[ai][bj][m][n] = __builtin_amdgcn_mfma_f32_16x16x32_bf16(Bt_[n][k], At[m][k], acc[ai][bj][m][n], 0, 0, 0); \
    __builtin_amdgcn_s_setprio(0); } while (0)
#define G8_WAIT_V(n) asm volatile("s_waitcnt vmcnt(" #n ")" ::: "memory")
#define G8_WAIT_L(n) asm volatile("s_waitcnt lgkmcnt(" #n ")" ::: "memory")
#define G8_BAR __builtin_amdgcn_s_barrier()
#define G8_SCHED __builtin_amdgcn_sched_barrier(0)
    const int tid = tid_opaque(); int wid = tid >> 6, lane = tid & 63, wr = wid >> 2, wc = wid & 3, fr = lane & 15, fq = lane >> 4;
    bf16x8 At[4][2], B0[2][2], B1[2][2];
    if (wr == 1) G8_BAR;
    G8_WAIT_V(4); G8_BAR;
    G8_STAGE(G8_SB(1, 0), Bt, ldb, 0, 1); G8_STAGE(G8_SA(1, 0), A, lda, 0, 1); G8_STAGE(G8_SB(1, 1), Bt, ldb, 128, 1);
    G8_WAIT_V(6); G8_BAR;
    for (int t = 0; t < nt - 2; t += 2) {
        G8_LDB(B0, 0, 0); G8_SCHED; G8_LDA(At, 0, 0); G8_STAGE(G8_SA(1, 1), A, lda, 128, t + 1);
        G8_WAIT_L(8); G8_BAR; G8_WAIT_L(0); G8_MMA(0, 0, At, B0); G8_BAR; G8_SCHED;
        G8_LDB(B1, 0, 1); G8_STAGE(G8_SB(0, 0), Bt, ldb, 0, t + 2);
        G8_BAR; G8_WAIT_L(0); G8_MMA(0, 1, At, B1); G8_BAR;
        G8_LDA(At, 0, 1); G8_STAGE(G8_SA(0, 0), A, lda, 0, t + 2);
        G8_BAR; G8_WAIT_L(0); G8_MMA(1, 0, At, B0); G8_BAR; G8_SCHED;
        G8_STAGE(G8_SB(0, 1), Bt, ldb, 128, t + 2);
        G8_WAIT_V(6); G8_BAR; G8_MMA(1, 1, At, B1); G8_BAR;
        G8_LDB(B0, 1, 0); G8_SCHED; G8_LDA(At, 1, 0); G8_STAGE(G8_SA(0, 1), A, lda, 128, t + 2);
        G8_WAIT_L(8); G8_BAR; G8_WAIT_L(0); G8_MMA(0, 0, At, B0); G8_BAR; G8_SCHED;
        G8_LDB(B1, 1, 1); G8_STAGE(G8_SB(1, 0), Bt, ldb, 0, t + 3);
        G8_BAR; G8_WAIT_L(0); G8_MMA(0, 1, At, B1); G8_BAR;
        G8_LDA(At, 1, 1); G8_STAGE(G8_SA(1, 0), A, lda, 0, t + 3);
        G8_BAR; G8_WAIT_L(0); G8_MMA(1, 0, At, B0); G8_BAR; G8_SCHED;
        G8_STAGE(G8_SB(1, 1), Bt, ldb, 128, t + 3);
        G8_WAIT_V(6); G8_BAR; G8_MMA(1, 1, At, B1); G8_BAR;
    }
    int tz = tid_opaque(); wid = tz >> 6; lane = tz & 63; wr = wid >> 2; wc = wid & 3; fr = lane & 15; fq = lane >> 4;
    { G8_LDB(B0, 0, 0); G8_WAIT_V(0); G8_LDA(At, 0, 0); G8_STAGE_X(tz, G8_SA(1, 1), A, lda, 128, nt - 1);
      G8_BAR; G8_WAIT_L(0); G8_MMA(0, 0, At, B0); G8_BAR;
      G8_LDB(B1, 0, 1); G8_BAR; G8_WAIT_L(0); G8_MMA(0, 1, At, B1); G8_BAR;
      G8_LDA(At, 0, 1); G8_WAIT_V(4); G8_BAR; G8_WAIT_L(0); G8_MMA(1, 0, At, B0); G8_MMA(1, 1, At, B1); G8_BAR; }
    { G8_LDB(B0, 1, 0); G8_LDA(At, 1, 0); G8_WAIT_V(2); G8_BAR; G8_WAIT_L(0); G8_MMA(0, 0, At, B0); G8_BAR;
      G8_LDB(B1, 1, 1); G8_WAIT_V(0); G8_BAR; G8_WAIT_L(0); G8_MMA(0, 1, At, B1); G8_BAR;
      G8_LDA(At, 1, 1); G8_BAR; G8_WAIT_L(0); G8_MMA(1, 0, At, B0); G8_MMA(1, 1, At, B1); G8_BAR; }
    if (wr == 0) G8_BAR;
}
#define G8_ZERO(acc) do { _Pragma("unroll") for (int a_ = 0; a_ < 2; ++a_) _Pragma("unroll") for (int b_ = 0; b_ < 2; ++b_) _Pragma("unroll") for (int m_ = 0; m_ < 4; ++m_) _Pragma("unroll") for (int n_ = 0; n_ < 2; ++n_) acc[a_][b_][m_][n_] = (f32x4){0.f, 0.f, 0.f, 0.f}; } while (0)
__device__ __forceinline__ void prep_tile(const float* W, size_t ldw, int k0, int nsrc0, bf16_t* WT, size_t ldt, int ndst0, LAS unsigned char* lds) {
    LAS unsigned* T = (LAS unsigned*)lds;
    const int tid = tid_opaque();
#pragma unroll
    for (int i = 0; i < 4; ++i) { const int it = tid + 512 * i, nq = (it & 15) + 16 * ((it >> 6) & 3), kp = ((it >> 4) & 3) + 4 * (it >> 8);
        const float* w = W + (size_t)(k0 + 2 * kp) * ldw + nsrc0 + 4 * nq; const f32x4 w0 = *(const f32x4*)w, w1 = *(const f32x4*)(w + ldw);
#pragma unroll
        for (int j = 0; j < 4; ++j) T[(4 * nq + j) * 33 + kp] = cvtpk(w0[j], w1[j]); }
    __syncthreads();
    { const int n = tid >> 1, hh = tid & 1; u32x4 o[4];
#pragma unroll
      for (int q = 0; q < 4; ++q)
#pragma unroll
          for (int j = 0; j < 4; ++j) o[q][j] = T[n * 33 + hh * 16 + q * 4 + j];
      bf16_t* d = WT + (size_t)(ndst0 + n) * ldt + k0 + hh * 32;
#pragma unroll
      for (int q = 0; q < 4; ++q) *(u32x4*)(d + q * 8) = o[q]; }
    __syncthreads();
}
__device__ __forceinline__ void phase_prep(const Ptrs& p, LAS unsigned char* lds) {
    bf16_t* wtin = (bf16_t*)(p.ws + OFF_WTIN); bf16_t* wtco = (bf16_t*)(p.ws + OFF_WTCO); bf16_t* wtao = (bf16_t*)(p.ws + OFF_WTAO); bf16_t* wto = (bf16_t*)(p.ws + OFF_WTO);
    for (int t = vwg_id(); t < 1792; t += gridDim.x) {
        if (t < 1280) { const int kb = t & 31, nb = t >> 5, pc = nb * 256; prep_tile(p.w_in, NIN, kb * 64, pc < C_GC ? pc : pc + (W_GC - C_GC), wtin, WTP2, pc, lds); }
        else if (t < 1408) { const int q = t - 1280, kb = q & 15, nb = q >> 4; prep_tile(p.w_conv_out, D, kb * 64, nb * 256, wtco, WTP1, nb * 256, lds); }
        else if (t < 1536) { const int q = t - 1408, kb = q & 15, nb = q >> 4; prep_tile(p.w_attn_out, D, kb * 64, nb * 256, wtao, WTP1, nb * 256, lds); }
        else { const int q = t - 1536, kb = q & 31, nb = q >> 5; prep_tile(p.w_out, D, kb * 64, nb * 256, wto, WTP2, nb * 256, lds); }
    }
}
__device__ __forceinline__ void phase_gemm1(const Ptrs& p, LAS unsigned char* lds) {
    const bf16_t* ha = (const bf16_t*)(p.ws + OFF_HA); bf16_t* pr = (bf16_t*)(p.ws + OFF_PROJ); const bf16_t* wtin = (const bf16_t*)(p.ws + OFF_WTIN);
#define G1_A(u_) (ha + (size_t)((((u_) >> 3) & 31) * 256) * D)
#define G1_B(u_) (wtin + (size_t)((((u_) & 7) + 8 * ((u_) >> 8)) * 256) * WTP2)
    { const int u0 = vwg_id(); if (u0 < 32 * 40) gemm8_issue0((char*)lds, G1_A(u0), D, G1_B(u0), WTP2); }
    for (int u = vwg_id(); u < 32 * 40; u += gridDim.x) {
        const int pm = (u >> 3) & 31, pn = (u & 7) + 8 * (u >> 8);
        const int row0 = pm * 256, pcol0 = pn * 256;
        f32x4 acc[2][2][4][2]; G8_ZERO(acc);
        gemm8_kloop(acc, (char*)lds, G1_A(u), D, G1_B(u), WTP2, D / 64);
        { const int un = u + (int)gridDim.x; if (un < 32 * 40) gemm8_issue0((char*)lds, G1_A(un), D, G1_B(un), WTP2); }
        const int tid = tid_opaque(), wid = tid >> 6, lane = tid & 63, wr = wid >> 2, wc = wid & 3, fr = lane & 15, fq = lane >> 4;
        const int mode = (pcol0 >= C_GC) ? 2 : ((pcol0 >= C_Q && pcol0 < C_K) ? 1 : 0);
        const int cst = (fq & 1) ? 16 + 4 * (fq - 1) : 4 * fq;
#pragma unroll
        for (int ai = 0; ai < 2; ++ai)
#pragma unroll
            for (int m = 0; m < 4; ++m) { bf16_t* prow = pr + (size_t)(row0 + ai * 128 + wr * 64 + m * 16 + fr) * PLD + pcol0 + wc * 32 + cst;
#pragma unroll
                for (int bj = 0; bj < 2; ++bj) { f32x4 v0 = acc[ai][bj][m][0], v1 = acc[ai][bj][m][1];
                    if (mode == 1) { v0 *= QSCALE; v1 *= QSCALE; }
                    else if (mode == 2) {
#pragma unroll
                        for (int j = 0; j < 4; ++j) { v0[j] = sigmoidf_(v0[j]); v1[j] = sigmoidf_(v1[j]); } }
#pragma unroll
                    for (int j = 0; j < 4; ++j) { const auto r = __builtin_amdgcn_permlane16_swap(__float_as_uint(v0[j]), __float_as_uint(v1[j]), false, false); v0[j] = __uint_as_float(r[0]); v1[j] = __uint_as_float(r[1]); }
                    *(u32x4*)(prow + bj * 128) = pack8(v0, v1); } }
    }
#undef G1_A
#undef G1_B
}
__device__ __forceinline__ void phase_merge(const Ptrs& p, LAS unsigned char* lds) {
    const bf16_t* ua = (const bf16_t*)(p.ws + OFF_UA); const bf16_t* pr = (const bf16_t*)(p.ws + OFF_PROJ); bf16_t* mg = (bf16_t*)(p.ws + OFF_MRG);
    const bf16_t* wtco = (const bf16_t*)(p.ws + OFF_WTCO); const bf16_t* wtao = (const bf16_t*)(p.ws + OFF_WTAO);
    for (int u = vwg_id(); u < 32 * 8; u += gridDim.x) {
        const int pm = u >> 3, pn = u & 7, row0 = pm * 256, col0 = pn * 256;
        f32x4 acc[2][2][4][2]; G8_ZERO(acc);
        gemm8_issue0((char*)lds, ua + (size_t)row0 * 2048, 2048, wtco + (size_t)col0 * WTP1, WTP1);
#pragma unroll 1
        for (int seg = 0; seg < 2; ++seg) {
            gemm8_kloop(acc, (char*)lds, ua + (size_t)row0 * 2048 + seg * 1024, 2048, (seg ? wtao : wtco) + (size_t)col0 * WTP1, WTP1, 1024 / 64);
            if (seg == 0) gemm8_issue0((char*)lds, ua + (size_t)row0 * 2048 + 1024, 2048, wtao + (size_t)col0 * WTP1, WTP1);
            else { const int un = u + (int)gridDim.x; if (un < 32 * 8) gemm8_issue0((char*)lds, ua + (size_t)((un >> 3) * 256) * 2048, 2048, wtco + (size_t)((un & 7) * 256) * WTP1, WTP1); }
            const int tid = tid_opaque(), wid = tid >> 6, lane = tid & 63, wr = wid >> 2, wc = wid & 3, fr = lane & 15, fq = lane >> 4;
#pragma unroll
            for (int ai = 0; ai < 2; ++ai)
#pragma unroll
                for (int m = 0; m < 4; ++m) { const int row = row0 + ai * 128 + wr * 64 + m * 16 + fr;
#pragma unroll
                    for (int bj = 0; bj < 2; ++bj)
#pragma unroll
                        for (int n = 0; n < 2; ++n) { const int c = col0 + bj * 128 + wc * 32 + n * 16 + fq * 4; const size_t o = (size_t)row * PLD + c;
                            const u32x2 sa = *(const u32x2*)(pr + o + C_GA); u32x2 sc = sa; if (seg == 0) sc = *(const u32x2*)(pr + o + C_GC);
                            f32x4 v = acc[ai][bj][m][n];
                            const float a0 = bflo(sa.x), a1 = bfhi(sa.x), a2 = bflo(sa.y), a3 = bfhi(sa.y);
                            if (seg == 0) { v[0] *= bflo(sc.x) * __builtin_amdgcn_rcpf(a0); v[1] *= bfhi(sc.x) * __builtin_amdgcn_rcpf(a1); v[2] *= bflo(sc.y) * __builtin_amdgcn_rcpf(a2); v[3] *= bfhi(sc.y) * __builtin_amdgcn_rcpf(a3); }
                            else { v[0] *= a0; v[1] *= a1; v[2] *= a2; v[3] *= a3; }
                            acc[ai][bj][m][n] = v;
                            if (seg == 1) { u32x2 w; w.x = cvtpk(v[0], v[1]); w.y = cvtpk(v[2], v[3]); *(u32x2*)(mg + (size_t)row * D + c) = w; } }
                    asm volatile("" ::: "memory"); }
        }
    }
}
__device__ __forceinline__ void phase_out(const Ptrs& p, LAS unsigned char* lds) {
    const bf16_t* mg = (const bf16_t*)(p.ws + OFF_MRG); float* x1 = (float*)(p.ws + OFF_X1); const float* mod = (const float*)(p.ws + OFF_MOD); const bf16_t* wto = (const bf16_t*)(p.ws + OFF_WTO);
    for (int u = vwg_id(); u < 32 * 8; u += gridDim.x) {
        const int pm = u >> 3, pn = u & 7, row0 = pm * 256, col0 = pn * 256;
        f32x4 acc[2][2][4][2]; G8_ZERO(acc);
        if (u == vwg_id()) gemm8_issue0((char*)lds, mg + (size_t)row0 * D, D, wto + (size_t)col0 * WTP2, WTP2);
        gemm8_kloop(acc, (char*)lds, mg + (size_t)row0 * D, D, wto + (size_t)col0 * WTP2, WTP2, D / 64);
        { const int un = u + (int)gridDim.x; if (un < 32 * 8) gemm8_issue0((char*)lds, mg + (size_t)((un >> 3) * 256) * D, D, wto + (size_t)((un & 7) * 256) * WTP2, WTP2); }
        const int tid = tid_opaque(), wid = tid >> 6, lane = tid & 63, wr = wid >> 2, wc = wid & 3, fr = lane & 15, fq = lane >> 4;
        const float* gm = mod + (size_t)(row0 / S) * NMOD + 2 * D;
#pragma unroll
        for (int ai = 0; ai < 2; ++ai)
#pragma unroll
            for (int m = 0; m < 4; ++m) { const int row = row0 + ai * 128 + wr * 64 + m * 16 + fr;
#pragma unroll
                for (int bj = 0; bj < 2; ++bj)
#pragma unroll
                    for (int n = 0; n < 2; ++n) { const int c = col0 + bj * 128 + wc * 32 + n * 16 + fq * 4; const size_t o = (size_t)row * D + c;
                        *(f32x4*)(x1 + o) = *(const f32x4*)(p.x + o) + *(const f32x4*)(gm + c) * acc[ai][bj][m][n]; } }
    }
}
constexpr size_t OFF_GUTOT = OFF_CTRL + 1024;
constexpr size_t OFF_GUDONE = OFF_CTRL + 2048;
struct MoeUnit { int e, mt, nt, cnt, base, light; };
__device__ __forceinline__ bool moe_unit(int cv, int u, int ntiles_n, MoeUnit& mu) {
    int base = 0;
#pragma unroll
    for (int e = 0; e < E; ++e) { const int c = __builtin_amdgcn_readlane(cv, e), tm = (c + 255) >> 8, nu = tm * ntiles_n;
        if (u < nu) { mu.e = e; mu.cnt = c; mu.base = base; mu.nt = u / tm; mu.mt = u - mu.nt * tm; mu.light = (mu.mt == tm - 1 && c - mu.mt * 256 <= 128) ? 1 : 0; return true; }
        u -= nu; base += tm * 256; }
    return false;
}
__device__ __forceinline__ void phase_moe_gu(const Ptrs& p, LAS unsigned char* lds) {
    const int* counts = (const int*)(p.ws + OFF_CTRL); const bf16_t* h2 = (const bf16_t*)(p.ws + OFF_HA); bf16_t* act = (bf16_t*)(p.ws + OFF_ACT);
    const __amdgpu_buffer_rsrc_t ract = __builtin_amdgcn_make_buffer_rsrc((void*)act, 0, 0x7ffffff0, 0x00020000);
    MoeUnit mu; const int cv = counts[tid_opaque() & 31];
    for (int u = vwg_id(); moe_unit(cv, u, 16, mu); u += gridDim.x) {
        GemmT T; T.init();
        const int* list = (const int*)(p.ws + OFF_LIST) + (size_t)mu.e * NTOK; const int i0 = mu.mt * 256, n0 = mu.nt * 128;
        unsigned ao[4];
#pragma unroll
        for (int i = 0; i < 4; ++i) { const int r = i0 + T.aR + 64 * i; const int tok = (r < mu.cnt) ? (list[r] >> 2) : 0; ao[i] = (unsigned)((tok * D + T.aC) * 2); }
        const float* wsel = ((__builtin_amdgcn_readfirstlane(T.b_p) & 1) ? p.w_up : p.w_gate) + (size_t)mu.e * D * D + n0;
        const unsigned bo = (unsigned)((T.b_k * D + T.b_gucol) * 4);
        f32x4 acc[8][4]; acc_zero(acc);
        const int mlim = __builtin_amdgcn_readfirstlane(T.wr) ? 0 : ((mu.cnt - i0 + 15) >> 4);
        if (mu.light) gemm_kloop_light(acc, lds, T, mk_rsrc(h2), ao[0], ao[1], ao[2], ao[3], mk_rsrc(wsel), bo, D * 4u, D / 64, mlim);
        else gemm_kloop(acc, lds, T, mk_rsrc(h2), ao[0], ao[1], ao[2], ao[3], mk_rsrc(wsel), bo, D * 4u, D / 64);
T.init_epi();
        const int c = n0 + T.wc * 32 + T.fq * 8;
        const float* bg = p.b_gate + (size_t)mu.e * D + c; const float* bu = p.b_up + (size_t)mu.e * D + c;
        const f32x4 bg0 = *(const f32x4*)bg, bg1 = *(const f32x4*)(bg + 4), bu0 = *(const f32x4*)bu, bu1 = *(const f32x4*)(bu + 4);
#pragma unroll
        for (int m = 0; m < 8; ++m) { const int r = i0 + T.wr * 128 + m * 16 + T.fr;
            f32x4 g0 = acc[m][0] + bg0, g1 = rot1(acc[m][1]) + bg1, u0 = acc[m][2] + bu0, u1 = rot1(acc[m][3]) + bu1;
#pragma unroll
            for (int j = 0; j < 4; ++j) { float g = fminf(g0[j], 7.0f), uu = fminf(fmaxf(u0[j], -7.0f), 7.0f); g0[j] = (uu + 1.0f) * g * sigmoidf_(1.702f * g);
                g = fminf(g1[j], 7.0f); uu = fminf(fmaxf(u1[j], -7.0f), 7.0f); g1[j] = (uu + 1.0f) * g * sigmoidf_(1.702f * g); }
            if (r < mu.cnt) __builtin_amdgcn_raw_buffer_store_b128(pack8(g0, g1), ract, (unsigned)(((mu.base + r) * D + c) * 2), 0, 16); }
        asm volatile("s_waitcnt vmcnt(0)" ::: "memory");
        __syncthreads();
        if (threadIdx.x == 0) { __hip_atomic_fetch_add((unsigned*)(p.ws + OFF_GUDONE) + mu.e * 16, 1u, __ATOMIC_RELAXED, __HIP_MEMORY_SCOPE_AGENT);
                                __hip_atomic_fetch_add((unsigned*)(p.ws + OFF_GUTOT), 1u, __ATOMIC_RELAXED, __HIP_MEMORY_SCOPE_AGENT); }
    }
}
__device__ __forceinline__ void phase_moe_down(const Ptrs& p, LAS unsigned char* lds) {
    const int* counts = (const int*)(p.ws + OFF_CTRL); const bf16_t* act = (const bf16_t*)(p.ws + OFF_ACT); bf16_t* y = (bf16_t*)(p.ws + OFF_Y); const float* gate = (const float*)(p.ws + OFF_GATE);
    MoeUnit mu; const int cv = counts[tid_opaque() & 31];
    int Ttot = 0;
#pragma unroll
    for (int e = 0; e < E; ++e) Ttot += (__builtin_amdgcn_readlane(cv, e) + 255) >> 8;
    const int G = (int)gridDim.x, Ugu = Ttot * 16, u0 = ((vwg_id() - Ugu % G) % G + G) % G;
    LAS int* wslot = (LAS int*)(lds + GEMM_LDS + 4096);
    int all_done = 0;
    for (int u = u0; moe_unit(cv, u, 8, mu); u += G) {
        if (!all_done) {
            if (threadIdx.x == 0) {
                unsigned* tot = (unsigned*)(p.ws + OFF_GUTOT); unsigned* de = (unsigned*)(p.ws + OFF_GUDONE) + mu.e * 16;
                const unsigned need = (unsigned)(((mu.cnt + 255) >> 8) * 16); int all = 0;
                for (unsigned sp = 0; sp < (1u << 22); ++sp) {
                    if (__hip_atomic_load(tot, __ATOMIC_RELAXED, __HIP_MEMORY_SCOPE_AGENT) >= (unsigned)Ugu) { all = 1; break; }
                    if (__hip_atomic_load(de, __ATOMIC_RELAXED, __HIP_MEMORY_SCOPE_AGENT) >= need) break;
                    __builtin_amdgcn_s_sleep(8); }
                __builtin_amdgcn_fence(__ATOMIC_ACQUIRE, "agent");
                *wslot = all; }
            asm volatile("s_waitcnt vmcnt(0)" ::: "memory");
            __syncthreads();
            all_done = __builtin_amdgcn_readfirstlane(*wslot);
            __syncthreads(); }
        GemmT T; T.init();
        const int* list = (const int*)(p.ws + OFF_LIST) + (size_t)mu.e * NTOK; const int i0 = mu.mt * 256, col0 = mu.nt * 256;
        const unsigned ao = (unsigned)((T.aR * D + T.aC) * 2), bo = (unsigned)((T.b_k * D + T.b_col) * 4);
        int pa = -1; float pg = 0.f;
        { const int t_ = tid_opaque(); if (t_ < 256 && i0 + t_ < mu.cnt) { pa = list[i0 + t_]; pg = gate[pa]; } }
        f32x4 acc[8][4]; acc_zero(acc);
        const int mlim = __builtin_amdgcn_readfirstlane(T.wr) ? 0 : ((mu.cnt - i0 + 15) >> 4);
        if (mu.light) gemm_kloop_light(acc, lds, T, mk_rsrc(act + (size_t)(mu.base + i0) * D), ao, ao + 64u * 4096, ao + 128u * 4096, ao + 192u * 4096,
                                       mk_rsrc(p.w_down + (size_t)mu.e * D * D + col0), bo, D * 4u, D / 64, mlim);
        else gemm_kloop(acc, lds, T, mk_rsrc(act + (size_t)(mu.base + i0) * D), ao, ao + 64u * 4096, ao + 128u * 4096, ao + 192u * 4096,
                        mk_rsrc(p.w_down + (size_t)mu.e * D * D + col0), bo, D * 4u, D / 64);
T.init_epi();
        LAS int* tab = (LAS int*)(lds + GEMM_LDS);
        { const int t_ = tid_opaque(); if (t_ < 256) { tab[2 * t_] = pa; tab[2 * t_ + 1] = __float_as_int(pg); } }
        __syncthreads();
        const float* bd = p.b_down + (size_t)mu.e * D;
#pragma unroll
        for (int m = 0; m < 8; ++m) { const int rl = T.wr * 128 + m * 16 + T.fr, r = i0 + rl;
            if (r < mu.cnt) { const int a = tab[2 * rl]; const float gt = __int_as_float(tab[2 * rl + 1]);
#pragma unroll
                for (int pp = 0; pp < 2; ++pp) { const int c = col0 + T.wc * 64 + pp * 32 + T.fq * 8;
                    const f32x4 v0 = (acc[m][2 * pp] + *(const f32x4*)(bd + c)) * gt, v1 = (rot1(acc[m][2 * pp + 1]) + *(const f32x4*)(bd + c + 4)) * gt;
                    *(u32x4*)(y + (size_t)a * D + c) = pack8(v0, v1); } } }
        __syncthreads();
    }
}
extern __shared__ __attribute__((aligned(1024))) unsigned char dyn_lds[];
typedef float f32x16 __attribute__((ext_vector_type(16)));
typedef short v4i16_t __attribute__((ext_vector_type(4)));
__device__ __forceinline__ float xhalf_max(float v) { const auto rr = __builtin_amdgcn_permlane32_swap(__float_as_uint(v), __float_as_uint(v), false, false); return fmaxf(__uint_as_float(rr[0]), __uint_as_float(rr[1])); }
__device__ __forceinline__ float xhalf_sum(float v) { const auto rr = __builtin_amdgcn_permlane32_swap(__float_as_uint(v), __float_as_uint(v), false, false); return __uint_as_float(rr[0]) + __uint_as_float(rr[1]); }
template <int CTRL> __device__ __forceinline__ float dppf(float x) { return __builtin_bit_cast(float, __builtin_amdgcn_mov_dpp(__builtin_bit_cast(int, x), CTRL, 0xf, 0xf, true)); }
constexpr int DPP_XOR1 = 0xB1, DPP_XOR2 = 0x4E, DPP_XOR7 = 0x141, DPP_XOR8 = 0x128;
__device__ __forceinline__ float xrow_sum(float x) { const auto s = __builtin_amdgcn_permlane16_swap(__float_as_uint(x), __float_as_uint(x), false, false); x = __uint_as_float(s[0]) + __uint_as_float(s[1]); return xhalf_sum(x); }
__device__ __forceinline__ float xrow_max(float x) { const auto s = __builtin_amdgcn_permlane16_swap(__float_as_uint(x), __float_as_uint(x), false, false); x = fmaxf(__uint_as_float(s[0]), __uint_as_float(s[1])); return xhalf_max(x); }
__device__ __forceinline__ float wave_sum(float v) { v += dppf<DPP_XOR1>(v); v += dppf<DPP_XOR2>(v); v += dppf<DPP_XOR7>(v); v += dppf<DPP_XOR8>(v); return xrow_sum(v); }
__device__ __forceinline__ float wave_max(float v) { v = fmaxf(v, dppf<DPP_XOR1>(v)); v = fmaxf(v, dppf<DPP_XOR2>(v)); v = fmaxf(v, dppf<DPP_XOR7>(v)); v = fmaxf(v, dppf<DPP_XOR8>(v)); return xrow_max(v); }
__device__ __forceinline__ float reduce16(float (&v)[16], int lane) {
    float a[8], b[4], c[2];
#pragma unroll
    for (int i = 0; i < 8; ++i) { const auto r = __builtin_amdgcn_permlane32_swap(__float_as_uint(v[i]), __float_as_uint(v[i + 8]), false, false); a[i] = __uint_as_float(r[0]) + __uint_as_float(r[1]); }
#pragma unroll
    for (int i = 0; i < 4; ++i) { const auto r = __builtin_amdgcn_permlane16_swap(__float_as_uint(a[i]), __float_as_uint(a[i + 4]), false, false); b[i] = __uint_as_float(r[0]) + __uint_as_float(r[1]); }
#pragma unroll
    for (int i = 0; i < 2; ++i) { const float t1 = b[i] + dppf<DPP_XOR8>(b[i]), t2 = b[i + 2] + dppf<DPP_XOR8>(b[i + 2]); c[i] = (lane & 8) ? t2 : t1; }
    float d; { const float t1 = c[0] + dppf<DPP_XOR7>(c[0]), t2 = c[1] + dppf<DPP_XOR7>(c[1]); d = (lane & 4) ? t2 : t1; }
    d += dppf<DPP_XOR1>(d); d += dppf<DPP_XOR2>(d);
    return d;
}
constexpr int WT_LDS = 16 * 2048 * 4;
constexpr int AUX_LDS = 160 * 1024 - 64;

__device__ __forceinline__ void phase_mod(const Ptrs& p, LAS unsigned char* lds) {
    LAS float* sc = (LAS float*)lds;
    LAS float* red = (LAS float*)(lds + 16384);
    const int tid = tid_opaque();
    for (int i = tid; i < B * D; i += 512) { const float v = p.c[i]; sc[i] = v / (1.0f + __expf(-v)); }
    __syncthreads();
    float* mod = (float*)(p.ws + OFF_MOD);
    for (int ch = vwg_id(); ch < NMOD / 48; ch += gridDim.x) {
        const int cq = tid % 12, kg = tid / 12;
        if (kg < 42) {
            f32x4 a0 = {0.f, 0.f, 0.f, 0.f}, a1 = {0.f, 0.f, 0.f, 0.f};
            const float* wp = p.ada_w + (size_t)ch * 48 + cq * 4;
#pragma unroll 7
            for (int k = kg; k < D; k += 42) { const f32x4 w = *(const f32x4*)(wp + (size_t)k * NMOD); a0 += w * sc[k]; a1 += w * sc[D + k]; }
#pragma unroll
            for (int j = 0; j < 4; ++j) { red[kg * 96 + cq * 4 + j] = a0[j]; red[kg * 96 + 48 + cq * 4 + j] = a1[j]; }
        }
        __syncthreads();
        if (tid < 96) { float s = 0.f; for (int g = 0; g < 42; ++g) s += red[g * 96 + tid]; const int b = tid / 48, c = ch * 48 + tid % 48; mod[(size_t)b * NMOD + c] = s + p.ada_b[c]; }
        __syncthreads();
    }
}
__device__ __forceinline__ void stage_wt16(LAS float* wt, const float* w, size_t ldw) {
    const int tid = tid_opaque();
    for (int i = tid; i < 2048 * 4; i += 512) { const int k = i >> 2, q = i & 3; const f32x4 v = *(const f32x4*)(w + (size_t)k * ldw + q * 4);
#pragma unroll
        for (int j = 0; j < 4; ++j) wt[(q * 4 + j) * 2048 + k] = v[j]; }
}
constexpr int N1_PITCH = 2048 * 2 + 16;
constexpr int N1_WT = 0, N1_HS = 16 * N1_PITCH, N1_GS = 2 * 16 * N1_PITCH, N1_PS = N1_GS + 16384, N1_END = N1_PS + 8 * 256 * 4;
__device__ __forceinline__ void phase_norm1(const Ptrs& p, LAS unsigned char* lds) {
    LAS float* gs = (LAS float*)(lds + N1_GS); LAS float* sh = gs + 2048; LAS float* ps = (LAS float*)(lds + N1_PS);
    const int tid = tid_opaque(), lane = tid & 63, wid = tid >> 6;
    for (int i = tid; i < 1024 * 4; i += 512) { const int kp = i >> 2, q = i & 3; const float* w = p.w_in + (size_t)(2 * kp) * NIN + W_F + q * 4;
        const f32x4 v0 = *(const f32x4*)w, v1 = *(const f32x4*)(w + NIN);
#pragma unroll
        for (int j = 0; j < 4; ++j) *(LAS unsigned*)(lds + N1_WT + (q * 4 + j) * N1_PITCH + kp * 4) = cvtpk(v0[j], v1[j]); }
    bf16_t* ha = (bf16_t*)(p.ws + OFF_HA); float* logf = (float*)(p.ws + OFF_LOGF);
    for (int blk = vwg_id(); blk < NTOK / 32; blk += gridDim.x) {
        const int b = (blk * 32) / S; const float* mod = (const float*)(p.ws + OFF_MOD) + (size_t)b * NMOD;
        __syncthreads();
        for (int i = tid; i < 2048; i += 512) { gs[i] = p.norm_mix_g[i] * (1.0f + mod[D + i]); sh[i] = mod[i]; }
        __syncthreads();
#pragma unroll 1
        for (int half = 0; half < 2; ++half) {
#pragma unroll 1
            for (int rr = 0; rr < 2; ++rr) {
                const int r16 = wid * 2 + rr, row = blk * 32 + half * 16 + r16; const float* xr = p.x + (size_t)row * D;
                f32x4 v[8]; float ss = 0.f;
#pragma unroll
                for (int c = 0; c < 8; ++c) { v[c] = *(const f32x4*)(xr + c * 256 + lane * 4); ss += v[c][0] * v[c][0] + v[c][1] * v[c][1] + v[c][2] * v[c][2] + v[c][3] * v[c][3]; }
                ss = wave_sum(ss); const float r = rsqrtf(ss * (1.0f / D) + EPS);
#pragma unroll
                for (int c = 0; c < 8; ++c) { const int k = c * 256 + lane * 4; const f32x4 g4 = *(const LAS f32x4*)(gs + k), s4 = *(const LAS f32x4*)(sh + k);
                    const f32x4 h4 = (v[c] * r) * g4 + s4; u32x2 w; w.x = cvtpk(h4[0], h4[1]); w.y = cvtpk(h4[2], h4[3]);
                    *(u32x2*)(ha + (size_t)row * D + k) = w; *(LAS u32x2*)(lds + N1_HS + r16 * N1_PITCH + k * 2) = w; }
            }
            __syncthreads();
            {
                f32x4 acc = {0.f, 0.f, 0.f, 0.f};
                const LAS unsigned char* ap = lds + N1_HS + (lane & 15) * N1_PITCH + wid * 512 + (lane >> 4) * 16;
                const LAS unsigned char* bp = lds + N1_WT + (lane & 15) * N1_PITCH + wid * 512 + (lane >> 4) * 16;
#pragma unroll
                for (int ks = 0; ks < 8; ++ks) acc = __builtin_amdgcn_mfma_f32_16x16x32_bf16(*(const LAS bf16x8*)(ap + ks * 64), *(const LAS bf16x8*)(bp + ks * 64), acc, 0, 0, 0);
#pragma unroll
                for (int i = 0; i < 4; ++i) ps[wid * 256 + (4 * (lane >> 4) + i) * 16 + (lane & 15)] = acc[i];
            }
            __syncthreads();
            if (tid < 256) { float z = p.b_forget[tid & 15];
#pragma unroll
                for (int w = 0; w < 8; ++w) z += ps[w * 256 + tid];
                const int row = blk * 32 + half * 16 + (tid >> 4);
                logf[((size_t)b * H + (tid & 15)) * S + (row % S)] = fminf(z, 0.f) - log1pf(__expf(-fabsf(z))); }
        }
    }
}
__device__ __forceinline__ void phase_scan_conv(const Ptrs& p, LAS unsigned char* lds) {
    const int tid = tid_opaque(), lane = tid & 63, wid = tid >> 6; LAS float* wtot = (LAS float*)lds;
    for (int sq = vwg_id(); sq < B * H; sq += gridDim.x) {
        const float* lf = (const float*)(p.ws + OFF_LOGF) + (size_t)sq * S; float* fc = (float*)(p.ws + OFF_FCUM) + (size_t)sq * S;
        f32x4 a = *(const f32x4*)(lf + tid * 8), b4 = *(const f32x4*)(lf + tid * 8 + 4);
        a[1] += a[0]; a[2] += a[1]; a[3] += a[2]; b4[0] += a[3]; b4[1] += b4[0]; b4[2] += b4[1]; b4[3] += b4[2];
        const float tot = b4[3]; float inc = tot;
#pragma unroll
        for (int o = 1; o < 64; o <<= 1) { const float n = __shfl_up(inc, o); if (lane >= o) inc += n; }
        __syncthreads();
        if (lane == 63) wtot[wid] = inc;
        __syncthreads();
        float off = inc - tot; for (int w = 0; w < wid; ++w) off += wtot[w];
        *(f32x4*)(fc + tid * 8) = (a + off) * -LOG2E; *(f32x4*)(fc + tid * 8 + 4) = (b4 + off) * -LOG2E;
    }
    const bf16_t* pr = (const bf16_t*)(p.ws + OFF_PROJ); bf16_t* ua = (bf16_t*)(p.ws + OFF_UA);
    for (int item = vwg_id() * 512 + tid; item < (NTOK / 8) * (DC / 8); item += gridDim.x * 512) {
        const int cg = item & 127, rc = item >> 7, r0 = rc * 8, c = cg * 8;
        float w0[8], w1[8], w2[8], pm2[8], pm1[8];
#pragma unroll
        for (int j = 0; j < 8; ++j) { w0[j] = p.conv_w[c + j]; w1[j] = p.conv_w[DC + c + j]; w2[j] = p.conv_w[2 * DC + c + j]; pm2[j] = 0.f; pm1[j] = 0.f; }
        if ((r0 % S) != 0) {
#pragma unroll
            for (int d = 0; d < 2; ++d) { const bf16_t* q = pr + (size_t)(r0 - 2 + d) * PLD; const u32x4 xc = *(const u32x4*)(q + C_XC + c), cc = *(const u32x4*)(q + C_CC + c);
#pragma unroll
                for (int j = 0; j < 4; ++j) { const float e0 = bflo(xc[j]) * bflo(cc[j]), e1 = bfhi(xc[j]) * bfhi(cc[j]); if (d == 0) { pm2[2 * j] = e0; pm2[2 * j + 1] = e1; } else { pm1[2 * j] = e0; pm1[2 * j + 1] = e1; } } }
        }
#pragma unroll
        for (int i = 0; i < 8; ++i) { const bf16_t* q = pr + (size_t)(r0 + i) * PLD; const u32x4 xc = *(const u32x4*)(q + C_XC + c), cc = *(const u32x4*)(q + C_CC + c), cb = *(const u32x4*)(q + C_CB + c);
            float o[8];
#pragma unroll
            for (int j = 0; j < 4; ++j) { const float e0 = bflo(xc[j]) * bflo(cc[j]), e1 = bfhi(xc[j]) * bfhi(cc[j]);
                o[2 * j] = bflo(cb[j]) * (w0[2 * j] * pm2[2 * j] + w1[2 * j] * pm1[2 * j] + w2[2 * j] * e0); o[2 * j + 1] = bfhi(cb[j]) * (w0[2 * j + 1] * pm2[2 * j + 1] + w1[2 * j + 1] * pm1[2 * j + 1] + w2[2 * j + 1] * e1);
                pm2[2 * j] = pm1[2 * j]; pm2[2 * j + 1] = pm1[2 * j + 1]; pm1[2 * j] = e0; pm1[2 * j + 1] = e1; }
            u32x4 w; w.x = cvtpk(o[0], o[1]); w.y = cvtpk(o[2], o[3]); w.z = cvtpk(o[4], o[5]); w.w = cvtpk(o[6], o[7]);
            *(u32x4*)(ua + (size_t)(r0 + i) * 2048 + c) = w; }
    }
}
typedef short s16x4 __attribute__((ext_vector_type(4)));
constexpr int A_SLOTB = 8192, A_LDS_K = 0, A_LDS_V = 3 * A_SLOTB, A_LDS_WS = 6 * A_SLOTB, A_LDS_OST = A_LDS_WS + 8 * 256, A_LDS_F = A_LDS_OST + 8 * 4096, ATT_LDS = A_LDS_F + S * 4;
#define A_THR 32.0f
#define A_SBAR() __builtin_amdgcn_sched_barrier(0)
#define A_PIN(x) asm volatile("" : "+v"(x))
#define A_MFMA(a, b, c) __builtin_amdgcn_mfma_f32_32x32x16_bf16(a, b, c, 0, 0, 0)
#define A_WAIT_BAR(N) asm volatile("s_waitcnt vmcnt(" #N ") lgkmcnt(0)\n\ts_barrier" ::: "memory")
__device__ __forceinline__ int crow(int r, int hi) { return (r & 3) + 8 * (r >> 2) + 4 * hi; }
__device__ __forceinline__ unsigned a_cvtpk(float lo, float hi) { unsigned r; asm("v_cvt_pk_bf16_f32 %0, %1, %2" : "=v"(r) : "v"(lo), "v"(hi)); return r; }
__device__ __forceinline__ void a_glds16(const void* g, unsigned lds_base) {
    unsigned sv; asm volatile("s_mov_b32 %0, m0\n\ts_mov_b32 m0, %2\n\ts_nop 0\n\tglobal_load_lds_dwordx4 %1, off\n\ts_mov_b32 m0, %0" : "=&s"(sv) : "v"(g), "s"(lds_base) : "memory"); }
typedef __attribute__((address_space(3))) const char* a_lds_cptr;
__device__ __forceinline__ void a_kload2(bf16x8* kf, a_lds_cptr kp, int d0) { kf[2 * d0] = *(const __attribute__((address_space(3))) bf16x8*)(kp + d0 * 2048); kf[2 * d0 + 1] = *(const __attribute__((address_space(3))) bf16x8*)(kp + d0 * 2048 + 512); }
__device__ __forceinline__ s16x4 a_vtr(a_lds_cptr p) { return __builtin_bit_cast(s16x4, __builtin_amdgcn_ds_read_tr16_b64_v4i16((__attribute__((address_space(3))) v4i16_t*)p)); }
#define A_MX3(a, b, c) __builtin_fmaxf(__builtin_fmaxf((a), (b)), (c))
__device__ __forceinline__ float a_rowmax(const f32x16& p0, const f32x16& p1) {
    float a = A_MX3(p0[0], p0[1], p1[0]), b = A_MX3(p0[2], p0[3], p1[1]); a = A_MX3(a, p1[2], p1[3]);
#pragma unroll
    for (int r = 4; r < 16; r += 4) { a = A_MX3(a, p0[r], p0[r + 1]); b = A_MX3(b, p0[r + 2], p0[r + 3]); a = A_MX3(a, p1[r], p1[r + 1]); b = A_MX3(b, p1[r + 2], p1[r + 3]); }
    float m = __builtin_fmaxf(a, b); auto rr = __builtin_amdgcn_permlane32_swap(__float_as_uint(m), __float_as_uint(m), false, false);
    return __builtin_fmaxf(__uint_as_float(rr[0]), __uint_as_float(rr[1])); }
__device__ __forceinline__ void a_cmask(f32x16& p0, f32x16& p1, int jb, int qrel, int hi) {
    const int kb = 64 * jb + 4 * hi;
#pragma unroll
    for (int r = 0; r < 16; ++r) { const int kv = kb + (r & 3) + 8 * (r >> 2); if (kv > qrel) p0[r] = -INFINITY; if (kv + 32 > qrel) p1[r] = -INFINITY; } }
#define A_FLD(X0, X1, fp_) do { _Pragma("unroll") for (int g_ = 0; g_ < 4; ++g_) { const f32x4 fa_ = *(const __attribute__((address_space(3))) f32x4*)((fp_) + g_ * 32), fb_ = *(const __attribute__((address_space(3))) f32x4*)((fp_) + 128 + g_ * 32); \
        _Pragma("unroll") for (int i_ = 0; i_ < 4; ++i_) { X0[4 * g_ + i_] = fa_[i_]; X1[4 * g_ + i_] = fb_[i_]; } } } while (0)
#define A_FRD2(G, X, fp_, g_) do { if (G) { const f32x4 fa_ = *(const __attribute__((address_space(3))) f32x4*)((fp_) + (g_) * 32), fb_ = *(const __attribute__((address_space(3))) f32x4*)((fp_) + (g_) * 32 + 32); \
        _Pragma("unroll") for (int i_ = 0; i_ < 4; ++i_) { X[4 * (g_) + i_] = fa_[i_]; X[4 * (g_) + 4 + i_] = fb_[i_]; } A_SBAR(); } } while (0)

__device__ __forceinline__ void attn64_unit(int b, int h, int qb, const bf16_t* Q, const bf16_t* __restrict__ K, const bf16_t* __restrict__ V, bf16_t* O, const float* __restrict__ nf, char* lds) {
    const int tid = tid_opaque(), lane = tid & 63, r32 = lane & 31, hi = lane >> 5; const int wid = __builtin_amdgcn_readfirstlane(tid >> 6);
    const long rowbase = (long)b * S; const int q0 = qb * 256, NT = (q0 + 256) / 64;
    const bf16_t* Qw = Q + (rowbase + q0 + wid * 32) * PLD + h * 64;
    const unsigned lds0 = (unsigned)(size_t)lds; float* wsf = (float*)(lds + A_LDS_WS) + wid * 64;
    const bf16_t* ksrc = K + rowbase * PLD + h * 64 + (long)lane * PLD + wid * 8;
    const bf16_t* vsrc = V + rowbase * PLD + h * 64 + (long)(16 * (wid & 3) + (lane >> 2)) * PLD + (wid >> 2) * 32 + (lane & 3) * 8;
    const unsigned kdst = lds0 + A_LDS_K + wid * 1024, vdst = lds0 + A_LDS_V + wid * 1024;
#define DMA_K(t, slot) a_glds16(ksrc + (long)(t) * 64 * PLD, (unsigned)__builtin_amdgcn_readfirstlane(kdst + (slot)))
#define DMA_V(t, slot) a_glds16(vsrc + (long)(t) * 64 * PLD, (unsigned)__builtin_amdgcn_readfirstlane(vdst + (slot)))
    const a_lds_cptr vp0 = (a_lds_cptr)lds + A_LDS_V + ((lane >> 4) & 1) * 32 + (lane & 3) * 8 + (4 * hi + ((lane & 15) >> 2)) * 64;
    const a_lds_cptr kp0 = (a_lds_cptr)lds + A_LDS_K + hi * 1024 + r32 * 16;
    const a_lds_cptr fp0 = (a_lds_cptr)lds + A_LDS_F + hi * 16;
    a_glds16(nf + 512 * wid + 4 * lane, (unsigned)__builtin_amdgcn_readfirstlane(lds0 + A_LDS_F + wid * 2048));
    a_glds16(nf + 512 * wid + 256 + 4 * lane, (unsigned)__builtin_amdgcn_readfirstlane(lds0 + A_LDS_F + wid * 2048 + 1024));
    DMA_K(0, 0); DMA_V(0, 0); DMA_K(1, A_SLOTB);
    bf16x8 qr[4];
#pragma unroll
    for (int d0 = 0; d0 < 4; ++d0) qr[d0] = *reinterpret_cast<const bf16x8*>(&Qw[(long)r32 * PLD + d0 * 16 + hi * 8]);
    float mhat = 0.f, l_reg = 0.f; f32x16 o[2];
#pragma unroll
    for (int r = 0; r < 16; ++r) { o[0][r] = 0.f; o[1][r] = 0.f; }
    const int qrel = wid * 32 + r32; bool resc = false;
    f32x16 pA0, pA1, pB0, pB1; bf16x8 kf[8]; s16x4 vlo[8], vhi[8]; u32x4 pw0, pw1, pw2, pw3;
    int sl_prev = 0, sl_cur = 0, sl_next = A_SLOTB;
#define ROT() do { sl_prev = sl_cur; sl_cur = sl_next; sl_next = (sl_next == 2 * A_SLOTB) ? 0 : sl_next + A_SLOTB; } while (0)
#define EX(v) __builtin_amdgcn_exp2f((v) + nmh)
#define RESC() do { if (resc) { _Pragma("unroll") for (int d_ = 0; d_ < 2; ++d_) _Pragma("unroll") for (int r = 0; r < 16; ++r) o[d_][r] *= wsf[crow(r, hi)]; } } while (0)
    DMA_K(2, 2 * A_SLOTB);
    A_WAIT_BAR(0);
    _Pragma("unroll") for (int d0 = 0; d0 < 4; ++d0) a_kload2(kf, kp0, d0);
    A_FLD(pA0, pA1, fp0);
    pA0 = A_MFMA(kf[0], qr[0], pA0); pA1 = A_MFMA(kf[1], qr[0], pA1); pA0 = A_MFMA(kf[2], qr[1], pA0); pA1 = A_MFMA(kf[3], qr[1], pA1);
    pA0 = A_MFMA(kf[4], qr[2], pA0); pA1 = A_MFMA(kf[5], qr[2], pA1); pA0 = A_MFMA(kf[6], qr[3], pA0); pA1 = A_MFMA(kf[7], qr[3], pA1);
    if (NT == 4) a_cmask(pA0, pA1, 0, qrel, hi);
    { const float rm = a_rowmax(pA0, pA1); mhat = rm; const float nmh = -mhat;
#pragma unroll
      for (int r = 0; r < 16; ++r) { pA0[r] = EX(pA0[r]); pA1[r] = EX(pA1[r]); } }
    A_FLD(pB0, pB1, fp0 + 256);
    A_WAIT_BAR(0);
    DMA_K(3, 0); DMA_V(1, A_SLOTB); ROT();
    _Pragma("unroll") for (int d0 = 0; d0 < 4; ++d0) a_kload2(kf, kp0 + sl_cur, d0);
    A_WAIT_BAR(2);
#define PKW(P, i) a_cvtpk(P[i], P[i + 1])
#define PAF(k) __builtin_bit_cast(bf16x8, pw##k)
#define VFR(i) (bf16x8){vlo[i][0], vlo[i][1], vlo[i][2], vlo[i][3], vhi[i][0], vhi[i][1], vhi[i][2], vhi[i][3]}
#define VRD(i) do { vlo[i] = a_vtr(vp_ + (((i) >> 2) * 4096 + ((i) & 3) * 1024)); vhi[i] = a_vtr(vp_ + (((i) >> 2) * 4096 + ((i) & 3) * 1024 + 512)); } while (0)
#define KRD(G, d0) do { if (G) { a_kload2(kf, kp0 + sl_next, d0); A_SBAR(); } } while (0)
#define GAPA(MF, a0, a1, a2, a3, W0, W1, PW) do { MF; sacc += a0; sacc += a1; sacc += a2; sacc += a3; W0; W1; A_PIN(PW); A_PIN(sacc); A_SBAR(); } while (0)
#define GAPB(MF, X, i) do { MF; X[i] = EX(X[i]); X[i + 1] = EX(X[i + 1]); X[i + 2] = EX(X[i + 2]); X[i + 3] = EX(X[i + 3]); A_PIN(X); A_SBAR(); } while (0)
#define STEP(C0, C1, P0, P1, t, MASK, GK, GV, GL) do { A_SBAR(); \
    const a_lds_cptr vp_ = vp0 + sl_prev; const a_lds_cptr fn_ = fp0 + ((t) + 1) * 256; \
    VRD(0); A_SBAR(); float sacc = P0[0] + P0[1]; \
                    GAPA(C0 = A_MFMA(kf[0], qr[0], C0), P0[2], P0[3], P0[4], P0[5],     pw0[0] = PKW(P0, 0),  pw0[1] = PKW(P0, 2),  pw0); \
    VRD(4); A_SBAR(); GAPA(C1 = A_MFMA(kf[1], qr[0], C1), P0[6], P0[7], P0[8], P0[9],     pw0[2] = PKW(P0, 4),  pw0[3] = PKW(P0, 6),  pw0); \
    VRD(1); A_SBAR(); GAPA(C0 = A_MFMA(kf[2], qr[1], C0),    P0[10], P0[11], P0[12], P0[13], pw1[0] = PKW(P0, 8),  pw1[1] = PKW(P0, 10), pw1); \
    VRD(5); A_SBAR(); GAPA(C1 = A_MFMA(kf[3], qr[1], C1),    P0[14], P0[15], P1[0], P1[1],   pw1[2] = PKW(P0, 12), pw1[3] = PKW(P0, 14), pw1); \
    VRD(2); A_SBAR(); GAPA(C0 = A_MFMA(kf[4], qr[2], C0),    P1[2], P1[3], P1[4], P1[5],     pw2[0] = PKW(P1, 0),  pw2[1] = PKW(P1, 2),  pw2); \
    VRD(6); A_SBAR(); GAPA(C1 = A_MFMA(kf[5], qr[2], C1),    P1[6], P1[7], P1[8], P1[9],     pw2[2] = PKW(P1, 4),  pw2[3] = PKW(P1, 6),  pw2); \
    VRD(3); A_SBAR(); GAPA(C0 = A_MFMA(kf[6], qr[3], C0),    P1[10], P1[11], P1[12], P1[13], pw3[0] = PKW(P1, 8),  pw3[1] = PKW(P1, 10), pw3); \
    VRD(7); A_SBAR(); GAPA(C1 = A_MFMA(kf[7], qr[3], C1),    P1[14], P1[15], 0.f, 0.f,       pw3[2] = PKW(P1, 12), pw3[3] = PKW(P1, 14), pw3); \
    l_reg += sacc; \
    if (GK) DMA_K((t) + 3, sl_cur); if (GV) DMA_V((t) + 1, sl_next); \
    if (MASK) a_cmask(C0, C1, (t) - (NT - 4), qrel, hi); \
    { const float rm = a_rowmax(C0, C1) - mhat; resc = false; \
      if (__builtin_expect(__any(rm > A_THR), 0)) { const float dl = __builtin_fmaxf(rm, 0.f); mhat += dl; \
          const float f = __builtin_amdgcn_exp2f(-dl); l_reg *= f; if (hi == 0) wsf[r32] = f; resc = true; } } \
    const float nmh = -mhat; A_SBAR(); \
    A_FRD2(GL, P0, fn_, 0); GAPB(o[0] = A_MFMA(PAF(0), VFR(0), o[0]), C0, 0);  A_FRD2(GL, P0, fn_, 2); GAPB(o[1] = A_MFMA(PAF(0), VFR(4), o[1]), C0, 4); \
    KRD(GL, 0); GAPB(o[0] = A_MFMA(PAF(1), VFR(1), o[0]), C0, 8);  KRD(GL, 1); GAPB(o[1] = A_MFMA(PAF(1), VFR(5), o[1]), C0, 12); \
    KRD(GL, 2); GAPB(o[0] = A_MFMA(PAF(2), VFR(2), o[0]), C1, 0);  KRD(GL, 3); GAPB(o[1] = A_MFMA(PAF(2), VFR(6), o[1]), C1, 4); \
    A_FRD2(GL, P1, fn_ + 128, 0); GAPB(o[0] = A_MFMA(PAF(3), VFR(3), o[0]), C1, 8);  A_FRD2(GL, P1, fn_ + 128, 2); GAPB(o[1] = A_MFMA(PAF(3), VFR(7), o[1]), C1, 12); \
    } while (0)
    int t = 1;
    for (; t + 5 < NT; t += 2) {
        STEP(pB0, pB1, pA0, pA1, t, false, true, true, true);     A_WAIT_BAR(2); RESC(); ROT();
        STEP(pA0, pA1, pB0, pB1, t + 1, false, true, true, true); A_WAIT_BAR(2); RESC(); ROT();
    }
#define ENDW(tt) do { if ((tt) + 3 < NT) { A_WAIT_BAR(2); } else if ((tt) + 2 < NT) { A_WAIT_BAR(1); } else { A_WAIT_BAR(0); } } while (0)
    for (; t + 1 < NT; t += 2) {
        STEP(pB0, pB1, pA0, pA1, t, true, (t + 3 < NT), (t + 1 < NT), (t + 1 < NT));         ENDW(t);     RESC(); ROT();
        STEP(pA0, pA1, pB0, pB1, t + 1, true, (t + 4 < NT), (t + 2 < NT), (t + 2 < NT));     ENDW(t + 1); RESC(); ROT();
    }
    STEP(pB0, pB1, pA0, pA1, NT - 1, true, false, false, false); RESC();
    { float sacc = pB0[0] + pB0[1];
#pragma unroll
      for (int r = 2; r < 16; ++r) sacc += pB0[r];
#pragma unroll
      for (int r = 0; r < 16; ++r) sacc += pB1[r];
      l_reg += sacc;
      pw0 = (u32x4){PKW(pB0, 0), PKW(pB0, 2), PKW(pB0, 4), PKW(pB0, 6)}; pw1 = (u32x4){PKW(pB0, 8), PKW(pB0, 10), PKW(pB0, 12), PKW(pB0, 14)};
      pw2 = (u32x4){PKW(pB1, 0), PKW(pB1, 2), PKW(pB1, 4), PKW(pB1, 6)}; pw3 = (u32x4){PKW(pB1, 8), PKW(pB1, 10), PKW(pB1, 12), PKW(pB1, 14)};
      const a_lds_cptr vp_ = vp0 + sl_cur; _Pragma("unroll") for (int i = 0; i < 8; ++i) VRD(i);
      o[0] = A_MFMA(PAF(0), VFR(0), o[0]); o[1] = A_MFMA(PAF(0), VFR(4), o[1]); o[0] = A_MFMA(PAF(1), VFR(1), o[0]); o[1] = A_MFMA(PAF(1), VFR(5), o[1]);
      o[0] = A_MFMA(PAF(2), VFR(2), o[0]); o[1] = A_MFMA(PAF(2), VFR(6), o[1]); o[0] = A_MFMA(PAF(3), VFR(3), o[0]); o[1] = A_MFMA(PAF(3), VFR(7), o[1]); }
    { auto rr = __builtin_amdgcn_permlane32_swap(__float_as_uint(l_reg), __float_as_uint(l_reg), false, false); l_reg = __uint_as_float(rr[0]) + __uint_as_float(rr[1]); }
    if (hi == 0) wsf[32 + r32] = l_reg; asm volatile("s_waitcnt lgkmcnt(0)" ::: "memory");
    float rli[16];
#pragma unroll
    for (int r = 0; r < 16; ++r) rli[r] = __builtin_amdgcn_rcpf(wsf[32 + crow(r, hi)]);
    bf16_t* Ow = O + (rowbase + q0 + wid * 32) * 2048 + h * 64; bf16_t* stg = (bf16_t*)(lds + A_LDS_OST) + wid * 2048;
#pragma unroll
    for (int r = 0; r < 16; ++r) { const int orow = crow(r, hi);
#pragma unroll
        for (int d0 = 0; d0 < 2; ++d0) stg[orow * 64 + d0 * 32 + r32] = (bf16_t)(a_cvtpk(o[d0][r] * rli[r], 0.f) & 0xffffu); }
    asm volatile("s_waitcnt lgkmcnt(0)" ::: "memory");
#pragma unroll
    for (int i = 0; i < 4; ++i) { const int row = i * 8 + (lane >> 3), ch = lane & 7; *(u32x4*)(Ow + (long)row * 2048 + ch * 8) = *(const u32x4*)(stg + row * 64 + ch * 8); }
    asm volatile("s_waitcnt lgkmcnt(0)\n\ts_barrier" ::: "memory");
#undef DMA_K
#undef DMA_V
#undef ROT
#undef EX
#undef RESC
#undef PKW
#undef PAF
#undef VFR
#undef VRD
#undef KRD
#undef ENDW
#undef GAPA
#undef GAPB
#undef STEP
}
__device__ __forceinline__ void phase_attn(const Ptrs& p, LAS unsigned char* lds) {
    const bf16_t* pr = (const bf16_t*)(p.ws + OFF_PROJ); bf16_t* ua = (bf16_t*)(p.ws + OFF_UA);
    for (int pi = vwg_id(); pi < 256; pi += gridDim.x) {
        const int s_ = pi & 7, bh = pi >> 3; const float* nf = (const float*)(p.ws + OFF_FCUM) + (size_t)bh * S;
#pragma unroll 1
        for (int half = 0; half < 2; ++half)
            attn64_unit(bh >> 4, bh & 15, half ? 15 - s_ : s_, pr + C_Q, pr + C_K, pr + C_V, ua + 1024, nf, (char*)lds);
    }
}
constexpr int R_PITCH = 512 * 2 + 16, R_WHI = 0, R_WLO = 32 * R_PITCH, R_HHI = 64 * R_PITCH, R_HLO = 96 * R_PITCH, R_GS = 128 * R_PITCH, R_LG = R_GS + 16384, R_TAB = R_LG + 4096, R_END = R_TAB + 2048;
__device__ __forceinline__ void phase_norm2_route(const Ptrs& p, LAS unsigned char* lds) {
    LAS float* gs = (LAS float*)(lds + R_GS); LAS float* sh = gs + 2048; LAS float* lg = (LAS float*)(lds + R_LG); LAS float* ps = (LAS float*)lds;
    const int tid = tid_opaque(), lane = tid & 63, wid = tid >> 6;
    bf16_t* ha = (bf16_t*)(p.ws + OFF_HA); const float* x1 = (const float*)(p.ws + OFF_X1);
    int* counts = (int*)(p.ws + OFF_CTRL); int* list = (int*)(p.ws + OFF_LIST); float* gate = (float*)(p.ws + OFF_GATE);
    for (int blk = vwg_id(); blk < NTOK / 32; blk += gridDim.x) {
        const int b = (blk * 32) / S; const float* mod = (const float*)(p.ws + OFF_MOD) + (size_t)b * NMOD;
        __syncthreads();
        for (int i = tid; i < 2048; i += 512) { gs[i] = p.norm_ffn_g[i] * (1.0f + mod[4 * D + i]); sh[i] = mod[3 * D + i]; }
        __syncthreads();
#pragma unroll 1
        for (int half = 0; half < 2; ++half) {
            f32x4 v[2][8];
#pragma unroll
            for (int q = 0; q < 2; ++q) { const int row = blk * 32 + half * 16 + wid * 2 + q; const float* xr = x1 + (size_t)row * D; float ss = 0.f;
#pragma unroll
                for (int c = 0; c < 8; ++c) { v[q][c] = *(const f32x4*)(xr + c * 256 + lane * 4); ss += v[q][c][0] * v[q][c][0] + v[q][c][1] * v[q][c][1] + v[q][c][2] * v[q][c][2] + v[q][c][3] * v[q][c][3]; }
                ss = wave_sum(ss); const float r = rsqrtf(ss * (1.0f / D) + EPS);
#pragma unroll
                for (int c = 0; c < 8; ++c) { const int k = c * 256 + lane * 4; const f32x4 g4 = *(const LAS f32x4*)(gs + k), s4 = *(const LAS f32x4*)(sh + k);
                    v[q][c] = (v[q][c] * r) * g4 + s4; u32x2 w; w.x = cvtpk(v[q][c][0], v[q][c][1]); w.y = cvtpk(v[q][c][2], v[q][c][3]); *(u32x2*)(ha + (size_t)row * D + k) = w; } }
            f32x4 acc[2];
            acc[0] = (f32x4){0.f, 0.f, 0.f, 0.f}; acc[1] = (f32x4){0.f, 0.f, 0.f, 0.f};
#pragma unroll
            for (int ch = 0; ch < 4; ++ch) {
                __syncthreads();
                for (int i = tid; i < 2048; i += 512) { const int kp = i >> 3, cq = i & 7; const float* w = p.router_w + (size_t)(512 * ch + 2 * kp) * E + cq * 4;
                    const f32x4 w0 = *(const f32x4*)w, w1 = *(const f32x4*)(w + E);
#pragma unroll
                    for (int j = 0; j < 4; ++j) { const unsigned hi = cvtpk(w0[j], w1[j]), lo = cvtpk(w0[j] - bflo(hi), w1[j] - bfhi(hi));
                        *(LAS unsigned*)(lds + R_WHI + (cq * 4 + j) * R_PITCH + kp * 4) = hi; *(LAS unsigned*)(lds + R_WLO + (cq * 4 + j) * R_PITCH + kp * 4) = lo; } }
#pragma unroll
                for (int q = 0; q < 2; ++q)
#pragma unroll
                    for (int cc = 0; cc < 2; ++cc) { const f32x4 h4 = v[q][2 * ch + cc]; u32x2 hi, lo; hi.x = cvtpk(h4[0], h4[1]); hi.y = cvtpk(h4[2], h4[3]);
                        lo.x = cvtpk(h4[0] - bflo(hi.x), h4[1] - bfhi(hi.x)); lo.y = cvtpk(h4[2] - bflo(hi.y), h4[3] - bfhi(hi.y));
                        const int o = (wid * 2 + q) * R_PITCH + (cc * 256 + lane * 4) * 2;
                        *(LAS u32x2*)(lds + R_HHI + o) = hi; *(LAS u32x2*)(lds + R_HLO + o) = lo; }
                __syncthreads();
#pragma unroll
                for (int s2 = 0; s2 < 2; ++s2) { const int off = (lane & 15) * R_PITCH + (2 * wid + s2) * 64 + (lane >> 4) * 16;
                    const bf16x8 ahi = *(const LAS bf16x8*)(lds + R_HHI + off), alo = *(const LAS bf16x8*)(lds + R_HLO + off);
#pragma unroll
                    for (int ct = 0; ct < 2; ++ct) { const bf16x8 bhi = *(const LAS bf16x8*)(lds + R_WHI + ct * 16 * R_PITCH + off), blo = *(const LAS bf16x8*)(lds + R_WLO + ct * 16 * R_PITCH + off);
                        acc[ct] = __builtin_amdgcn_mfma_f32_16x16x32_bf16(ahi, bhi, acc[ct], 0, 0, 0); acc[ct] = __builtin_amdgcn_mfma_f32_16x16x32_bf16(alo, bhi, acc[ct], 0, 0, 0);
                        acc[ct] = __builtin_amdgcn_mfma_f32_16x16x32_bf16(ahi, blo, acc[ct], 0, 0, 0); } }
            }
            __syncthreads();
#pragma unroll
            for (int ct = 0; ct < 2; ++ct)
#pragma unroll
                for (int i = 0; i < 4; ++i) ps[wid * 512 + (4 * (lane >> 4) + i) * 32 + ct * 16 + (lane & 15)] = acc[ct][i];
            __syncthreads();
            { const int o = tid; float z = p.router_b[o & 31];
#pragma unroll
              for (int w = 0; w < 8; ++w) z += ps[w * 512 + o];
              lg[half * 512 + o] = z; }
        }
        LAS int* lcnt = (LAS int*)(lds + R_TAB);
        LAS int* lbase = lcnt + 32;
        LAS int* asg_e = lbase + 32;
        LAS int* asg_r = asg_e + 128;
        if (tid < 32) lcnt[tid] = 0;
        __syncthreads();
#pragma unroll 1
        for (int rr = 0; rr < 4; ++rr) {
            const int rl = wid * 4 + rr, row = blk * 32 + rl;
            float val = (lane < 32) ? lg[rl * 32 + lane] : -INFINITY;
            float tv[4]; int ti[4];
#pragma unroll
            for (int k = 0; k < 4; ++k) { const float m = wave_max(val);
                const unsigned long long bal = __ballot(val == m); const int idx = __ffsll((long long)bal) - 1;
                tv[k] = m; ti[k] = idx; if (lane == idx) val = -INFINITY; }
            if (lane < 4) { float pe[4], sum = 0.f;
#pragma unroll
                for (int k = 0; k < 4; ++k) { pe[k] = __expf(tv[k] - tv[0]); sum += pe[k]; }
                const int e = lane == 0 ? ti[0] : lane == 1 ? ti[1] : lane == 2 ? ti[2] : ti[3]; const float pk = (lane == 0 ? pe[0] : lane == 1 ? pe[1] : lane == 2 ? pe[2] : pe[3]) / sum;
                const int lr = __hip_atomic_fetch_add((int*)(lcnt + e), 1, __ATOMIC_RELAXED, __HIP_MEMORY_SCOPE_WORKGROUP); asg_e[rl * 4 + lane] = e; asg_r[rl * 4 + lane] = lr; gate[row * 4 + lane] = pk; }
        }
        __syncthreads();
        if (tid < 32) lbase[tid] = atomicAdd(&counts[tid], lcnt[tid]);
        __syncthreads();
        if (tid < 128) { const int e = asg_e[tid]; list[(size_t)e * NTOK + lbase[e] + asg_r[tid]] = (blk * 32) * 4 + tid; }
    }
}
__device__ __forceinline__ void phase_final(const Ptrs& p, LAS unsigned char* lds) {
    const int tid = tid_opaque(), lane = tid & 63, wid = tid >> 6;
    const float* x1 = (const float*)(p.ws + OFF_X1); const bf16_t* y = (const bf16_t*)(p.ws + OFF_Y);
    for (int row = vwg_id() * 8 + wid; row < NTOK; row += gridDim.x * 8) {
        const int b = row / S; const float* gf = (const float*)(p.ws + OFF_MOD) + (size_t)b * NMOD + 5 * D; const float* xr = x1 + (size_t)row * D; const bf16_t* yr = y + (size_t)row * 4 * D;
        f32x4 v[8]; float ss = 0.f;
#pragma unroll
        for (int c = 0; c < 8; ++c) { const int k = c * 256 + lane * 4; f32x4 s = {0.f, 0.f, 0.f, 0.f};
#pragma unroll
            for (int q = 0; q < 4; ++q) { const u32x2 w = *(const u32x2*)(yr + (size_t)q * D + k); s[0] += bflo(w.x); s[1] += bfhi(w.x); s[2] += bflo(w.y); s[3] += bfhi(w.y); }
            v[c] = *(const f32x4*)(xr + k) + *(const f32x4*)(gf + k) * s; ss += v[c][0] * v[c][0] + v[c][1] * v[c][1] + v[c][2] * v[c][2] + v[c][3] * v[c][3]; }
        ss = wave_sum(ss); const float r = rsqrtf(ss * (1.0f / D) + EPS);
#pragma unroll
        for (int c = 0; c < 8; ++c) { const int k = c * 256 + lane * 4; *(f32x4*)(p.out + (size_t)row * D + k) = (v[c] * r) * *(const f32x4*)(p.final_g + k); }
    }
}

#define XB_TMO      128
#define XB_XCNT(j)  (256  + 64 * (j))
#define XB_XSUB(j)  (1280 + 64 * (j))
#define XB_XGEN(j)  (2304 + 64 * (j))
#define XB_TOP      3328
#define XB_TOPGEN   3392
#define XCD_BAR_WORDS 3456
#define XB_SPIN_CAP (1u << 18)

__device__ __forceinline__ unsigned xb_ld(unsigned* p)              { return __hip_atomic_load(p, __ATOMIC_RELAXED, __HIP_MEMORY_SCOPE_AGENT); }
__device__ __forceinline__ unsigned xb_add(unsigned* p, unsigned v) { return __hip_atomic_fetch_add(p, v, __ATOMIC_RELAXED, __HIP_MEMORY_SCOPE_AGENT); }
__device__ __forceinline__ unsigned xb_xcc_id() { return (unsigned)__builtin_amdgcn_s_getreg((3 << 11) | 20) & 0xFu; }
#define XB_SPIN(cond, bar) do { unsigned _sp = 0; while (cond) { __builtin_amdgcn_s_sleep(1); \
    if ((++_sp & 255u) == 0u) { if (xb_ld(&(bar)[XB_TMO])) break; if (_sp > XB_SPIN_CAP) { atomicAdd(&(bar)[XB_TMO], 1u); break; } } } } while (0)

struct XcdBarrier {
    unsigned* bar; unsigned x;
    volatile LAS unsigned* st;
};

__device__ __forceinline__ XcdBarrier xcd_barrier_post(unsigned* bar, volatile LAS unsigned* st) {
    XcdBarrier b; b.bar = bar; b.x = xb_xcc_id(); b.st = st;
    if (threadIdx.x == 0) (void)xb_add(&bar[XB_XCNT(b.x)], 1u);
    return b;
}
__device__ __forceinline__ void xcd_barrier_complete(unsigned* bar, unsigned x, unsigned& nloc, unsigned& nx) {
    const unsigned G = gridDim.x * gridDim.y * gridDim.z;
    unsigned sum, cnt, mine, sp = 0u;
    for (;;) {
        sum = 0u; cnt = 0u; mine = 0u;
#pragma unroll
        for (unsigned j = 0; j < 16; ++j) { const unsigned c = xb_ld(&bar[XB_XCNT(j)]); sum += c; cnt += (c > 0u) ? 1u : 0u; mine = (j == x) ? c : mine; }
        if (sum == G) break;
        __builtin_amdgcn_s_sleep(1);
        if ((++sp & 255u) == 0u) { if (xb_ld(&bar[XB_TMO])) break; if (sp > XB_SPIN_CAP) { atomicAdd(&bar[XB_TMO], 1u); break; } }
    }
    nloc = mine > 0u ? mine : 1u; nx = cnt > 0u ? cnt : 1u;
}

__device__ __forceinline__ void xcd_barrier(const XcdBarrier& b) {
    asm volatile("s_waitcnt vmcnt(0)" ::: "memory");
    __syncthreads();
    if (threadIdx.x == 0) {
        unsigned* bar = b.bar;
        __builtin_amdgcn_s_waitcnt(0);
        unsigned nloc = b.st[0], nx = b.st[1];
        if (nloc == 0u) { xcd_barrier_complete(bar, b.x, nloc, nx); b.st[0] = nloc; b.st[1] = nx; }
        const unsigned old = xb_add(&bar[XB_XSUB(b.x)], 1u);
        const unsigned gen = old / nloc;
        if (old + 1u == (gen + 1u) * nloc) {
            __builtin_amdgcn_fence(__ATOMIC_RELEASE, "agent");
            asm volatile("s_waitcnt vmcnt(0)" ::: "memory");
            const unsigned og = xb_add(&bar[XB_TOP], 1u);
            const unsigned tg = og / nx;
            if (og + 1u == (tg + 1u) * nx) xb_add(&bar[XB_TOPGEN], 1u);
            else XB_SPIN(xb_ld(&bar[XB_TOPGEN]) == tg, bar);
            __builtin_amdgcn_fence(__ATOMIC_ACQUIRE, "agent");
            xb_add(&bar[XB_XGEN(b.x)], 1u);
            asm volatile("s_waitcnt vmcnt(0)" ::: "memory");
        } else {
            XB_SPIN(xb_ld(&bar[XB_XGEN(b.x)]) == gen, bar);
            __builtin_amdgcn_fence(__ATOMIC_ACQUIRE, "agent");
            asm volatile("s_waitcnt vmcnt(0)" ::: "memory");
        }
    }
    __syncthreads();
}


constexpr int LDS_TOTAL = AUX_LDS + 16;
constexpr size_t OFF_BAR = OFF_CTRL + 4096;
static_assert(GEMM_LDS <= AUX_LDS && ATT_LDS <= AUX_LDS && N1_END <= AUX_LDS && R_END <= AUX_LDS, "LDS");
static_assert(4096 + XCD_BAR_WORDS * 4 <= 65536, "ctrl");
__global__ void __launch_bounds__(512, 2) mega_fwd(Ptrs p) {
    LAS unsigned char* lds = (LAS unsigned char*)dyn_lds;
    volatile LAS unsigned* st = (volatile LAS unsigned*)(lds + AUX_LDS);
    if (threadIdx.x == 0) { st[0] = 0u; st[1] = 0u; st[2] = 0u; st[3] = 0u; }
    __syncthreads();
    XcdBarrier bar = xcd_barrier_post((unsigned*)(p.ws + OFF_BAR), st);
    phase_mod(p, lds);          phase_prep(p, lds);         xcd_barrier(bar);
    phase_norm1(p, lds);        xcd_barrier(bar);
    phase_gemm1(p, lds);        xcd_barrier(bar);
    phase_scan_conv(p, lds);    xcd_barrier(bar);
    phase_attn(p, lds);         xcd_barrier(bar);
    phase_merge(p, lds);        xcd_barrier(bar);
    phase_out(p, lds);          xcd_barrier(bar);
    phase_norm2_route(p, lds);  xcd_barrier(bar);
    phase_moe_gu(p, lds);
    phase_moe_down(p, lds);     xcd_barrier(bar);
    phase_final(p, lds);
}

extern "C" void kernel_launch(void* const* d_in, const int* in_sizes, int n_in, void* d_out, int out_size, void* d_ws, size_t ws_size, hipStream_t stream) {
    Ptrs p{};
    const float** f = (const float**)&p;
    for (int i = 0; i < 21; ++i) f[i] = (const float*)d_in[i];
    p.out = (float*)d_out; p.ws = (unsigned char*)d_ws;
    static int grid = 0;
    if (!grid) {
        (void)hipFuncSetAttribute((const void*)mega_fwd, hipFuncAttributeMaxDynamicSharedMemorySize, LDS_TOTAL);
        int dev = 0, cus = 0, per_cu = 0;
        (void)hipGetDevice(&dev);
        (void)hipDeviceGetAttribute(&cus, hipDeviceAttributeMultiprocessorCount, dev);
        (void)hipOccupancyMaxActiveBlocksPerMultiprocessor(&per_cu, mega_fwd, 512, LDS_TOTAL);
        grid = cus * (per_cu < 1 ? per_cu : 1);
        if (grid <= 0) grid = cus > 0 ? cus : 256;
    }
    (void)hipMemsetAsync(p.ws + OFF_CTRL, 0, 65536, stream);
    mega_fwd<<<grid, 512, LDS_TOTAL, stream>>>(p);
}
```

```cpp
#include <hip/hip_runtime.h>
#include <stdint.h>

typedef unsigned short bf16_t;
typedef float f32x4 __attribute__((ext_vector_type(4)));
typedef unsigned u32x4 __attribute__((ext_vector_type(4)));
typedef unsigned u32x2 __attribute__((ext_vector_type(2)));

namespace cfg {
constexpr int B = 2, S = 4096, D = 2048, NTOK = B * S, H = 16, DH = 64, DA = 1024, DC = 1024;
constexpr int NIN = 10256, NMOD = 6 * D, E = 32, TOPK = 4, NASG = NTOK * TOPK;
constexpr int PLD = 10240;
constexpr int C_XC = 0, C_CB = 1024, C_CC = 2048, C_Q = 3072, C_K = 4096, C_V = 5120, C_GC = 6144, C_GA = 8192;
constexpr int W_F = 6144, W_GC = 6160, W_GA = 8208;
constexpr float EPS = 1e-6f, LOG2E = 1.4426950408889634f;
constexpr float QSCALE = 0.125f * LOG2E;
constexpr int ACT_ROWS = NASG + E * 256;
constexpr size_t al(size_t x) { return (x + 255) & ~(size_t)255; }
constexpr size_t OFF_CTRL = 0;
constexpr size_t OFF_MOD = 65536;
constexpr size_t OFF_LOGF = OFF_MOD + al((size_t)B * NMOD * 4);
constexpr size_t OFF_FCUM = OFF_LOGF + al((size_t)B * H * S * 4);
constexpr size_t OFF_HA = OFF_FCUM + al((size_t)B * H * S * 4);
constexpr size_t OFF_PROJ = OFF_HA + al((size_t)NTOK * D * 2);
constexpr size_t OFF_UA = OFF_PROJ + al((size_t)NTOK * PLD * 2);
constexpr size_t OFF_MRG = OFF_UA + al((size_t)NTOK * 2048 * 2);
constexpr size_t OFF_X1 = OFF_MRG + al((size_t)NTOK * D * 2);
constexpr size_t OFF_TMP = OFF_X1 + al((size_t)NTOK * D * 4);
constexpr size_t OFF_GATE = OFF_TMP + al((size_t)NTOK * D * 4);
constexpr size_t OFF_LIST = OFF_GATE + al((size_t)NASG * 4);
constexpr size_t OFF_ACT = OFF_LIST + al((size_t)E * NTOK * 4);
constexpr size_t OFF_Y = OFF_ACT + al((size_t)ACT_ROWS * D * 2);
constexpr size_t WS_END = OFF_Y + al((size_t)NASG * D * 2);
constexpr int WTP2 = D + 64, WTP1 = 1024 + 64;
constexpr size_t OFF_WTIN = WS_END;
constexpr size_t OFF_WTCO = OFF_WTIN + al((size_t)PLD * WTP2 * 2);
constexpr size_t OFF_WTAO = OFF_WTCO + al((size_t)D * WTP1 * 2);
constexpr size_t OFF_WTO = OFF_WTAO + al((size_t)D * WTP1 * 2);
constexpr size_t WS_END2 = OFF_WTO + al((size_t)D * WTP2 * 2);
}
using namespace cfg;

__device__ __forceinline__ float bf2f(bf16_t v) { return __uint_as_float(((unsigned)v) << 16); }
__device__ __forceinline__ bf16_t f2bf(float f) { unsigned u = __float_as_uint(f); u += 0x7fffu + ((u >> 16) & 1u); return (bf16_t)(u >> 16); }
__device__ __forceinline__ float sigmoidf_(float x) { return __builtin_amdgcn_rcpf(1.0f + __builtin_amdgcn_exp2f(x * -1.4426950408889634f)); }

struct Ptrs {
    const float *x, *c, *ada_w, *ada_b, *norm_mix_g, *w_in, *b_forget, *conv_w, *w_conv_out, *w_attn_out, *w_out, *norm_ffn_g,
        *router_w, *router_b, *w_gate, *b_gate, *w_up, *b_up, *w_down, *b_down, *final_g;
    float* out; unsigned char* ws;
};

#define LAS __attribute__((address_space(3)))
typedef short bf16x8 __attribute__((ext_vector_type(8)));
typedef float f32x2_t __attribute__((ext_vector_type(2)));
typedef __bf16 bf16x2_t __attribute__((ext_vector_type(2)));
__device__ __forceinline__ unsigned cvtpk(float lo, float hi) { f32x2_t v = {lo, hi}; bf16x2_t b = __builtin_convertvector(v, bf16x2_t); return __builtin_bit_cast(unsigned, b); }
__device__ __forceinline__ float bflo(unsigned w) { return __uint_as_float(w << 16); }
__device__ __forceinline__ float bfhi(unsigned w) { return __uint_as_float(w & 0xffff0000u); }
__device__ __forceinline__ int tid_opaque() { int t = threadIdx.x; asm volatile("" : "+v"(t)); return t; }
constexpr int GEMM_LDS = 131072;

struct GemmT {
    int wr, wc, fr, fq;
    int aR, aC;
    unsigned a_w;
    int b_k, b_col, b_p, b_gucol;
    unsigned b_w, b_rot;
    unsigned a_r, b_r;
    __device__ __forceinline__ void init_epi() { const int tid = tid_opaque(), wid = tid >> 6, lane = tid & 63; wr = wid >> 2; wc = wid & 3; fr = lane & 15; fq = lane >> 4; }
    __device__ __forceinline__ void init() {
        const int tid = tid_opaque(), wid = tid >> 6, lane = tid & 63;
        wr = wid >> 2; wc = wid & 3; fr = lane & 15; fq = lane >> 4;
        aR = (wid >> 1) * 16 + (lane >> 2); aC = (wid & 1) * 32 + (((lane & 3) ^ ((lane >> 5) << 1)) * 8);
        a_w = (unsigned)(wid * 1024 + lane * 16);
        { const int l32 = lane & 31, kc8 = 2 * (wid >> 1) + (lane >> 5), wc_ = l32 >> 3, bfq = (l32 >> 1) & 3, nlo = l32 & 1; b_p = wid & 1;
          b_k = kc8 * 8; b_col = wc_ * 64 + b_p * 32 + bfq * 8 + nlo * 4; b_gucol = wc_ * 32 + bfq * 8 + nlo * 4;
          const int sub = wc_ * 4 + 2 * b_p + nlo;
          b_w = (unsigned)((sub * 2 + (kc8 >> 2)) * 1024 + (((4 * bfq) * 64 + (kc8 & 3) * 16) ^ ((bfq >> 1) << 5))); b_rot = (unsigned)(nlo * 64); }
        const unsigned lo = (unsigned)((fr * 64 + fq * 16) ^ ((fr >> 3) << 5));
        a_r = (unsigned)(wr * 16384) + lo; b_r = 32768u + (unsigned)(wc * 8192) + lo;
    }
};

__device__ __forceinline__ void gemm_kloop(f32x4 (&acc)[8][4], LAS unsigned char* lds, const GemmT& T,
                                           __amdgpu_buffer_rsrc_t ra, unsigned ao0, unsigned ao1, unsigned ao2, unsigned ao3,
                                           __amdgpu_buffer_rsrc_t rb, unsigned bo, unsigned ldbB, int nt) {
    f32x4 sb[8];
    const unsigned a_wu = (unsigned)__builtin_amdgcn_readfirstlane((int)(T.a_w & ~1023u));
#define G_DMA_A(buf, t, i_) __builtin_amdgcn_raw_ptr_buffer_load_lds(ra, (LAS void*)(lds + (buf) * 65536 + a_wu + (i_) * 8192), 16, ao##i_, (unsigned)(t) * 128u, 0, 0)
#define G_ISSUE_B(t) do { const unsigned so_ = (unsigned)(t) * 64u * ldbB; _Pragma("unroll") for (int i_ = 0; i_ < 8; ++i_) sb[i_] = __builtin_bit_cast(f32x4, __builtin_amdgcn_raw_buffer_load_b128(rb, bo, so_ + (unsigned)i_ * ldbB, 0)); } while (0)
#define G_RETIRE() asm volatile("s_waitcnt vmcnt(0)" : "+v"(sb[0]), "+v"(sb[1]), "+v"(sb[2]), "+v"(sb[3]), "+v"(sb[4]), "+v"(sb[5]), "+v"(sb[6]), "+v"(sb[7]) :: "memory")
#define G_WRITE_B(buf) do { LAS unsigned char* d_ = lds + (buf) * 65536; \
        _Pragma("unroll") for (int j_ = 0; j_ < 4; ++j_) { u32x4 w_; w_.x = cvtpk(sb[0][j_], sb[1][j_]); w_.y = cvtpk(sb[2][j_], sb[3][j_]); w_.z = cvtpk(sb[4][j_], sb[5][j_]); w_.w = cvtpk(sb[6][j_], sb[7][j_]); \
            *(LAS u32x4*)(d_ + 32768 + T.b_w + ((T.b_rot + 64u * j_) & 255u)) = w_; } } while (0)
#define G_LDB(dst, buf, ks) do { const LAS unsigned char* s_ = lds + (buf) * 65536 + (ks) * 1024; _Pragma("unroll") for (int n_ = 0; n_ < 4; ++n_) dst[n_] = *(const LAS bf16x8*)(s_ + T.b_r + n_ * 2048); } while (0)
#define G_LDA(dst, buf, ks, h_) do { const LAS unsigned char* s_ = lds + (buf) * 65536 + (ks) * 1024; _Pragma("unroll") for (int m_ = 0; m_ < 4; ++m_) dst[m_] = *(const LAS bf16x8*)(s_ + T.a_r + ((h_) * 4 + m_) * 2048); } while (0)
#define G_MMA(At_, Bf_, h_) do { _Pragma("unroll") for (int m_ = 0; m_ < 4; ++m_) _Pragma("unroll") for (int n_ = 0; n_ < 4; ++n_) \
        acc[(h_) * 4 + m_][n_] = __builtin_amdgcn_mfma_f32_16x16x32_bf16(Bf_[n_], At_[m_], acc[(h_) * 4 + m_][n_], 0, 0, 0); } while (0)
#define G_SB() __builtin_amdgcn_sched_barrier(0)
#define G_BAR() do { asm volatile("s_waitcnt lgkmcnt(0)" ::: "memory"); __builtin_amdgcn_s_barrier(); asm volatile("" ::: "memory"); } while (0)
    bf16x8 Bf0[4], Bf1[4], AtA[4], AtB[4];
    G_ISSUE_B(0); G_DMA_A(0, 0, 0); G_DMA_A(0, 0, 1); G_DMA_A(0, 0, 2); G_DMA_A(0, 0, 3); G_RETIRE(); G_WRITE_B(0);
    if (nt > 1) G_ISSUE_B(1);
    G_BAR();
    for (int t = 0; t < nt; ++t) { const int cur = t & 1; const bool w1 = t + 1 < nt, i2 = t + 2 < nt;
        G_LDB(Bf0, cur, 0); G_LDA(AtA, cur, 0, 0); G_SB();
        G_LDA(AtB, cur, 0, 1); if (w1) { G_DMA_A(cur ^ 1, t + 1, 0); G_DMA_A(cur ^ 1, t + 1, 1); G_DMA_A(cur ^ 1, t + 1, 2); G_DMA_A(cur ^ 1, t + 1, 3); } G_MMA(AtA, Bf0, 0); G_SB();
        G_LDB(Bf1, cur, 1); G_LDA(AtA, cur, 1, 0); G_MMA(AtB, Bf0, 1); G_SB();
        G_LDA(AtB, cur, 1, 1); if (w1) { G_RETIRE(); G_WRITE_B(cur ^ 1); } if (i2) G_ISSUE_B(t + 2); G_MMA(AtA, Bf1, 0); G_SB();
        G_MMA(AtB, Bf1, 1); G_SB();
        G_BAR(); }
#undef G_LDA
#undef G_MMA
#undef G_SB
#undef G_DMA_A
#undef G_ISSUE_B
#undef G_WRITE_B
#undef G_RETIRE
#undef G_LDB
}
__device__ __forceinline__ void gemm_kloop_light(f32x4 (&acc)[8][4], LAS unsigned char* lds, const GemmT& T,
                                                 __amdgpu_buffer_rsrc_t ra, unsigned ao0, unsigned ao1, unsigned ao2, unsigned ao3,
                                                 __amdgpu_buffer_rsrc_t rb, unsigned bo, unsigned ldbB, int nt, int mlim) {
    f32x4 sb[8];
    const unsigned a_wu = (unsigned)__builtin_amdgcn_readfirstlane((int)(T.a_w & ~1023u));
#define G_DMA_A(buf, t, i_) __builtin_amdgcn_raw_ptr_buffer_load_lds(ra, (LAS void*)(lds + (buf) * 65536 + a_wu + (i_) * 8192), 16, ao##i_, (unsigned)(t) * 128u, 0, 0)
#define G_ISSUE_B(t) do { const unsigned so_ = (unsigned)(t) * 64u * ldbB; _Pragma("unroll") for (int i_ = 0; i_ < 8; ++i_) sb[i_] = __builtin_bit_cast(f32x4, __builtin_amdgcn_raw_buffer_load_b128(rb, bo, so_ + (unsigned)i_ * ldbB, 0)); } while (0)
#define G_RETIRE() asm volatile("s_waitcnt vmcnt(0)" : "+v"(sb[0]), "+v"(sb[1]), "+v"(sb[2]), "+v"(sb[3]), "+v"(sb[4]), "+v"(sb[5]), "+v"(sb[6]), "+v"(sb[7]) :: "memory")
#define G_WRITE_B(buf) do { LAS unsigned char* d_ = lds + (buf) * 65536; \
        _Pragma("unroll") for (int j_ = 0; j_ < 4; ++j_) { u32x4 w_; w_.x = cvtpk(sb[0][j_], sb[1][j_]); w_.y = cvtpk(sb[2][j_], sb[3][j_]); w_.z = cvtpk(sb[4][j_], sb[5][j_]); w_.w = cvtpk(sb[6][j_], sb[7][j_]); \
            *(LAS u32x4*)(d_ + 32768 + T.b_w + ((T.b_rot + 64u * j_) & 255u)) = w_; } } while (0)
    G_ISSUE_B(0); G_DMA_A(0, 0, 0); G_DMA_A(0, 0, 1); G_DMA_A(0, 0, 2); G_DMA_A(0, 0, 3); G_RETIRE(); G_WRITE_B(0);
    if (nt > 1) G_ISSUE_B(1);
    G_BAR();
    for (int t = 0; t < nt; ++t) { const int cur = t & 1; const bool w1 = t + 1 < nt, i2 = t + 2 < nt;
        if (w1) { G_DMA_A(cur ^ 1, t + 1, 0); G_DMA_A(cur ^ 1, t + 1, 1); G_DMA_A(cur ^ 1, t + 1, 2); G_DMA_A(cur ^ 1, t + 1, 3); }
        if (mlim > 0) {
#pragma unroll
            for (int ks = 0; ks < 2; ++ks) { const LAS unsigned char* s_ = lds + cur * 65536 + ks * 1024; bf16x8 Bf_[4];
#pragma unroll
                for (int n_ = 0; n_ < 4; ++n_) Bf_[n_] = *(const LAS bf16x8*)(s_ + T.b_r + n_ * 2048);
#pragma unroll
                for (int m_ = 0; m_ < 8; ++m_) if (m_ < mlim) { const bf16x8 At_ = *(const LAS bf16x8*)(s_ + T.a_r + m_ * 2048);
#pragma unroll
                    for (int n_ = 0; n_ < 4; ++n_) acc[m_][n_] = __builtin_amdgcn_mfma_f32_16x16x32_bf16(Bf_[n_], At_, acc[m_][n_], 0, 0, 0); } } }
        if (w1) { G_RETIRE(); G_WRITE_B(cur ^ 1); }
        if (i2) G_ISSUE_B(t + 2);
        G_BAR(); }
#undef G_DMA_A
#undef G_ISSUE_B
#undef G_RETIRE
#undef G_WRITE_B
}
__device__ __forceinline__ __amdgpu_buffer_rsrc_t mk_rsrc(const void* p) { return __builtin_amdgcn_make_buffer_rsrc((void*)p, 0, 0x7ffffff0, 0x00020000); }
__device__ __forceinline__ void acc_zero(f32x4 (&acc)[8][4]) {
#pragma unroll
    for (int m = 0; m < 8; ++m)
#pragma unroll
        for (int n = 0; n < 4; ++n) acc[m][n] = (f32x4){0.f, 0.f, 0.f, 0.f};
}
__device__ __forceinline__ f32x4 rot1(const f32x4 a) { return (f32x4){a[1], a[2], a[3], a[0]}; }
__device__ __forceinline__ f32x4 rotinv(const f32x4 a) { return (f32x4){a[3], a[0], a[1], a[2]}; }
__device__ __forceinline__ u32x4 pack8(const f32x4 a, const f32x4 b) { u32x4 w; w.x = cvtpk(a[0], a[1]); w.y = cvtpk(a[2], a[3]); w.z = cvtpk(b[0], b[1]); w.w = cvtpk(b[2], b[3]); return w; }
__device__ __forceinline__ int vwg_id() { const int G = gridDim.x; return (G % 8 == 0) ? (int)((blockIdx.x % 8) * (G / 8) + blockIdx.x / 8) : (int)blockIdx.x; }

__device__ __forceinline__ void g8_stage_rc(int b, int& R, int& C) { const int st = b / 1024, sb = b % 1024, swz = sb ^ (((sb >> 9) & 1) << 5); R = (st >> 1) * 16 + swz / 64; C = (st & 1) * 32 + (swz % 64) / 2; }
__device__ __forceinline__ int g8_lds_byte(int r, int c) { const int st = (r >> 4) * 2 + (c >> 5), rr = r & 15, cc = c & 31, ob = rr * 64 + cc * 2; return st * 1024 + (ob ^ (((ob >> 9) & 1) << 5)); }
__device__ __forceinline__ void gemm8_issue0(char* shm_, const bf16_t* A, long lda, const bf16_t* Bt, long ldb) {
    constexpr int HT = 128 * 64; bf16_t* shm = (bf16_t*)shm_; const int tid = tid_opaque();
#define G8I_STAGE(P, BASE, LD, br) do { const long g_ = (long)(br) * (LD); \
    for (int i_ = 0; i_ < 2; ++i_) { const int b_ = tid * 16 + i_ * 8192; int r_, c_; g8_stage_rc(b_, r_, c_); \
      __builtin_amdgcn_global_load_lds((const unsigned*)((BASE) + g_ + (long)r_ * (LD) + c_), (__attribute__((address_space(3))) unsigned*)((__attribute__((address_space(3))) char*)(P) + b_), 16, 0, 0); } } while (0)
    G8I_STAGE(shm + 4 * HT, Bt, ldb, 0); G8I_STAGE(shm, A, lda, 0); G8I_STAGE(shm + 5 * HT, Bt, ldb, 128); G8I_STAGE(shm + HT, A, lda, 128);
#undef G8I_STAGE
}
__device__ __forceinline__ void gemm8_kloop(f32x4 (&acc)[2][2][4][2], char* shm_, const bf16_t* A, long lda, const bf16_t* Bt, long ldb, int nt) {
    constexpr int HT = 128 * 64;
    bf16_t* shm = (bf16_t*)shm_;
#define G8_SA(b, h) (shm + ((b) * 2 + (h)) * HT)
#define G8_SB(b, h) (shm + (4 + (b) * 2 + (h)) * HT)
#define G8_STAGE_X(T_, P, BASE, LD, br, kt) do { const long g_ = (long)(br) * (LD) + (long)(kt) * 64; \
    for (int i_ = 0; i_ < 2; ++i_) { const int b_ = (T_) * 16 + i_ * 8192; int r_, c_; g8_stage_rc(b_, r_, c_); \
      __builtin_amdgcn_global_load_lds((const unsigned*)((BASE) + g_ + (long)r_ * (LD) + c_), (__attribute__((address_space(3))) unsigned*)((__attribute__((address_space(3))) char*)(P) + b_), 16, 0, 0); } } while (0)
#define G8_STAGE(P, BASE, LD, br, kt) G8_STAGE_X(tid, P, BASE, LD, br, kt)
#define G8_LDA(dst, b, h) for (int m = 0; m < 4; ++m) for (int k = 0; k < 2; ++k) dst[m][k] = *reinterpret_cast<const bf16x8*>((char*)G8_SA(b, h) + g8_lds_byte(wr * 64 + m * 16 + fr, k * 32 + fq * 8))
#define G8_LDB(dst, b, h) for (int n = 0; n < 2; ++n) for (int k = 0; k < 2; ++k) dst[n][k] = *reinterpret_cast<const bf16x8*>((char*)G8_SB(b, h) + g8_lds_byte(wc * 32 + n * 16 + fr, k * 32 + fq * 8))
#define G8_MMA(ai, bj, At, Bt_) do { __builtin_amdgcn_s_setprio(1); \
    for (int m = 0; m < 4; ++m) for (int n = 0; n < 2; ++n) for (int k = 0; k < 2; ++k) \
      acc[ai][bj][m][n] = __builtin_amdgcn_mfma_f32_16x16x32_bf16(Bt_[n][k], At[m][k], acc[ai][bj][m][n], 0, 0, 0); \
    __builtin_amdgcn_s_setprio(0); } while (0)
#define G8_WAIT_V(n) asm volatile("s_waitcnt vmcnt(" #n ")" ::: "memory")
#define G8_WAIT_L(n) asm volatile("s_waitcnt lgkmcnt(" #n ")" ::: "memory")
#define G8_BAR __builtin_amdgcn_s_barrier()
#define G8_SCHED __builtin_amdgcn_sched_barrier(0)
    const int tid = tid_opaque(); int wid = tid >> 6, lane = tid & 63, wr = wid >> 2, wc = wid & 3, fr = lane & 15, fq = lane >> 4;
    bf16x8 At[4][2], B0[2][2], B1[2][2];
    if (wr == 1) G8_BAR;
    G8_WAIT_V(4); G8_BAR;
    G8_STAGE(G8_SB(1, 0), Bt, ldb, 0, 1); G8_STAGE(G8_SA(1, 0), A, lda, 0, 1); G8_STAGE(G8_SB(1, 1), Bt, ldb, 128, 1);
    G8_WAIT_V(6); G8_BAR;
    for (int t = 0; t < nt - 2; t += 2) {
        G8_LDB(B0, 0, 0); G8_SCHED; G8_LDA(At, 0, 0); G8_STAGE(G8_SA(1, 1), A, lda, 128, t + 1);
        G8_WAIT_L(8); G8_BAR; G8_WAIT_L(0); G8_MMA(0, 0, At, B0); G8_BAR; G8_SCHED;
        G8_LDB(B1, 0, 1); G8_STAGE(G8_SB(0, 0), Bt, ldb, 0, t + 2);
        G8_BAR; G8_WAIT_L(0); G8_MMA(0, 1, At, B1); G8_BAR;
        G8_LDA(At, 0, 1); G8_STAGE(G8_SA(0, 0), A, lda, 0, t + 2);
        G8_BAR; G8_WAIT_L(0); G8_MMA(1, 0, At, B0); G8_BAR; G8_SCHED;
        G8_STAGE(G8_SB(0, 1), Bt, ldb, 128, t + 2);
        G8_WAIT_V(6); G8_BAR; G8_MMA(1, 1, At, B1); G8_BAR;
        G8_LDB(B0, 1, 0); G8_SCHED; G8_LDA(At, 1, 0); G8_STAGE(G8_SA(0, 1), A, lda, 128, t + 2);
        G8_WAIT_L(8); G8_BAR; G8_WAIT_L(0); G8_MMA(0, 0, At, B0); G8_BAR; G8_SCHED;
        G8_LDB(B1, 1, 1); G8_STAGE(G8_SB(1, 0), Bt, ldb, 0, t + 3);
        G8_BAR; G8_WAIT_L(0); G8_MMA(0, 1, At, B1); G8_BAR;
        G8_LDA(At, 1, 1); G8_STAGE(G8_SA(1, 0), A, lda, 0, t + 3);
        G8_BAR; G8_WAIT_L(0); G8_MMA(1, 0, At, B0); G8_BAR; G8_SCHED;
        G8_STAGE(G8_SB(1, 1), Bt, ldb, 128, t + 3);
        G8_WAIT_V(6); G8_BAR; G8_MMA(1, 1, At, B1); G8_BAR;
    }
    int tz = tid_opaque(); wid = tz >> 6; lane = tz & 63; wr = wid >> 2; wc = wid & 3; fr = lane & 15; fq = lane >> 4;
    { G8_LDB(B0, 0, 0); G8_WAIT_V(0); G8_LDA(At, 0, 0); G8_STAGE_X(tz, G8_SA(1, 1), A, lda, 128, nt - 1);
      G8_BAR; G8_WAIT_L(0); G8_MMA(0, 0, At, B0); G8_BAR;
      G8_LDB(B1, 0, 1); G8_BAR; G8_WAIT_L(0); G8_MMA(0, 1, At, B1); G8_BAR;
      G8_LDA(At, 0, 1); G8_WAIT_V(4); G8_BAR; G8_WAIT_L(0); G8_MMA(1, 0, At, B0); G8_MMA(1, 1, At, B1); G8_BAR; }
    { G8_LDB(B0, 1, 0); G8_LDA(At, 1, 0); G8_WAIT_V(2); G8_BAR; G8_WAIT_L(0); G8_MMA(0, 0, At, B0); G8_BAR;
      G8_LDB(B1, 1, 1); G8_WAIT_V(0); G8_BAR; G8_WAIT_L(0); G8_MMA(0, 1, At, B1); G8_BAR;
      G8_LDA(At, 1, 1); G8_BAR; G8_WAIT_L(0); G8_MMA(1, 0, At, B0); G8_MMA(1, 1, At, B1); G8_BAR; }
    if (wr == 0) G8_BAR;
}
#define G8_ZERO(acc) do { _Pragma("unroll") for (int a_ = 0; a_ < 2; ++a_) _Pragma("unroll") for (int b_ = 0; b_ < 2; ++b_) _Pragma("unroll") for (int m_ = 0; m_ < 4; ++m_) _Pragma("unroll") for (int n_ = 0; n_ < 2; ++n_) acc[a_][b_][m_][n_] = (f32x4){0.f, 0.f, 0.f, 0.f}; } while (0)
__device__ __forceinline__ void prep_tile(const float* W, size_t ldw, int k0, int nsrc0, bf16_t* WT, size_t ldt, int ndst0, LAS unsigned char* lds) {
    LAS unsigned* T = (LAS unsigned*)lds;
    const int tid = tid_opaque();
#pragma unroll
    for (int i = 0; i < 4; ++i) { const int it = tid + 512 * i, nq = (it & 15) + 16 * ((it >> 6) & 3), kp = ((it >> 4) & 3) + 4 * (it >> 8);
        const float* w = W + (size_t)(k0 + 2 * kp) * ldw + nsrc0 + 4 * nq; const f32x4 w0 = *(const f32x4*)w, w1 = *(const f32x4*)(w + ldw);
#pragma unroll
        for (int j = 0; j < 4; ++j) T[(4 * nq + j) * 33 + kp] = cvtpk(w0[j], w1[j]); }
    __syncthreads();
    { const int n = tid >> 1, hh = tid & 1; u32x4 o[4];
#pragma unroll
      for (int q = 0; q < 4; ++q)
#pragma unroll
          for (int j = 0; j < 4; ++j) o[q][j] = T[n * 33 + hh * 16 + q * 4 + j];
      bf16_t* d = WT + (size_t)(ndst0 + n) * ldt + k0 + hh * 32;
#pragma unroll
      for (int q = 0; q < 4; ++q) *(u32x4*)(d + q * 8) = o[q]; }
    __syncthreads();
}
__device__ __forceinline__ void phase_prep(const Ptrs& p, LAS unsigned char* lds) {
    bf16_t* wtin = (bf16_t*)(p.ws + OFF_WTIN); bf16_t* wtco = (bf16_t*)(p.ws + OFF_WTCO); bf16_t* wtao = (bf16_t*)(p.ws + OFF_WTAO); bf16_t* wto = (bf16_t*)(p.ws + OFF_WTO);
    for (int t = vwg_id(); t < 1792; t += gridDim.x) {
        if (t < 1280) { const int kb = t & 31, nb = t >> 5, pc = nb * 256; prep_tile(p.w_in, NIN, kb * 64, pc < C_GC ? pc : pc + (W_GC - C_GC), wtin, WTP2, pc, lds); }
        else if (t < 1408) { const int q = t - 1280, kb = q & 15, nb = q >> 4; prep_tile(p.w_conv_out, D, kb * 64, nb * 256, wtco, WTP1, nb * 256, lds); }
        else if (t < 1536) { const int q = t - 1408, kb = q & 15, nb = q >> 4; prep_tile(p.w_attn_out, D, kb * 64, nb * 256, wtao, WTP1, nb * 256, lds); }
        else { const int q = t - 1536, kb = q & 31, nb = q >> 5; prep_tile(p.w_out, D, kb * 64, nb * 256, wto, WTP2, nb * 256, lds); }
    }
}
__device__ __forceinline__ void phase_gemm1(const Ptrs& p, LAS unsigned char* lds) {
    const bf16_t* ha = (const bf16_t*)(p.ws + OFF_HA); bf16_t* pr = (bf16_t*)(p.ws + OFF_PROJ); const bf16_t* wtin = (const bf16_t*)(p.ws + OFF_WTIN);
#define G1_A(u_) (ha + (size_t)((((u_) >> 3) & 31) * 256) * D)
#define G1_B(u_) (wtin + (size_t)((((u_) & 7) + 8 * ((u_) >> 8)) * 256) * WTP2)
    { const int u0 = vwg_id(); if (u0 < 32 * 40) gemm8_issue0((char*)lds, G1_A(u0), D, G1_B(u0), WTP2); }
    for (int u = vwg_id(); u < 32 * 40; u += gridDim.x) {
        const int pm = (u >> 3) & 31, pn = (u & 7) + 8 * (u >> 8);
        const int row0 = pm * 256, pcol0 = pn * 256;
        f32x4 acc[2][2][4][2]; G8_ZERO(acc);
        gemm8_kloop(acc, (char*)lds, G1_A(u), D, G1_B(u), WTP2, D / 64);
        { const int un = u + (int)gridDim.x; if (un < 32 * 40) gemm8_issue0((char*)lds, G1_A(un), D, G1_B(un), WTP2); }
        const int tid = tid_opaque(), wid = tid >> 6, lane = tid & 63, wr = wid >> 2, wc = wid & 3, fr = lane & 15, fq = lane >> 4;
        const int mode = (pcol0 >= C_GC) ? 2 : ((pcol0 >= C_Q && pcol0 < C_K) ? 1 : 0);
        const int cst = (fq & 1) ? 16 + 4 * (fq - 1) : 4 * fq;
#pragma unroll
        for (int ai = 0; ai < 2; ++ai)
#pragma unroll
            for (int m = 0; m < 4; ++m) { bf16_t* prow = pr + (size_t)(row0 + ai * 128 + wr * 64 + m * 16 + fr) * PLD + pcol0 + wc * 32 + cst;
#pragma unroll
                for (int bj = 0; bj < 2; ++bj) { f32x4 v0 = acc[ai][bj][m][0], v1 = acc[ai][bj][m][1];
                    if (mode == 1) { v0 *= QSCALE; v1 *= QSCALE; }
                    else if (mode == 2) {
#pragma unroll
                        for (int j = 0; j < 4; ++j) { v0[j] = sigmoidf_(v0[j]); v1[j] = sigmoidf_(v1[j]); } }
#pragma unroll
                    for (int j = 0; j < 4; ++j) { const auto r = __builtin_amdgcn_permlane16_swap(__float_as_uint(v0[j]), __float_as_uint(v1[j]), false, false); v0[j] = __uint_as_float(r[0]); v1[j] = __uint_as_float(r[1]); }
                    *(u32x4*)(prow + bj * 128) = pack8(v0, v1); } }
    }
#undef G1_A
#undef G1_B
}
__device__ __forceinline__ void phase_merge(const Ptrs& p, LAS unsigned char* lds) {
    const bf16_t* ua = (const bf16_t*)(p.ws + OFF_UA); const bf16_t* pr = (const bf16_t*)(p.ws + OFF_PROJ); bf16_t* mg = (bf16_t*)(p.ws + OFF_MRG);
    const bf16_t* wtco = (const bf16_t*)(p.ws + OFF_WTCO); const bf16_t* wtao = (const bf16_t*)(p.ws + OFF_WTAO);
    for (int u = vwg_id(); u < 32 * 8; u += gridDim.x) {
        const int pm = u >> 3, pn = u & 7, row0 = pm * 256, col0 = pn * 256;
        f32x4 acc[2][2][4][2]; G8_ZERO(acc);
        gemm8_issue0((char*)lds, ua + (size_t)row0 * 2048, 2048, wtco + (size_t)col0 * WTP1, WTP1);
#pragma unroll 1
        for (int seg = 0; seg < 2; ++seg) {
            gemm8_kloop(acc, (char*)lds, ua + (size_t)row0 * 2048 + seg * 1024, 2048, (seg ? wtao : wtco) + (size_t)col0 * WTP1, WTP1, 1024 / 64);
            if (seg == 0) gemm8_issue0((char*)lds, ua + (size_t)row0 * 2048 + 1024, 2048, wtao + (size_t)col0 * WTP1, WTP1);
            else { const int un = u + (int)gridDim.x; if (un < 32 * 8) gemm8_issue0((char*)lds, ua + (size_t)((un >> 3) * 256) * 2048, 2048, wtco + (size_t)((un & 7) * 256) * WTP1, WTP1); }
            const int tid = tid_opaque(), wid = tid >> 6, lane = tid & 63, wr = wid >> 2, wc = wid & 3, fr = lane & 15, fq = lane >> 4;
#pragma unroll
            for (int ai = 0; ai < 2; ++ai)
#pragma unroll
                for (int m = 0; m < 4; ++m) { const int row = row0 + ai * 128 + wr * 64 + m * 16 + fr;
#pragma unroll
                    for (int bj = 0; bj < 2; ++bj)
#pragma unroll
                        for (int n = 0; n < 2; ++n) { const int c = col0 + bj * 128 + wc * 32 + n * 16 + fq * 4; const size_t o = (size_t)row * PLD + c;
                            const u32x2 sa = *(const u32x2*)(pr + o + C_GA); u32x2 sc = sa; if (seg == 0) sc = *(const u32x2*)(pr + o + C_GC);
                            f32x4 v = acc[ai][bj][m][n];
                            const float a0 = bflo(sa.x), a1 = bfhi(sa.x), a2 = bflo(sa.y), a3 = bfhi(sa.y);
                            if (seg == 0) { v[0] *= bflo(sc.x) * __builtin_amdgcn_rcpf(a0); v[1] *= bfhi(sc.x) * __builtin_amdgcn_rcpf(a1); v[2] *= bflo(sc.y) * __builtin_amdgcn_rcpf(a2); v[3] *= bfhi(sc.y) * __builtin_amdgcn_rcpf(a3); }
                            else { v[0] *= a0; v[1] *= a1; v[2] *= a2; v[3] *= a3; }
                            acc[ai][bj][m][n] = v;
                            if (seg == 1) { u32x2 w; w.x = cvtpk(v[0], v[1]); w.y = cvtpk(v[2], v[3]); *(u32x2*)(mg + (size_t)row * D + c) = w; } }
                    asm volatile("" ::: "memory"); }
        }
    }
}
__device__ __forceinline__ void phase_out(const Ptrs& p, LAS unsigned char* lds) {
    const bf16_t* mg = (const bf16_t*)(p.ws + OFF_MRG); float* x1 = (float*)(p.ws + OFF_X1); const float* mod = (const float*)(p.ws + OFF_MOD); const bf16_t* wto = (const bf16_t*)(p.ws + OFF_WTO);
    for (int u = vwg_id(); u < 32 * 8; u += gridDim.x) {
        const int pm = u >> 3, pn = u & 7, row0 = pm * 256, col0 = pn * 256;
        f32x4 acc[2][2][4][2]; G8_ZERO(acc);
        if (u == vwg_id()) gemm8_issue0((char*)lds, mg + (size_t)row0 * D, D, wto + (size_t)col0 * WTP2, WTP2);
        gemm8_kloop(acc, (char*)lds, mg + (size_t)row0 * D, D, wto + (size_t)col0 * WTP2, WTP2, D / 64);
        { const int un = u + (int)gridDim.x; if (un < 32 * 8) gemm8_issue0((char*)lds, mg + (size_t)((un >> 3) * 256) * D, D, wto + (size_t)((un & 7) * 256) * WTP2, WTP2); }
        const int tid = tid_opaque(), wid = tid >> 6, lane = tid & 63, wr = wid >> 2, wc = wid & 3, fr = lane & 15, fq = lane >> 4;
        const float* gm = mod + (size_t)(row0 / S) * NMOD + 2 * D;
#pragma unroll
        for (int ai = 0; ai < 2; ++ai)
#pragma unroll
            for (int m = 0; m < 4; ++m) { const int row = row0 + ai * 128 + wr * 64 + m * 16 + fr;
#pragma unroll
                for (int bj = 0; bj < 2; ++bj)
#pragma unroll
                    for (int n = 0; n < 2; ++n) { const int c = col0 + bj * 128 + wc * 32 + n * 16 + fq * 4; const size_t o = (size_t)row * D + c;
                        *(f32x4*)(x1 + o) = *(const f32x4*)(p.x + o) + *(const f32x4*)(gm + c) * acc[ai][bj][m][n]; } }
    }
}
constexpr size_t OFF_GUTOT = OFF_CTRL + 1024;
constexpr size_t OFF_GUDONE = OFF_CTRL + 2048;
struct MoeUnit { int e, mt, nt, cnt, base, light; };
__device__ __forceinline__ bool moe_unit(int cv, int u, int ntiles_n, MoeUnit& mu) {
    int base = 0;
#pragma unroll
    for (int e = 0; e < E; ++e) { const int c = __builtin_amdgcn_readlane(cv, e), tm = (c + 255) >> 8, nu = tm * ntiles_n;
        if (u < nu) { mu.e = e; mu.cnt = c; mu.base = base; mu.nt = u / tm; mu.mt = u - mu.nt * tm; mu.light = (mu.mt == tm - 1 && c - mu.mt * 256 <= 128) ? 1 : 0; return true; }
        u -= nu; base += tm * 256; }
    return false;
}
__device__ __forceinline__ void phase_moe_gu(const Ptrs& p, LAS unsigned char* lds) {
    const int* counts = (const int*)(p.ws + OFF_CTRL); const bf16_t* h2 = (const bf16_t*)(p.ws + OFF_HA); bf16_t* act = (bf16_t*)(p.ws + OFF_ACT);
    const __amdgpu_buffer_rsrc_t ract = __builtin_amdgcn_make_buffer_rsrc((void*)act, 0, 0x7ffffff0, 0x00020000);
    MoeUnit mu; const int cv = counts[tid_opaque() & 31];
    for (int u = vwg_id(); moe_unit(cv, u, 16, mu); u += gridDim.x) {
        GemmT T; T.init();
        const int* list = (const int*)(p.ws + OFF_LIST) + (size_t)mu.e * NTOK; const int i0 = mu.mt * 256, n0 = mu.nt * 128;
        unsigned ao[4];
#pragma unroll
        for (int i = 0; i < 4; ++i) { const int r = i0 + T.aR + 64 * i; const int tok = (r < mu.cnt) ? (list[r] >> 2) : 0; ao[i] = (unsigned)((tok * D + T.aC) * 2); }
        const float* wsel = ((__builtin_amdgcn_readfirstlane(T.b_p) & 1) ? p.w_up : p.w_gate) + (size_t)mu.e * D * D + n0;
        const unsigned bo = (unsigned)((T.b_k * D + T.b_gucol) * 4);
        f32x4 acc[8][4]; acc_zero(acc);
        const int mlim = __builtin_amdgcn_readfirstlane(T.wr) ? 0 : ((mu.cnt - i0 + 15) >> 4);
        if (mu.light) gemm_kloop_light(acc, lds, T, mk_rsrc(h2), ao[0], ao[1], ao[2], ao[3], mk_rsrc(wsel), bo, D * 4u, D / 64, mlim);
        else gemm_kloop(acc, lds, T, mk_rsrc(h2), ao[0], ao[1], ao[2], ao[3], mk_rsrc(wsel), bo, D * 4u, D / 64);
T.init_epi();
        const int c = n0 + T.wc * 32 + T.fq * 8;
        const float* bg = p.b_gate + (size_t)mu.e * D + c; const float* bu = p.b_up + (size_t)mu.e * D + c;
        const f32x4 bg0 = *(const f32x4*)bg, bg1 = *(const f32x4*)(bg + 4), bu0 = *(const f32x4*)bu, bu1 = *(const f32x4*)(bu + 4);
#pragma unroll
        for (int m = 0; m < 8; ++m) { const int r = i0 + T.wr * 128 + m * 16 + T.fr;
            f32x4 g0 = acc[m][0] + bg0, g1 = rot1(acc[m][1]) + bg1, u0 = acc[m][2] + bu0, u1 = rot1(acc[m][3]) + bu1;
#pragma unroll
            for (int j = 0; j < 4; ++j) { float g = fminf(g0[j], 7.0f), uu = fminf(fmaxf(u0[j], -7.0f), 7.0f); g0[j] = (uu + 1.0f) * g * sigmoidf_(1.702f * g);
                g = fminf(g1[j], 7.0f); uu = fminf(fmaxf(u1[j], -7.0f), 7.0f); g1[j] = (uu + 1.0f) * g * sigmoidf_(1.702f * g); }
            if (r < mu.cnt) __builtin_amdgcn_raw_buffer_store_b128(pack8(g0, g1), ract, (unsigned)(((mu.base + r) * D + c) * 2), 0, 16); }
        asm volatile("s_waitcnt vmcnt(0)" ::: "memory");
        __syncthreads();
        if (threadIdx.x == 0) { __hip_atomic_fetch_add((unsigned*)(p.ws + OFF_GUDONE) + mu.e * 16, 1u, __ATOMIC_RELAXED, __HIP_MEMORY_SCOPE_AGENT);
                                __hip_atomic_fetch_add((unsigned*)(p.ws + OFF_GUTOT), 1u, __ATOMIC_RELAXED, __HIP_MEMORY_SCOPE_AGENT); }
    }
}
__device__ __forceinline__ void phase_moe_down(const Ptrs& p, LAS unsigned char* lds) {
    const int* counts = (const int*)(p.ws + OFF_CTRL); const bf16_t* act = (const bf16_t*)(p.ws + OFF_ACT); bf16_t* y = (bf16_t*)(p.ws + OFF_Y); const float* gate = (const float*)(p.ws + OFF_GATE);
    MoeUnit mu; const int cv = counts[tid_opaque() & 31];
    int Ttot = 0;
#pragma unroll
    for (int e = 0; e < E; ++e) Ttot += (__builtin_amdgcn_readlane(cv, e) + 255) >> 8;
    const int G = (int)gridDim.x, Ugu = Ttot * 16, u0 = ((vwg_id() - Ugu % G) % G + G) % G;
    LAS int* wslot = (LAS int*)(lds + GEMM_LDS + 4096);
    int all_done = 0;
    for (int u = u0; moe_unit(cv, u, 8, mu); u += G) {
        if (!all_done) {
            if (threadIdx.x == 0) {
                unsigned* tot = (unsigned*)(p.ws + OFF_GUTOT); unsigned* de = (unsigned*)(p.ws + OFF_GUDONE) + mu.e * 16;
                const unsigned need = (unsigned)(((mu.cnt + 255) >> 8) * 16); int all = 0;
                for (unsigned sp = 0; sp < (1u << 22); ++sp) {
                    if (__hip_atomic_load(tot, __ATOMIC_RELAXED, __HIP_MEMORY_SCOPE_AGENT) >= (unsigned)Ugu) { all = 1; break; }
                    if (__hip_atomic_load(de, __ATOMIC_RELAXED, __HIP_MEMORY_SCOPE_AGENT) >= need) break;
                    __builtin_amdgcn_s_sleep(8); }
                __builtin_amdgcn_fence(__ATOMIC_ACQUIRE, "agent");
                *wslot = all; }
            asm volatile("s_waitcnt vmcnt(0)" ::: "memory");
            __syncthreads();
            all_done = __builtin_amdgcn_readfirstlane(*wslot);
            __syncthreads(); }
        GemmT T; T.init();
        const int* list = (const int*)(p.ws + OFF_LIST) + (size_t)mu.e * NTOK; const int i0 = mu.mt * 256, col0 = mu.nt * 256;
        const unsigned ao = (unsigned)((T.aR * D + T.aC) * 2), bo = (unsigned)((T.b_k * D + T.b_col) * 4);
        int pa = -1; float pg = 0.f;
        { const int t_ = tid_opaque(); if (t_ < 256 && i0 + t_ < mu.cnt) { pa = list[i0 + t_]; pg = gate[pa]; } }
        f32x4 acc[8][4]; acc_zero(acc);
        const int mlim = __builtin_amdgcn_readfirstlane(T.wr) ? 0 : ((mu.cnt - i0 + 15) >> 4);
        if (mu.light) gemm_kloop_light(acc, lds, T, mk_rsrc(act + (size_t)(mu.base + i0) * D), ao, ao + 64u * 4096, ao + 128u * 4096, ao + 192u * 4096,
                                       mk_rsrc(p.w_down + (size_t)mu.e * D * D + col0), bo, D * 4u, D / 64, mlim);
        else gemm_kloop(acc, lds, T, mk_rsrc(act + (size_t)(mu.base + i0) * D), ao, ao + 64u * 4096, ao + 128u * 4096, ao + 192u * 4096,
                        mk_rsrc(p.w_down + (size_t)mu.e * D * D + col0), bo, D * 4u, D / 64);
T.init_epi();
        LAS int* tab = (LAS int*)(lds + GEMM_LDS);
        { const int t_ = tid_opaque(); if (t_ < 256) { tab[2 * t_] = pa; tab[2 * t_ + 1] = __float_as_int(pg); } }
        __syncthreads();
        const float* bd = p.b_down + (size_t)mu.e * D;
#pragma unroll
        for (int m = 0; m < 8; ++m) { const int rl = T.wr * 128 + m * 16 + T.fr, r = i0 + rl;
            if (r < mu.cnt) { const int a = tab[2 * rl]; const float gt = __int_as_float(tab[2 * rl + 1]);
#pragma unroll
                for (int pp = 0; pp < 2; ++pp) { const int c = col0 + T.wc * 64 + pp * 32 + T.fq * 8;
                    const f32x4 v0 = (acc[m][2 * pp] + *(const f32x4*)(bd + c)) * gt, v1 = (rot1(acc[m][2 * pp + 1]) + *(const f32x4*)(bd + c + 4)) * gt;
                    *(u32x4*)(y + (size_t)a * D + c) = pack8(v0, v1); } } }
        __syncthreads();
    }
}
extern __shared__ __attribute__((aligned(1024))) unsigned char dyn_lds[];
typedef float f32x16 __attribute__((ext_vector_type(16)));
typedef short v4i16_t __attribute__((ext_vector_type(4)));
__device__ __forceinline__ float xhalf_max(float v) { const auto rr = __builtin_amdgcn_permlane32_swap(__float_as_uint(v), __float_as_uint(v), false, false); return fmaxf(__uint_as_float(rr[0]), __uint_as_float(rr[1])); }
__device__ __forceinline__ float xhalf_sum(float v) { const auto rr = __builtin_amdgcn_permlane32_swap(__float_as_uint(v), __float_as_uint(v), false, false); return __uint_as_float(rr[0]) + __uint_as_float(rr[1]); }
template <int CTRL> __device__ __forceinline__ float dppf(float x) { return __builtin_bit_cast(float, __builtin_amdgcn_mov_dpp(__builtin_bit_cast(int, x), CTRL, 0xf, 0xf, true)); }
constexpr int DPP_XOR1 = 0xB1, DPP_XOR2 = 0x4E, DPP_XOR7 = 0x141, DPP_XOR8 = 0x128;
__device__ __forceinline__ float xrow_sum(float x) { const auto s = __builtin_amdgcn_permlane16_swap(__float_as_uint(x), __float_as_uint(x), false, false); x = __uint_as_float(s[0]) + __uint_as_float(s[1]); return xhalf_sum(x); }
__device__ __forceinline__ float xrow_max(float x) { const auto s = __builtin_amdgcn_permlane16_swap(__float_as_uint(x), __float_as_uint(x), false, false); x = fmaxf(__uint_as_float(s[0]), __uint_as_float(s[1])); return xhalf_max(x); }
__device__ __forceinline__ float wave_sum(float v) { v += dppf<DPP_XOR1>(v); v += dppf<DPP_XOR2>(v); v += dppf<DPP_XOR7>(v); v += dppf<DPP_XOR8>(v); return xrow_sum(v); }
__device__ __forceinline__ float wave_max(float v) { v = fmaxf(v, dppf<DPP_XOR1>(v)); v = fmaxf(v, dppf<DPP_XOR2>(v)); v = fmaxf(v, dppf<DPP_XOR7>(v)); v = fmaxf(v, dppf<DPP_XOR8>(v)); return xrow_max(v); }
__device__ __forceinline__ float reduce16(float (&v)[16], int lane) {
    float a[8], b[4], c[2];
#pragma unroll
    for (int i = 0; i < 8; ++i) { const auto r = __builtin_amdgcn_permlane32_swap(__float_as_uint(v[i]), __float_as_uint(v[i + 8]), false, false); a[i] = __uint_as_float(r[0]) + __uint_as_float(r[1]); }
#pragma unroll
    for (int i = 0; i < 4; ++i) { const auto r = __builtin_amdgcn_permlane16_swap(__float_as_uint(a[i]), __float_as_uint(a[i + 4]), false, false); b[i] = __uint_as_float(r[0]) + __uint_as_float(r[1]); }
#pragma unroll
    for (int i = 0; i < 2; ++i) { const float t1 = b[i] + dppf<DPP_XOR8>(b[i]), t2 = b[i + 2] + dppf<DPP_XOR8>(b[i + 2]); c[i] = (lane & 8) ? t2 : t1; }
    float d; { const float t1 = c[0] + dppf<DPP_XOR7>(c[0]), t2 = c[1] + dppf<DPP_XOR7>(c[1]); d = (lane & 4) ? t2 : t1; }
    d += dppf<DPP_XOR1>(d); d += dppf<DPP_XOR2>(d);
    return d;
}
constexpr int WT_LDS = 16 * 2048 * 4;
constexpr int AUX_LDS = 160 * 1024 - 64;

__device__ __forceinline__ void phase_mod(const Ptrs& p, LAS unsigned char* lds) {
    LAS float* sc = (LAS float*)lds;
    LAS float* red = (LAS float*)(lds + 16384);
    const int tid = tid_opaque();
    for (int i = tid; i < B * D; i += 512) { const float v = p.c[i]; sc[i] = v / (1.0f + __expf(-v)); }
    __syncthreads();
    float* mod = (float*)(p.ws + OFF_MOD);
    for (int ch = vwg_id(); ch < NMOD / 48; ch += gridDim.x) {
        const int cq = tid % 12, kg = tid / 12;
        if (kg < 42) {
            f32x4 a0 = {0.f, 0.f, 0.f, 0.f}, a1 = {0.f, 0.f, 0.f, 0.f};
            const float* wp = p.ada_w + (size_t)ch * 48 + cq * 4;
#pragma unroll 7
            for (int k = kg; k < D; k += 42) { const f32x4 w = *(const f32x4*)(wp + (size_t)k * NMOD); a0 += w * sc[k]; a1 += w * sc[D + k]; }
#pragma unroll
            for (int j = 0; j < 4; ++j) { red[kg * 96 + cq * 4 + j] = a0[j]; red[kg * 96 + 48 + cq * 4 + j] = a1[j]; }
        }
        __syncthreads();
        if (tid < 96) { float s = 0.f; for (int g = 0; g < 42; ++g) s += red[g * 96 + tid]; const int b = tid / 48, c = ch * 48 + tid % 48; mod[(size_t)b * NMOD + c] = s + p.ada_b[c]; }
        __syncthreads();
    }
}
__device__ __forceinline__ void stage_wt16(LAS float* wt, const float* w, size_t ldw) {
    const int tid = tid_opaque();
    for (int i = tid; i < 2048 * 4; i += 512) { const int k = i >> 2, q = i & 3; const f32x4 v = *(const f32x4*)(w + (size_t)k * ldw + q * 4);
#pragma unroll
        for (int j = 0; j < 4; ++j) wt[(q * 4 + j) * 2048 + k] = v[j]; }
}
constexpr int N1_PITCH = 2048 * 2 + 16;
constexpr int N1_WT = 0, N1_HS = 16 * N1_PITCH, N1_GS = 2 * 16 * N1_PITCH, N1_PS = N1_GS + 16384, N1_END = N1_PS + 8 * 256 * 4;
__device__ __forceinline__ void phase_norm1(const Ptrs& p, LAS unsigned char* lds) {
    LAS float* gs = (LAS float*)(lds + N1_GS); LAS float* sh = gs + 2048; LAS float* ps = (LAS float*)(lds + N1_PS);
    const int tid = tid_opaque(), lane = tid & 63, wid = tid >> 6;
    for (int i = tid; i < 1024 * 4; i += 512) { const int kp = i >> 2, q = i & 3; const float* w = p.w_in + (size_t)(2 * kp) * NIN + W_F + q * 4;
        const f32x4 v0 = *(const f32x4*)w, v1 = *(const f32x4*)(w + NIN);
#pragma unroll
        for (int j = 0; j < 4; ++j) *(LAS unsigned*)(lds + N1_WT + (q * 4 + j) * N1_PITCH + kp * 4) = cvtpk(v0[j], v1[j]); }
    bf16_t* ha = (bf16_t*)(p.ws + OFF_HA); float* logf = (float*)(p.ws + OFF_LOGF);
    for (int blk = vwg_id(); blk < NTOK / 32; blk += gridDim.x) {
        const int b = (blk * 32) / S; const float* mod = (const float*)(p.ws + OFF_MOD) + (size_t)b * NMOD;
        __syncthreads();
        for (int i = tid; i < 2048; i += 512) { gs[i] = p.norm_mix_g[i] * (1.0f + mod[D + i]); sh[i] = mod[i]; }
        __syncthreads();
#pragma unroll 1
        for (int half = 0; half < 2; ++half) {
#pragma unroll 1
            for (int rr = 0; rr < 2; ++rr) {
                const int r16 = wid * 2 + rr, row = blk * 32 + half * 16 + r16; const float* xr = p.x + (size_t)row * D;
                f32x4 v[8]; float ss = 0.f;
#pragma unroll
                for (int c = 0; c < 8; ++c) { v[c] = *(const f32x4*)(xr + c * 256 + lane * 4); ss += v[c][0] * v[c][0] + v[c][1] * v[c][1] + v[c][2] * v[c][2] + v[c][3] * v[c][3]; }
                ss = wave_sum(ss); const float r = rsqrtf(ss * (1.0f / D) + EPS);
#pragma unroll
                for (int c = 0; c < 8; ++c) { const int k = c * 256 + lane * 4; const f32x4 g4 = *(const LAS f32x4*)(gs + k), s4 = *(const LAS f32x4*)(sh + k);
                    const f32x4 h4 = (v[c] * r) * g4 + s4; u32x2 w; w.x = cvtpk(h4[0], h4[1]); w.y = cvtpk(h4[2], h4[3]);
                    *(u32x2*)(ha + (size_t)row * D + k) = w; *(LAS u32x2*)(lds + N1_HS + r16 * N1_PITCH + k * 2) = w; }
            }
            __syncthreads();
            {
                f32x4 acc = {0.f, 0.f, 0.f, 0.f};
                const LAS unsigned char* ap = lds + N1_HS + (lane & 15) * N1_PITCH + wid * 512 + (lane >> 4) * 16;
                const LAS unsigned char* bp = lds + N1_WT + (lane & 15) * N1_PITCH + wid * 512 + (lane >> 4) * 16;
#pragma unroll
                for (int ks = 0; ks < 8; ++ks) acc = __builtin_amdgcn_mfma_f32_16x16x32_bf16(*(const LAS bf16x8*)(ap + ks * 64), *(const LAS bf16x8*)(bp + ks * 64), acc, 0, 0, 0);
#pragma unroll
                for (int i = 0; i < 4; ++i) ps[wid * 256 + (4 * (lane >> 4) + i) * 16 + (lane & 15)] = acc[i];
            }
            __syncthreads();
            if (tid < 256) { float z = p.b_forget[tid & 15];
#pragma unroll
                for (int w = 0; w < 8; ++w) z += ps[w * 256 + tid];
                const int row = blk * 32 + half * 16 + (tid >> 4);
                logf[((size_t)b * H + (tid & 15)) * S + (row % S)] = fminf(z, 0.f) - log1pf(__expf(-fabsf(z))); }
        }
    }
}
__device__ __forceinline__ void phase_scan_conv(const Ptrs& p, LAS unsigned char* lds) {
    const int tid = tid_opaque();
    const bf16_t* pr = (const bf16_t*)(p.ws + OFF_PROJ); bf16_t* ua = (bf16_t*)(p.ws + OFF_UA);
    for (int item = vwg_id() * 512 + tid; item < (NTOK / 8) * (DC / 8); item += gridDim.x * 512) {
        const int cg = item & 127, rc = item >> 7, r0 = rc * 8, c = cg * 8;
        float w0[8], w1[8], w2[8], pm2[8], pm1[8];
#pragma unroll
        for (int j = 0; j < 8; ++j) { w0[j] = p.conv_w[c + j]; w1[j] = p.conv_w[DC + c + j]; w2[j] = p.conv_w[2 * DC + c + j]; pm2[j] = 0.f; pm1[j] = 0.f; }
        if ((r0 % S) != 0) {
#pragma unroll
            for (int d = 0; d < 2; ++d) { const bf16_t* q = pr + (size_t)(r0 - 2 + d) * PLD; const u32x4 xc = *(const u32x4*)(q + C_XC + c), cc = *(const u32x4*)(q + C_CC + c);
#pragma unroll
                for (int j = 0; j < 4; ++j) { const float e0 = bflo(xc[j]) * bflo(cc[j]), e1 = bfhi(xc[j]) * bfhi(cc[j]); if (d == 0) { pm2[2 * j] = e0; pm2[2 * j + 1] = e1; } else { pm1[2 * j] = e0; pm1[2 * j + 1] = e1; } } }
        }
#pragma unroll
        for (int i = 0; i < 8; ++i) { const bf16_t* q = pr + (size_t)(r0 + i) * PLD; const u32x4 xc = *(const u32x4*)(q + C_XC + c), cc = *(const u32x4*)(q + C_CC + c), cb = *(const u32x4*)(q + C_CB + c);
            float o[8];
#pragma unroll
            for (int j = 0; j < 4; ++j) { const float e0 = bflo(xc[j]) * bflo(cc[j]), e1 = bfhi(xc[j]) * bfhi(cc[j]);
                o[2 * j] = bflo(cb[j]) * (w0[2 * j] * pm2[2 * j] + w1[2 * j] * pm1[2 * j] + w2[2 * j] * e0); o[2 * j + 1] = bfhi(cb[j]) * (w0[2 * j + 1] * pm2[2 * j + 1] + w1[2 * j + 1] * pm1[2 * j + 1] + w2[2 * j + 1] * e1);
                pm2[2 * j] = pm1[2 * j]; pm2[2 * j + 1] = pm1[2 * j + 1]; pm1[2 * j] = e0; pm1[2 * j + 1] = e1; }
            u32x4 w; w.x = cvtpk(o[0], o[1]); w.y = cvtpk(o[2], o[3]); w.z = cvtpk(o[4], o[5]); w.w = cvtpk(o[6], o[7]);
            *(u32x4*)(ua + (size_t)(r0 + i) * 2048 + c) = w; }
    }
}
typedef short s16x4 __attribute__((ext_vector_type(4)));
constexpr int A_SLOTB = 8192, A_LDS_K = 0, A_LDS_V = 3 * A_SLOTB, A_LDS_WS = 6 * A_SLOTB, A_LDS_OST = A_LDS_WS + 8 * 256, A_LDS_F = A_LDS_OST + 8 * 4096, ATT_LDS = A_LDS_F + S * 4;
#define A_THR 32.0f
#define A_SBAR() __builtin_amdgcn_sched_barrier(0)
#define A_PIN(x) asm volatile("" : "+v"(x))
#define A_MFMA(a, b, c) __builtin_amdgcn_mfma_f32_32x32x16_bf16(a, b, c, 0, 0, 0)
#define A_WAIT_BAR(N) asm volatile("s_waitcnt vmcnt(" #N ") lgkmcnt(0)\n\ts_barrier" ::: "memory")
__device__ __forceinline__ int crow(int r, int hi) { return (r & 3) + 8 * (r >> 2) + 4 * hi; }
__device__ __forceinline__ unsigned a_cvtpk(float lo, float hi) { unsigned r; asm("v_cvt_pk_bf16_f32 %0, %1, %2" : "=v"(r) : "v"(lo), "v"(hi)); return r; }
__device__ __forceinline__ void a_glds16(const void* g, unsigned lds_base) {
    unsigned sv; asm volatile("s_mov_b32 %0, m0\n\ts_mov_b32 m0, %2\n\ts_nop 0\n\tglobal_load_lds_dwordx4 %1, off\n\ts_mov_b32 m0, %0" : "=&s"(sv) : "v"(g), "s"(lds_base) : "memory"); }
typedef __attribute__((address_space(3))) const char* a_lds_cptr;
__device__ __forceinline__ void a_kload2(bf16x8* kf, a_lds_cptr kp, int d0) { kf[2 * d0] = *(const __attribute__((address_space(3))) bf16x8*)(kp + d0 * 2048); kf[2 * d0 + 1] = *(const __attribute__((address_space(3))) bf16x8*)(kp + d0 * 2048 + 512); }
__device__ __forceinline__ s16x4 a_vtr(a_lds_cptr p) { return __builtin_bit_cast(s16x4, __builtin_amdgcn_ds_read_tr16_b64_v4i16((__attribute__((address_space(3))) v4i16_t*)p)); }
#define A_MX3(a, b, c) __builtin_fmaxf(__builtin_fmaxf((a), (b)), (c))
__device__ __forceinline__ float a_rowmax(const f32x16& p0, const f32x16& p1) {
    float a = A_MX3(p0[0], p0[1], p1[0]), b = A_MX3(p0[2], p0[3], p1[1]); a = A_MX3(a, p1[2], p1[3]);
#pragma unroll
    for (int r = 4; r < 16; r += 4) { a = A_MX3(a, p0[r], p0[r + 1]); b = A_MX3(b, p0[r + 2], p0[r + 3]); a = A_MX3(a, p1[r], p1[r + 1]); b = A_MX3(b, p1[r + 2], p1[r + 3]); }
    float m = __builtin_fmaxf(a, b); auto rr = __builtin_amdgcn_permlane32_swap(__float_as_uint(m), __float_as_uint(m), false, false);
    return __builtin_fmaxf(__uint_as_float(rr[0]), __uint_as_float(rr[1])); }
__device__ __forceinline__ void a_cmask(f32x16& p0, f32x16& p1, int jb, int qrel, int hi) {
    const int kb = 64 * jb + 4 * hi;
#pragma unroll
    for (int r = 0; r < 16; ++r) { const int kv = kb + (r & 3) + 8 * (r >> 2); if (kv > qrel) p0[r] = -INFINITY; if (kv + 32 > qrel) p1[r] = -INFINITY; } }
#define A_FLD(X0, X1, fp_) do { _Pragma("unroll") for (int g_ = 0; g_ < 4; ++g_) { const f32x4 fa_ = *(const __attribute__((address_space(3))) f32x4*)((fp_) + g_ * 32), fb_ = *(const __attribute__((address_space(3))) f32x4*)((fp_) + 128 + g_ * 32); \
        _Pragma("unroll") for (int i_ = 0; i_ < 4; ++i_) { X0[4 * g_ + i_] = fa_[i_]; X1[4 * g_ + i_] = fb_[i_]; } } } while (0)
#define A_FRD2(G, X, fp_, g_) do { if (G) { const f32x4 fa_ = *(const __attribute__((address_space(3))) f32x4*)((fp_) + (g_) * 32), fb_ = *(const __attribute__((address_space(3))) f32x4*)((fp_) + (g_) * 32 + 32); \
        _Pragma("unroll") for (int i_ = 0; i_ < 4; ++i_) { X[4 * (g_) + i_] = fa_[i_]; X[4 * (g_) + 4 + i_] = fb_[i_]; } A_SBAR(); } } while (0)

__device__ __forceinline__ void attn64_unit(int b, int h, int qb, const bf16_t* Q, const bf16_t* __restrict__ K, const bf16_t* __restrict__ V, bf16_t* O, char* lds) {
    const int tid = tid_opaque(), lane = tid & 63, r32 = lane & 31, hi = lane >> 5; const int wid = __builtin_amdgcn_readfirstlane(tid >> 6);
    const long rowbase = (long)b * S; const int q0 = qb * 256, NT = (q0 + 256) / 64;
    const bf16_t* Qw = Q + (rowbase + q0 + wid * 32) * PLD + h * 64;
    const unsigned lds0 = (unsigned)(size_t)lds; float* wsf = (float*)(lds + A_LDS_WS) + wid * 64;
    const bf16_t* ksrc = K + rowbase * PLD + h * 64 + (long)lane * PLD + wid * 8;
    const bf16_t* vsrc = V + rowbase * PLD + h * 64 + (long)(16 * (wid & 3) + (lane >> 2)) * PLD + (wid >> 2) * 32 + (lane & 3) * 8;
    const unsigned kdst = lds0 + A_LDS_K + wid * 1024, vdst = lds0 + A_LDS_V + wid * 1024;
#define DMA_K(t, slot) a_glds16(ksrc + (long)(t) * 64 * PLD, (unsigned)__builtin_amdgcn_readfirstlane(kdst + (slot)))
#define DMA_V(t, slot) a_glds16(vsrc + (long)(t) * 64 * PLD, (unsigned)__builtin_amdgcn_readfirstlane(vdst + (slot)))
    const a_lds_cptr vp0 = (a_lds_cptr)lds + A_LDS_V + ((lane >> 4) & 1) * 32 + (lane & 3) * 8 + (4 * hi + ((lane & 15) >> 2)) * 64;
    const a_lds_cptr kp0 = (a_lds_cptr)lds + A_LDS_K + hi * 1024 + r32 * 16;
    const a_lds_cptr fp0 = (a_lds_cptr)lds + A_LDS_F + hi * 16;
    DMA_K(0, 0); DMA_V(0, 0); DMA_K(1, A_SLOTB);
    bf16x8 qr[4];
#pragma unroll
    for (int d0 = 0; d0 < 4; ++d0) qr[d0] = *reinterpret_cast<const bf16x8*>(&Qw[(long)r32 * PLD + d0 * 16 + hi * 8]);
    float mhat = 0.f, l_reg = 0.f; f32x16 o[2];
#pragma unroll
    for (int r = 0; r < 16; ++r) { o[0][r] = 0.f; o[1][r] = 0.f; }
    const int qrel = wid * 32 + r32; bool resc = false;
    f32x16 pA0, pA1, pB0, pB1; bf16x8 kf[8]; s16x4 vlo[8], vhi[8]; u32x4 pw0, pw1, pw2, pw3;
    int sl_prev = 0, sl_cur = 0, sl_next = A_SLOTB;
#define ROT() do { sl_prev = sl_cur; sl_cur = sl_next; sl_next = (sl_next == 2 * A_SLOTB) ? 0 : sl_next + A_SLOTB; } while (0)
#define EX(v) __builtin_amdgcn_exp2f((v) + nmh)
#define RESC() do { if (resc) { _Pragma("unroll") for (int d_ = 0; d_ < 2; ++d_) _Pragma("unroll") for (int r = 0; r < 16; ++r) o[d_][r] *= wsf[crow(r, hi)]; } } while (0)
    DMA_K(2, 2 * A_SLOTB);
    A_WAIT_BAR(0);
    _Pragma("unroll") for (int d0 = 0; d0 < 4; ++d0) a_kload2(kf, kp0, d0);
    A_FLD(pA0, pA1, fp0);
    pA0 = A_MFMA(kf[0], qr[0], pA0); pA1 = A_MFMA(kf[1], qr[0], pA1); pA0 = A_MFMA(kf[2], qr[1], pA0); pA1 = A_MFMA(kf[3], qr[1], pA1);
    pA0 = A_MFMA(kf[4], qr[2], pA0); pA1 = A_MFMA(kf[5], qr[2], pA1); pA0 = A_MFMA(kf[6], qr[3], pA0); pA1 = A_MFMA(kf[7], qr[3], pA1);
    if (NT == 4) a_cmask(pA0, pA1, 0, qrel, hi);
    { const float rm = a_rowmax(pA0, pA1); mhat = rm; const float nmh = -mhat;
#pragma unroll
      for (int r = 0; r < 16; ++r) { pA0[r] = EX(pA0[r]); pA1[r] = EX(pA1[r]); } }
    A_FLD(pB0, pB1, fp0 + 256);
    A_WAIT_BAR(0);
    DMA_K(3, 0); DMA_V(1, A_SLOTB); ROT();
    _Pragma("unroll") for (int d0 = 0; d0 < 4; ++d0) a_kload2(kf, kp0 + sl_cur, d0);
    A_WAIT_BAR(2);
#define PKW(P, i) a_cvtpk(P[i], P[i + 1])
#define PAF(k) __builtin_bit_cast(bf16x8, pw##k)
#define VFR(i) (bf16x8){vlo[i][0], vlo[i][1], vlo[i][2], vlo[i][3], vhi[i][0], vhi[i][1], vhi[i][2], vhi[i][3]}
#define VRD(i) do { vlo[i] = a_vtr(vp_ + (((i) >> 2) * 4096 + ((i) & 3) * 1024)); vhi[i] = a_vtr(vp_ + (((i) >> 2) * 4096 + ((i) & 3) * 1024 + 512)); } while (0)
#define KRD(G, d0) do { if (G) { a_kload2(kf, kp0 + sl_next, d0); A_SBAR(); } } while (0)
#define GAPA(MF, a0, a1, a2, a3, W0, W1, PW) do { MF; sacc += a0; sacc += a1; sacc += a2; sacc += a3; W0; W1; A_PIN(PW); A_PIN(sacc); A_SBAR(); } while (0)
#define GAPB(MF, X, i) do { MF; X[i] = EX(X[i]); X[i + 1] = EX(X[i + 1]); X[i + 2] = EX(X[i + 2]); X[i + 3] = EX(X[i + 3]); A_PIN(X); A_SBAR(); } while (0)
#define STEP(C0, C1, P0, P1, t, MASK, GK, GV, GL) do { A_SBAR(); \
    const a_lds_cptr vp_ = vp0 + sl_prev; const a_lds_cptr fn_ = fp0 + ((t) + 1) * 256; \
    VRD(0); A_SBAR(); float sacc = P0[0] + P0[1]; \
                    GAPA(C0 = A_MFMA(kf[0], qr[0], C0), P0[2], P0[3], P0[4], P0[5],     pw0[0] = PKW(P0, 0),  pw0[1] = PKW(P0, 2),  pw0); \
    VRD(4); A_SBAR(); GAPA(C1 = A_MFMA(kf[1], qr[0], C1), P0[6], P0[7], P0[8], P0[9],     pw0[2] = PKW(P0, 4),  pw0[3] = PKW(P0, 6),  pw0); \
    VRD(1); A_SBAR(); GAPA(C0 = A_MFMA(kf[2], qr[1], C0),    P0[10], P0[11], P0[12], P0[13], pw1[0] = PKW(P0, 8),  pw1[1] = PKW(P0, 10), pw1); \
    VRD(5); A_SBAR(); GAPA(C1 = A_MFMA(kf[3], qr[1], C1),    P0[14], P0[15], P1[0], P1[1],   pw1[2] = PKW(P0, 12), pw1[3] = PKW(P0, 14), pw1); \
    VRD(2); A_SBAR(); GAPA(C0 = A_MFMA(kf[4], qr[2], C0),    P1[2], P1[3], P1[4], P1[5],     pw2[0] = PKW(P1, 0),  pw2[1] = PKW(P1, 2),  pw2); \
    VRD(6); A_SBAR(); GAPA(C1 = A_MFMA(kf[5], qr[2], C1),    P1[6], P1[7], P1[8], P1[9],     pw2[2] = PKW(P1, 4),  pw2[3] = PKW(P1, 6),  pw2); \
    VRD(3); A_SBAR(); GAPA(C0 = A_MFMA(kf[6], qr[3], C0),    P1[10], P1[11], P1[12], P1[13], pw3[0] = PKW(P1, 8),  pw3[1] = PKW(P1, 10), pw3); \
    VRD(7); A_SBAR(); GAPA(C1 = A_MFMA(kf[7], qr[3], C1),    P1[14], P1[15], 0.f, 0.f,       pw3[2] = PKW(P1, 12), pw3[3] = PKW(P1, 14), pw3); \
    l_reg += sacc; \
    if (GK) DMA_K((t) + 3, sl_cur); if (GV) DMA_V((t) + 1, sl_next); \
    if (MASK) a_cmask(C0, C1, (t) - (NT - 4), qrel, hi); \
    { const float rm = a_rowmax(C0, C1) - mhat; resc = false; \
      if (__builtin_expect(__any(rm > A_THR), 0)) { const float dl = __builtin_fmaxf(rm, 0.f); mhat += dl; \
          const float f = __builtin_amdgcn_exp2f(-dl); l_reg *= f; if (hi == 0) wsf[r32] = f; resc = true; } } \
    const float nmh = -mhat; A_SBAR(); \
    A_FRD2(GL, P0, fn_, 0); GAPB(o[0] = A_MFMA(PAF(0), VFR(0), o[0]), C0, 0);  A_FRD2(GL, P0, fn_, 2); GAPB(o[1] = A_MFMA(PAF(0), VFR(4), o[1]), C0, 4); \
    KRD(GL, 0); GAPB(o[0] = A_MFMA(PAF(1), VFR(1), o[0]), C0, 8);  KRD(GL, 1); GAPB(o[1] = A_MFMA(PAF(1), VFR(5), o[1]), C0, 12); \
    KRD(GL, 2); GAPB(o[0] = A_MFMA(PAF(2), VFR(2), o[0]), C1, 0);  KRD(GL, 3); GAPB(o[1] = A_MFMA(PAF(2), VFR(6), o[1]), C1, 4); \
    A_FRD2(GL, P1, fn_ + 128, 0); GAPB(o[0] = A_MFMA(PAF(3), VFR(3), o[0]), C1, 8);  A_FRD2(GL, P1, fn_ + 128, 2); GAPB(o[1] = A_MFMA(PAF(3), VFR(7), o[1]), C1, 12); \
    } while (0)
    int t = 1;
    for (; t + 5 < NT; t += 2) {
        STEP(pB0, pB1, pA0, pA1, t, false, true, true, true);     A_WAIT_BAR(2); RESC(); ROT();
        STEP(pA0, pA1, pB0, pB1, t + 1, false, true, true, true); A_WAIT_BAR(2); RESC(); ROT();
    }
#define ENDW(tt) do { if ((tt) + 3 < NT) { A_WAIT_BAR(2); } else if ((tt) + 2 < NT) { A_WAIT_BAR(1); } else { A_WAIT_BAR(0); } } while (0)
    for (; t + 1 < NT; t += 2) {
        STEP(pB0, pB1, pA0, pA1, t, true, (t + 3 < NT), (t + 1 < NT), (t + 1 < NT));         ENDW(t);     RESC(); ROT();
        STEP(pA0, pA1, pB0, pB1, t + 1, true, (t + 4 < NT), (t + 2 < NT), (t + 2 < NT));     ENDW(t + 1); RESC(); ROT();
    }
    STEP(pB0, pB1, pA0, pA1, NT - 1, true, false, false, false); RESC();
    { float sacc = pB0[0] + pB0[1];
#pragma unroll
      for (int r = 2; r < 16; ++r) sacc += pB0[r];
#pragma unroll
      for (int r = 0; r < 16; ++r) sacc += pB1[r];
      l_reg += sacc;
      pw0 = (u32x4){PKW(pB0, 0), PKW(pB0, 2), PKW(pB0, 4), PKW(pB0, 6)}; pw1 = (u32x4){PKW(pB0, 8), PKW(pB0, 10), PKW(pB0, 12), PKW(pB0, 14)};
      pw2 = (u32x4){PKW(pB1, 0), PKW(pB1, 2), PKW(pB1, 4), PKW(pB1, 6)}; pw3 = (u32x4){PKW(pB1, 8), PKW(pB1, 10), PKW(pB1, 12), PKW(pB1, 14)};
      const a_lds_cptr vp_ = vp0 + sl_cur; _Pragma("unroll") for (int i = 0; i < 8; ++i) VRD(i);
      o[0] = A_MFMA(PAF(0), VFR(0), o[0]); o[1] = A_MFMA(PAF(0), VFR(4), o[1]); o[0] = A_MFMA(PAF(1), VFR(1), o[0]); o[1] = A_MFMA(PAF(1), VFR(5), o[1]);
      o[0] = A_MFMA(PAF(2), VFR(2), o[0]); o[1] = A_MFMA(PAF(2), VFR(6), o[1]); o[0] = A_MFMA(PAF(3), VFR(3), o[0]); o[1] = A_MFMA(PAF(3), VFR(7), o[1]); }
    { auto rr = __builtin_amdgcn_permlane32_swap(__float_as_uint(l_reg), __float_as_uint(l_reg), false, false); l_reg = __uint_as_float(rr[0]) + __uint_as_float(rr[1]); }
    if (hi == 0) wsf[32 + r32] = l_reg; asm volatile("s_waitcnt lgkmcnt(0)" ::: "memory");
    float rli[16];
#pragma unroll
    for (int r = 0; r < 16; ++r) rli[r] = __builtin_amdgcn_rcpf(wsf[32 + crow(r, hi)]);
    bf16_t* Ow = O + (rowbase + q0 + wid * 32) * 2048 + h * 64; bf16_t* stg = (bf16_t*)(lds + A_LDS_OST) + wid * 2048;
#pragma unroll
    for (int r = 0; r < 16; ++r) { const int orow = crow(r, hi);
#pragma unroll
        for (int d0 = 0; d0 < 2; ++d0) stg[orow * 64 + d0 * 32 + r32] = (bf16_t)(a_cvtpk(o[d0][r] * rli[r], 0.f) & 0xffffu); }
    asm volatile("s_waitcnt lgkmcnt(0)" ::: "memory");
#pragma unroll
    for (int i = 0; i < 4; ++i) { const int row = i * 8 + (lane >> 3), ch = lane & 7; *(u32x4*)(Ow + (long)row * 2048 + ch * 8) = *(const u32x4*)(stg + row * 64 + ch * 8); }
    asm volatile("s_waitcnt lgkmcnt(0)\n\ts_barrier" ::: "memory");
#undef DMA_K
#undef DMA_V
#undef ROT
#undef EX
#undef RESC
#undef PKW
#undef PAF
#undef VFR
#undef VRD
#undef KRD
#undef ENDW
#undef GAPA
#undef GAPB
#undef STEP
}
__device__ __forceinline__ void phase_attn(const Ptrs& p, LAS unsigned char* lds) {
    const bf16_t* pr = (const bf16_t*)(p.ws + OFF_PROJ); bf16_t* ua = (bf16_t*)(p.ws + OFF_UA);
    for (int pi = vwg_id(); pi < 256; pi += gridDim.x) {
        const int s_ = pi & 7, bh = pi >> 3;
        {
            const int tid = tid_opaque(), lane = tid & 63, wid = tid >> 6; LAS float* wtot = (LAS float*)(lds + A_LDS_WS); LAS float* ft = (LAS float*)(lds + A_LDS_F);
            const float* lf = (const float*)(p.ws + OFF_LOGF) + (size_t)bh * S;
            f32x4 a = *(const f32x4*)(lf + tid * 8), b4 = *(const f32x4*)(lf + tid * 8 + 4);
            a[1] += a[0]; a[2] += a[1]; a[3] += a[2]; b4[0] += a[3]; b4[1] += b4[0]; b4[2] += b4[1]; b4[3] += b4[2];
            const float tot = b4[3]; float inc = tot;
#pragma unroll
            for (int o = 1; o < 64; o <<= 1) { const float n = __shfl_up(inc, o); if (lane >= o) inc += n; }
            __syncthreads();
            if (lane == 63) wtot[wid] = inc;
            __syncthreads();
            float off = inc - tot; for (int w = 0; w < wid; ++w) off += wtot[w];
            *(LAS f32x4*)(ft + tid * 8) = (a + off) * -LOG2E; *(LAS f32x4*)(ft + tid * 8 + 4) = (b4 + off) * -LOG2E;
            __syncthreads(); }
#pragma unroll 1
        for (int half = 0; half < 2; ++half)
            attn64_unit(bh >> 4, bh & 15, half ? 15 - s_ : s_, pr + C_Q, pr + C_K, pr + C_V, ua + 1024, (char*)lds);
    }
}
constexpr int R_PITCH = 512 * 2 + 16, R_WHI = 0, R_WLO = 32 * R_PITCH, R_HHI = 64 * R_PITCH, R_HLO = 96 * R_PITCH, R_GS = 128 * R_PITCH, R_LG = R_GS + 16384, R_TAB = R_LG + 4096, R_END = R_TAB + 2048;
__device__ __forceinline__ void phase_norm2_route(const Ptrs& p, LAS unsigned char* lds) {
    LAS float* gs = (LAS float*)(lds + R_GS); LAS float* sh = gs + 2048; LAS float* lg = (LAS float*)(lds + R_LG); LAS float* ps = (LAS float*)lds;
    const int tid = tid_opaque(), lane = tid & 63, wid = tid >> 6;
    bf16_t* ha = (bf16_t*)(p.ws + OFF_HA); const float* x1 = (const float*)(p.ws + OFF_X1);
    int* counts = (int*)(p.ws + OFF_CTRL); int* list = (int*)(p.ws + OFF_LIST); float* gate = (float*)(p.ws + OFF_GATE);
    for (int blk = vwg_id(); blk < NTOK / 32; blk += gridDim.x) {
        const int b = (blk * 32) / S; const float* mod = (const float*)(p.ws + OFF_MOD) + (size_t)b * NMOD;
        __syncthreads();
        for (int i = tid; i < 2048; i += 512) { gs[i] = p.norm_ffn_g[i] * (1.0f + mod[4 * D + i]); sh[i] = mod[3 * D + i]; }
        __syncthreads();
#pragma unroll 1
        for (int half = 0; half < 2; ++half) {
            f32x4 v[2][8];
#pragma unroll
            for (int q = 0; q < 2; ++q) { const int row = blk * 32 + half * 16 + wid * 2 + q; const float* xr = x1 + (size_t)row * D; float ss = 0.f;
#pragma unroll
                for (int c = 0; c < 8; ++c) { v[q][c] = *(const f32x4*)(xr + c * 256 + lane * 4); ss += v[q][c][0] * v[q][c][0] + v[q][c][1] * v[q][c][1] + v[q][c][2] * v[q][c][2] + v[q][c][3] * v[q][c][3]; }
                ss = wave_sum(ss); const float r = rsqrtf(ss * (1.0f / D) + EPS);
#pragma unroll
                for (int c = 0; c < 8; ++c) { const int k = c * 256 + lane * 4; const f32x4 g4 = *(const LAS f32x4*)(gs + k), s4 = *(const LAS f32x4*)(sh + k);
                    v[q][c] = (v[q][c] * r) * g4 + s4; u32x2 w; w.x = cvtpk(v[q][c][0], v[q][c][1]); w.y = cvtpk(v[q][c][2], v[q][c][3]); *(u32x2*)(ha + (size_t)row * D + k) = w; } }
            f32x4 acc[2];
            acc[0] = (f32x4){0.f, 0.f, 0.f, 0.f}; acc[1] = (f32x4){0.f, 0.f, 0.f, 0.f};
#pragma unroll
            for (int ch = 0; ch < 4; ++ch) {
                __syncthreads();
                for (int i = tid; i < 2048; i += 512) { const int kp = i >> 3, cq = i & 7; const float* w = p.router_w + (size_t)(512 * ch + 2 * kp) * E + cq * 4;
                    const f32x4 w0 = *(const f32x4*)w, w1 = *(const f32x4*)(w + E);
#pragma unroll
                    for (int j = 0; j < 4; ++j) { const unsigned hi = cvtpk(w0[j], w1[j]), lo = cvtpk(w0[j] - bflo(hi), w1[j] - bfhi(hi));
                        *(LAS unsigned*)(lds + R_WHI + (cq * 4 + j) * R_PITCH + kp * 4) = hi; *(LAS unsigned*)(lds + R_WLO + (cq * 4 + j) * R_PITCH + kp * 4) = lo; } }
#pragma unroll
                for (int q = 0; q < 2; ++q)
#pragma unroll
                    for (int cc = 0; cc < 2; ++cc) { const f32x4 h4 = v[q][2 * ch + cc]; u32x2 hi, lo; hi.x = cvtpk(h4[0], h4[1]); hi.y = cvtpk(h4[2], h4[3]);
                        lo.x = cvtpk(h4[0] - bflo(hi.x), h4[1] - bfhi(hi.x)); lo.y = cvtpk(h4[2] - bflo(hi.y), h4[3] - bfhi(hi.y));
                        const int o = (wid * 2 + q) * R_PITCH + (cc * 256 + lane * 4) * 2;
                        *(LAS u32x2*)(lds + R_HHI + o) = hi; *(LAS u32x2*)(lds + R_HLO + o) = lo; }
                __syncthreads();
#pragma unroll
                for (int s2 = 0; s2 < 2; ++s2) { const int off = (lane & 15) * R_PITCH + (2 * wid + s2) * 64 + (lane >> 4) * 16;
                    const bf16x8 ahi = *(const LAS bf16x8*)(lds + R_HHI + off), alo = *(const LAS bf16x8*)(lds + R_HLO + off);
#pragma unroll
                    for (int ct = 0; ct < 2; ++ct) { const bf16x8 bhi = *(const LAS bf16x8*)(lds + R_WHI + ct * 16 * R_PITCH + off), blo = *(const LAS bf16x8*)(lds + R_WLO + ct * 16 * R_PITCH + off);
                        acc[ct] = __builtin_amdgcn_mfma_f32_16x16x32_bf16(ahi, bhi, acc[ct], 0, 0, 0); acc[ct] = __builtin_amdgcn_mfma_f32_16x16x32_bf16(alo, bhi, acc[ct], 0, 0, 0);
                        acc[ct] = __builtin_amdgcn_mfma_f32_16x16x32_bf16(ahi, blo, acc[ct], 0, 0, 0); } }
            }
            __syncthreads();
#pragma unroll
            for (int ct = 0; ct < 2; ++ct)
#pragma unroll
                for (int i = 0; i < 4; ++i) ps[wid * 512 + (4 * (lane >> 4) + i) * 32 + ct * 16 + (lane & 15)] = acc[ct][i];
            __syncthreads();
            { const int o = tid; float z = p.router_b[o & 31];
#pragma unroll
              for (int w = 0; w < 8; ++w) z += ps[w * 512 + o];
              lg[half * 512 + o] = z; }
        }
        LAS int* lcnt = (LAS int*)(lds + R_TAB);
        LAS int* lbase = lcnt + 32;
        LAS int* asg_e = lbase + 32;
        LAS int* asg_r = asg_e + 128;
        if (tid < 32) lcnt[tid] = 0;
        __syncthreads();
#pragma unroll 1
        for (int rr = 0; rr < 4; ++rr) {
            const int rl = wid * 4 + rr, row = blk * 32 + rl;
            float val = (lane < 32) ? lg[rl * 32 + lane] : -INFINITY;
            float tv[4]; int ti[4];
#pragma unroll
            for (int k = 0; k < 4; ++k) { const float m = wave_max(val);
                const unsigned long long bal = __ballot(val == m); const int idx = __ffsll((long long)bal) - 1;
                tv[k] = m; ti[k] = idx; if (lane == idx) val = -INFINITY; }
            if (lane < 4) { float pe[4], sum = 0.f;
#pragma unroll
                for (int k = 0; k < 4; ++k) { pe[k] = __expf(tv[k] - tv[0]); sum += pe[k]; }
                const int e = lane == 0 ? ti[0] : lane == 1 ? ti[1] : lane == 2 ? ti[2] : ti[3]; const float pk = (lane == 0 ? pe[0] : lane == 1 ? pe[1] : lane == 2 ? pe[2] : pe[3]) / sum;
                const int lr = __hip_atomic_fetch_add((int*)(lcnt + e), 1, __ATOMIC_RELAXED, __HIP_MEMORY_SCOPE_WORKGROUP); asg_e[rl * 4 + lane] = e; asg_r[rl * 4 + lane] = lr; gate[row * 4 + lane] = pk; }
        }
        __syncthreads();
        if (tid < 32) lbase[tid] = atomicAdd(&counts[tid], lcnt[tid]);
        __syncthreads();
        if (tid < 128) { const int e = asg_e[tid]; list[(size_t)e * NTOK + lbase[e] + asg_r[tid]] = (blk * 32) * 4 + tid; }
    }
}
__device__ __forceinline__ void phase_final(const Ptrs& p, LAS unsigned char* lds) {
    const int tid = tid_opaque(), lane = tid & 63, wid = tid >> 6;
    const float* x1 = (const float*)(p.ws + OFF_X1); const bf16_t* y = (const bf16_t*)(p.ws + OFF_Y);
    for (int row = vwg_id() * 8 + wid; row < NTOK; row += gridDim.x * 8) {
        const int b = row / S; const float* gf = (const float*)(p.ws + OFF_MOD) + (size_t)b * NMOD + 5 * D; const float* xr = x1 + (size_t)row * D; const bf16_t* yr = y + (size_t)row * 4 * D;
        f32x4 v[8]; float ss = 0.f;
#pragma unroll
        for (int c = 0; c < 8; ++c) { const int k = c * 256 + lane * 4; f32x4 s = {0.f, 0.f, 0.f, 0.f};
#pragma unroll
            for (int q = 0; q < 4; ++q) { const u32x2 w = *(const u32x2*)(yr + (size_t)q * D + k); s[0] += bflo(w.x); s[1] += bfhi(w.x); s[2] += bflo(w.y); s[3] += bfhi(w.y); }
            v[c] = *(const f32x4*)(xr + k) + *(const f32x4*)(gf + k) * s; ss += v[c][0] * v[c][0] + v[c][1] * v[c][1] + v[c][2] * v[c][2] + v[c][3] * v[c][3]; }
        ss = wave_sum(ss); const float r = rsqrtf(ss * (1.0f / D) + EPS);
#pragma unroll
        for (int c = 0; c < 8; ++c) { const int k = c * 256 + lane * 4; *(f32x4*)(p.out + (size_t)row * D + k) = (v[c] * r) * *(const f32x4*)(p.final_g + k); }
    }
}

#define XB_TMO      128
#define XB_XCNT(j)  (256  + 64 * (j))
#define XB_XSUB(j)  (1280 + 64 * (j))
#define XB_XGEN(j)  (2304 + 64 * (j))
#define XB_TOP      3328
#define XB_TOPGEN   3392
#define XCD_BAR_WORDS 3456
#define XB_SPIN_CAP (1u << 18)

__device__ __forceinline__ unsigned xb_ld(unsigned* p)              { return __hip_atomic_load(p, __ATOMIC_RELAXED, __HIP_MEMORY_SCOPE_AGENT); }
__device__ __forceinline__ unsigned xb_add(unsigned* p, unsigned v) { return __hip_atomic_fetch_add(p, v, __ATOMIC_RELAXED, __HIP_MEMORY_SCOPE_AGENT); }
__device__ __forceinline__ unsigned xb_xcc_id() { return (unsigned)__builtin_amdgcn_s_getreg((3 << 11) | 20) & 0xFu; }
#define XB_SPIN(cond, bar) do { unsigned _sp = 0; while (cond) { __builtin_amdgcn_s_sleep(1); \
    if ((++_sp & 255u) == 0u) { if (xb_ld(&(bar)[XB_TMO])) break; if (_sp > XB_SPIN_CAP) { atomicAdd(&(bar)[XB_TMO], 1u); break; } } } } while (0)

struct XcdBarrier {
    unsigned* bar; unsigned x;
    volatile LAS unsigned* st;
};

__device__ __forceinline__ XcdBarrier xcd_barrier_post(unsigned* bar, volatile LAS unsigned* st) {
    XcdBarrier b; b.bar = bar; b.x = xb_xcc_id(); b.st = st;
    if (threadIdx.x == 0) (void)xb_add(&bar[XB_XCNT(b.x)], 1u);
    return b;
}
__device__ __forceinline__ void xcd_barrier_complete(unsigned* bar, unsigned x, unsigned& nloc, unsigned& nx) {
    const unsigned G = gridDim.x * gridDim.y * gridDim.z;
    unsigned sum, cnt, mine, sp = 0u;
    for (;;) {
        sum = 0u; cnt = 0u; mine = 0u;
#pragma unroll
        for (unsigned j = 0; j < 16; ++j) { const unsigned c = xb_ld(&bar[XB_XCNT(j)]); sum += c; cnt += (c > 0u) ? 1u : 0u; mine = (j == x) ? c : mine; }
        if (sum == G) break;
        __builtin_amdgcn_s_sleep(1);
        if ((++sp & 255u) == 0u) { if (xb_ld(&bar[XB_TMO])) break; if (sp > XB_SPIN_CAP) { atomicAdd(&bar[XB_TMO], 1u); break; } }
    }
    nloc = mine > 0u ? mine : 1u; nx = cnt > 0u ? cnt : 1u;
}

__device__ __forceinline__ void xcd_barrier(const XcdBarrier& b) {
    asm volatile("s_waitcnt vmcnt(0)" ::: "memory");
    __syncthreads();
    if (threadIdx.x == 0) {
        unsigned* bar = b.bar;
        __builtin_amdgcn_s_waitcnt(0);
        unsigned nloc = b.st[0], nx = b.st[1];
        if (nloc == 0u) { xcd_barrier_complete(bar, b.x, nloc, nx); b.st[0] = nloc; b.st[1] = nx; }
        const unsigned old = xb_add(&bar[XB_XSUB(b.x)], 1u);
        const unsigned gen = old / nloc;
        if (old + 1u == (gen + 1u) * nloc) {
            __builtin_amdgcn_fence(__ATOMIC_RELEASE, "agent");
            asm volatile("s_waitcnt vmcnt(0)" ::: "memory");
            const unsigned og = xb_add(&bar[XB_TOP], 1u);
            const unsigned tg = og / nx;
            if (og + 1u == (tg + 1u) * nx) xb_add(&bar[XB_TOPGEN], 1u);
            else XB_SPIN(xb_ld(&bar[XB_TOPGEN]) == tg, bar);
            __builtin_amdgcn_fence(__ATOMIC_ACQUIRE, "agent");
            xb_add(&bar[XB_XGEN(b.x)], 1u);
            asm volatile("s_waitcnt vmcnt(0)" ::: "memory");
        } else {
            XB_SPIN(xb_ld(&bar[XB_XGEN(b.x)]) == gen, bar);
            __builtin_amdgcn_fence(__ATOMIC_ACQUIRE, "agent");
            asm volatile("s_waitcnt vmcnt(0)" ::: "memory");
        }
    }
    __syncthreads();
}


constexpr int LDS_TOTAL = AUX_LDS + 16;
constexpr size_t OFF_BAR = OFF_CTRL + 4096;
static_assert(GEMM_LDS <= AUX_LDS && ATT_LDS <= AUX_LDS && N1_END <= AUX_LDS && R_END <= AUX_LDS, "LDS");
static_assert(4096 + XCD_BAR_WORDS * 4 <= 65536, "ctrl");
__global__ void __launch_bounds__(512, 2) mega_fwd(Ptrs p) {
    LAS unsigned char* lds = (LAS unsigned char*)dyn_lds;
    volatile LAS unsigned* st = (volatile LAS unsigned*)(lds + AUX_LDS);
    if (threadIdx.x == 0) { st[0] = 0u; st[1] = 0u; st[2] = 0u; st[3] = 0u; }
    __syncthreads();
    XcdBarrier bar = xcd_barrier_post((unsigned*)(p.ws + OFF_BAR), st);
    phase_mod(p, lds);          phase_prep(p, lds);         xcd_barrier(bar);
    phase_norm1(p, lds);        xcd_barrier(bar);
    phase_gemm1(p, lds);        xcd_barrier(bar);
    phase_attn(p, lds);         phase_scan_conv(p, lds);    xcd_barrier(bar);
    phase_merge(p, lds);        xcd_barrier(bar);
    phase_out(p, lds);          xcd_barrier(bar);
    phase_norm2_route(p, lds);  xcd_barrier(bar);
    phase_moe_gu(p, lds);
    phase_moe_down(p, lds);     xcd_barrier(bar);
    phase_final(p, lds);
}

extern "C" void kernel_launch(void* const* d_in, const int* in_sizes, int n_in, void* d_out, int out_size, void* d_ws, size_t ws_size, hipStream_t stream) {
    Ptrs p{};
    const float** f = (const float**)&p;
    for (int i = 0; i < 21; ++i) f[i] = (const float*)d_in[i];
    p.out = (float*)d_out; p.ws = (unsigned char*)d_ws;
    static int grid = 0;
    if (!grid) {
        (void)hipFuncSetAttribute((const void*)mega_fwd, hipFuncAttributeMaxDynamicSharedMemorySize, LDS_TOTAL);
        int dev = 0, cus = 0, per_cu = 0;
        (void)hipGetDevice(&dev);
        (void)hipDeviceGetAttribute(&cus, hipDeviceAttributeMultiprocessorCount, dev);
        (void)hipOccupancyMaxActiveBlocksPerMultiprocessor(&per_cu, mega_fwd, 512, LDS_TOTAL);
        grid = cus * (per_cu < 1 ? per_cu : 1);
        if (grid <= 0) grid = cus > 0 ? cus : 256;
    }
    (void)hipMemsetAsync(p.ws + OFF_CTRL, 0, 65536, stream);
    mega_fwd<<<grid, 512, LDS_TOTAL, stream>>>(p);
}
```

```cpp
#include <hip/hip_runtime.h>
#include <stdint.h>

typedef unsigned short bf16_t;
typedef float f32x4 __attribute__((ext_vector_type(4)));
typedef unsigned u32x4 __attribute__((ext_vector_type(4)));
typedef unsigned u32x2 __attribute__((ext_vector_type(2)));

namespace cfg {
constexpr int B = 2, S = 4096, D = 2048, NTOK = B * S, H = 16, DH = 64, DA = 1024, DC = 1024;
constexpr int NIN = 10256, NMOD = 6 * D, E = 32, TOPK = 4, NASG = NTOK * TOPK;
constexpr int PLD = 10240;
constexpr int C_XC = 0, C_CB = 1024, C_CC = 2048, C_Q = 3072, C_K = 4096, C_V = 5120, C_GC = 6144, C_GA = 8192;
constexpr int W_F = 6144, W_GC = 6160, W_GA = 8208;
constexpr float EPS = 1e-6f, LOG2E = 1.4426950408889634f;
constexpr float QSCALE = 0.125f * LOG2E;
constexpr int ACT_ROWS = NASG + E * 256;
constexpr size_t al(size_t x) { return (x + 255) & ~(size_t)255; }
constexpr size_t OFF_CTRL = 0;
constexpr size_t OFF_MOD = 65536;
constexpr size_t OFF_LOGF = OFF_MOD + al((size_t)B * NMOD * 4);
constexpr size_t OFF_FCUM = OFF_LOGF + al((size_t)B * H * S * 4);
constexpr size_t OFF_HA = OFF_FCUM + al((size_t)B * H * S * 4);
constexpr size_t OFF_PROJ = OFF_HA + al((size_t)NTOK * D * 2);
constexpr size_t OFF_UA = OFF_PROJ + al((size_t)NTOK * PLD * 2);
constexpr size_t OFF_MRG = OFF_UA + al((size_t)NTOK * 2048 * 2);
constexpr size_t OFF_X1 = OFF_MRG + al((size_t)NTOK * D * 2);
constexpr size_t OFF_TMP = OFF_X1 + al((size_t)NTOK * D * 4);
constexpr size_t OFF_GATE = OFF_TMP + al((size_t)NTOK * D * 4);
constexpr size_t OFF_LIST = OFF_GATE + al((size_t)NASG * 4);
constexpr size_t OFF_ACT = OFF_LIST + al((size_t)E * NTOK * 4);
constexpr size_t OFF_Y = OFF_ACT + al((size_t)ACT_ROWS * D * 2);
constexpr size_t WS_END = OFF_Y + al((size_t)NASG * D * 2);
constexpr int WTP2 = D + 64, WTP1 = 1024 + 64;
constexpr size_t OFF_WTIN = WS_END;
constexpr size_t OFF_WTCO = OFF_WTIN + al((size_t)PLD * WTP2 * 2);
constexpr size_t OFF_WTAO = OFF_WTCO + al((size_t)D * WTP1 * 2);
constexpr size_t OFF_WTO = OFF_WTAO + al((size_t)D * WTP1 * 2);
constexpr size_t WS_END2 = OFF_WTO + al((size_t)D * WTP2 * 2);
}
using namespace cfg;

__device__ __forceinline__ float bf2f(bf16_t v) { return __uint_as_float(((unsigned)v) << 16); }
__device__ __forceinline__ bf16_t f2bf(float f) { unsigned u = __float_as_uint(f); u += 0x7fffu + ((u >> 16) & 1u); return (bf16_t)(u >> 16); }
__device__ __forceinline__ float sigmoidf_(float x) { return __builtin_amdgcn_rcpf(1.0f + __builtin_amdgcn_exp2f(x * -1.4426950408889634f)); }

struct Ptrs {
    const float *x, *c, *ada_w, *ada_b, *norm_mix_g, *w_in, *b_forget, *conv_w, *w_conv_out, *w_attn_out, *w_out, *norm_ffn_g,
        *router_w, *router_b, *w_gate, *b_gate, *w_up, *b_up, *w_down, *b_down, *final_g;
    float* out; unsigned char* ws;
};

#define LAS __attribute__((address_space(3)))
typedef short bf16x8 __attribute__((ext_vector_type(8)));
typedef float f32x2_t __attribute__((ext_vector_type(2)));
typedef __bf16 bf16x2_t __attribute__((ext_vector_type(2)));
__device__ __forceinline__ unsigned cvtpk(float lo, float hi) { f32x2_t v = {lo, hi}; bf16x2_t b = __builtin_convertvector(v, bf16x2_t); return __builtin_bit_cast(unsigned, b); }
__device__ __forceinline__ float bflo(unsigned w) { return __uint_as_float(w << 16); }
__device__ __forceinline__ float bfhi(unsigned w) { return __uint_as_float(w & 0xffff0000u); }
__device__ __forceinline__ int tid_opaque() { int t = threadIdx.x; asm volatile("" : "+v"(t)); return t; }
constexpr int GEMM_LDS = 131072;

struct GemmT {
    int wr, wc, fr, fq;
    int aR, aC;
    unsigned a_w;
    int b_k, b_col, b_p, b_gucol;
    unsigned b_w, b_rot;
    unsigned a_r, b_r;
    __device__ __forceinline__ void init_epi() { const int tid = tid_opaque(), wid = tid >> 6, lane = tid & 63; wr = wid >> 2; wc = wid & 3; fr = lane & 15; fq = lane >> 4; }
    __device__ __forceinline__ void init() {
        const int tid = tid_opaque(), wid = tid >> 6, lane = tid & 63;
        wr = wid >> 2; wc = wid & 3; fr = lane & 15; fq = lane >> 4;
        aR = (wid >> 1) * 16 + (lane >> 2); aC = (wid & 1) * 32 + (((lane & 3) ^ ((lane >> 5) << 1)) * 8);
        a_w = (unsigned)(wid * 1024 + lane * 16);
        { const int l32 = lane & 31, kc8 = 2 * (wid >> 1) + (lane >> 5), wc_ = l32 >> 3, bfq = (l32 >> 1) & 3, nlo = l32 & 1; b_p = wid & 1;
          b_k = kc8 * 8; b_col = wc_ * 64 + b_p * 32 + bfq * 8 + nlo * 4; b_gucol = wc_ * 32 + bfq * 8 + nlo * 4;
          const int sub = wc_ * 4 + 2 * b_p + nlo;
          b_w = (unsigned)((sub * 2 + (kc8 >> 2)) * 1024 + (((4 * bfq) * 64 + (kc8 & 3) * 16) ^ ((bfq >> 1) << 5))); b_rot = (unsigned)(nlo * 64); }
        const unsigned lo = (unsigned)((fr * 64 + fq * 16) ^ ((fr >> 3) << 5));
        a_r = (unsigned)(wr * 16384) + lo; b_r = 32768u + (unsigned)(wc * 8192) + lo;
    }
};

__device__ __forceinline__ void gemm_kloop(f32x4 (&acc)[8][4], LAS unsigned char* lds, const GemmT& T,
                                           __amdgpu_buffer_rsrc_t ra, unsigned ao0, unsigned ao1, unsigned ao2, unsigned ao3,
                                           __amdgpu_buffer_rsrc_t rb, unsigned bo, unsigned ldbB, int nt) {
    f32x4 sb[8];
    const unsigned a_wu = (unsigned)__builtin_amdgcn_readfirstlane((int)(T.a_w & ~1023u));
#define G_DMA_A(buf, t, i_) __builtin_amdgcn_raw_ptr_buffer_load_lds(ra, (LAS void*)(lds + (buf) * 65536 + a_wu + (i_) * 8192), 16, ao##i_, (unsigned)(t) * 128u, 0, 0)
#define G_ISSUE_B(t) do { const unsigned so_ = (unsigned)(t) * 64u * ldbB; _Pragma("unroll") for (int i_ = 0; i_ < 8; ++i_) sb[i_] = __builtin_bit_cast(f32x4, __builtin_amdgcn_raw_buffer_load_b128(rb, bo, so_ + (unsigned)i_ * ldbB, 0)); } while (0)
#define G_RETIRE() asm volatile("s_waitcnt vmcnt(0)" : "+v"(sb[0]), "+v"(sb[1]), "+v"(sb[2]), "+v"(sb[3]), "+v"(sb[4]), "+v"(sb[5]), "+v"(sb[6]), "+v"(sb[7]) :: "memory")
#define G_WRITE_B(buf) do { LAS unsigned char* d_ = lds + (buf) * 65536; \
        _Pragma("unroll") for (int j_ = 0; j_ < 4; ++j_) { u32x4 w_; w_.x = cvtpk(sb[0][j_], sb[1][j_]); w_.y = cvtpk(sb[2][j_], sb[3][j_]); w_.z = cvtpk(sb[4][j_], sb[5][j_]); w_.w = cvtpk(sb[6][j_], sb[7][j_]); \
            *(LAS u32x4*)(d_ + 32768 + T.b_w + ((T.b_rot + 64u * j_) & 255u)) = w_; } } while (0)
#define G_LDB(dst, buf, ks) do { const LAS unsigned char* s_ = lds + (buf) * 65536 + (ks) * 1024; _Pragma("unroll") for (int n_ = 0; n_ < 4; ++n_) dst[n_] = *(const LAS bf16x8*)(s_ + T.b_r + n_ * 2048); } while (0)
#define G_LDA(dst, buf, ks, h_) do { const LAS unsigned char* s_ = lds + (buf) * 65536 + (ks) * 1024; _Pragma("unroll") for (int m_ = 0; m_ < 4; ++m_) dst[m_] = *(const LAS bf16x8*)(s_ + T.a_r + ((h_) * 4 + m_) * 2048); } while (0)
#define G_MMA(At_, Bf_, h_) do { _Pragma("unroll") for (int m_ = 0; m_ < 4; ++m_) _Pragma("unroll") for (int n_ = 0; n_ < 4; ++n_) \
        acc[(h_) * 4 + m_][n_] = __builtin_amdgcn_mfma_f32_16x16x32_bf16(Bf_[n_], At_[m_], acc[(h_) * 4 + m_][n_], 0, 0, 0); } while (0)
#define G_SB() __builtin_amdgcn_sched_barrier(0)
#define G_BAR() do { asm volatile("s_waitcnt lgkmcnt(0)" ::: "memory"); __builtin_amdgcn_s_barrier(); asm volatile("" ::: "memory"); } while (0)
    bf16x8 Bf0[4], Bf1[4], AtA[4], AtB[4];
    G_ISSUE_B(0); G_DMA_A(0, 0, 0); G_DMA_A(0, 0, 1); G_DMA_A(0, 0, 2); G_DMA_A(0, 0, 3); G_RETIRE(); G_WRITE_B(0);
    if (nt > 1) G_ISSUE_B(1);
    G_BAR();
    for (int t = 0; t < nt; ++t) { const int cur = t & 1; const bool w1 = t + 1 < nt, i2 = t + 2 < nt;
        G_LDB(Bf0, cur, 0); G_LDA(AtA, cur, 0, 0); G_SB();
        G_LDA(AtB, cur, 0, 1); if (w1) { G_DMA_A(cur ^ 1, t + 1, 0); G_DMA_A(cur ^ 1, t + 1, 1); G_DMA_A(cur ^ 1, t + 1, 2); G_DMA_A(cur ^ 1, t + 1, 3); } G_MMA(AtA, Bf0, 0); G_SB();
        G_LDB(Bf1, cur, 1); G_LDA(AtA, cur, 1, 0); G_MMA(AtB, Bf0, 1); G_SB();
        G_LDA(AtB, cur, 1, 1); if (w1) { G_RETIRE(); G_WRITE_B(cur ^ 1); } if (i2) G_ISSUE_B(t + 2); G_MMA(AtA, Bf1, 0); G_SB();
        G_MMA(AtB, Bf1, 1); G_SB();
        G_BAR(); }
#undef G_LDA
#undef G_MMA
#undef G_SB
#undef G_DMA_A
#undef G_ISSUE_B
#undef G_WRITE_B
#undef G_RETIRE
#undef G_LDB
}
__device__ __forceinline__ void gemm_kloop_light(f32x4 (&acc)[8][4], LAS unsigned char* lds, const GemmT& T,
                                                 __amdgpu_buffer_rsrc_t ra, unsigned ao0, unsigned ao1, unsigned ao2, unsigned ao3,
                                                 __amdgpu_buffer_rsrc_t rb, unsigned bo, unsigned ldbB, int nt, int mlim) {
    f32x4 sb[8];
    const unsigned a_wu = (unsigned)__builtin_amdgcn_readfirstlane((int)(T.a_w & ~1023u));
#define G_DMA_A(buf, t, i_) __builtin_amdgcn_raw_ptr_buffer_load_lds(ra, (LAS void*)(lds + (buf) * 65536 + a_wu + (i_) * 8192), 16, ao##i_, (unsigned)(t) * 128u, 0, 0)
#define G_ISSUE_B(t) do { const unsigned so_ = (unsigned)(t) * 64u * ldbB; _Pragma("unroll") for (int i_ = 0; i_ < 8; ++i_) sb[i_] = __builtin_bit_cast(f32x4, __builtin_amdgcn_raw_buffer_load_b128(rb, bo, so_ + (unsigned)i_ * ldbB, 0)); } while (0)
#define G_RETIRE() asm volatile("s_waitcnt vmcnt(0)" : "+v"(sb[0]), "+v"(sb[1]), "+v"(sb[2]), "+v"(sb[3]), "+v"(sb[4]), "+v"(sb[5]), "+v"(sb[6]), "+v"(sb[7]) :: "memory")
#define G_WRITE_B(buf) do { LAS unsigned char* d_ = lds + (buf) * 65536; \
        _Pragma("unroll") for (int j_ = 0; j_ < 4; ++j_) { u32x4 w_; w_.x = cvtpk(sb[0][j_], sb[1][j_]); w_.y = cvtpk(sb[2][j_], sb[3][j_]); w_.z = cvtpk(sb[4][j_], sb[5][j_]); w_.w = cvtpk(sb[6][j_], sb[7][j_]); \
            *(LAS u32x4*)(d_ + 32768 + T.b_w + ((T.b_rot + 64u * j_) & 255u)) = w_; } } while (0)
    G_ISSUE_B(0); G_DMA_A(0, 0, 0); G_DMA_A(0, 0, 1); G_DMA_A(0, 0, 2); G_DMA_A(0, 0, 3); G_RETIRE(); G_WRITE_B(0);
    if (nt > 1) G_ISSUE_B(1);
    G_BAR();
    for (int t = 0; t < nt; ++t) { const int cur = t & 1; const bool w1 = t + 1 < nt, i2 = t + 2 < nt;
        if (w1) { G_DMA_A(cur ^ 1, t + 1, 0); G_DMA_A(cur ^ 1, t + 1, 1); G_DMA_A(cur ^ 1, t + 1, 2); G_DMA_A(cur ^ 1, t + 1, 3); }
        if (mlim > 0) {
#pragma unroll
            for (int ks = 0; ks < 2; ++ks) { const LAS unsigned char* s_ = lds + cur * 65536 + ks * 1024; bf16x8 Bf_[4];
#pragma unroll
                for (int n_ = 0; n_ < 4; ++n_) Bf_[n_] = *(const LAS bf16x8*)(s_ + T.b_r + n_ * 2048);
#pragma unroll
                for (int m_ = 0; m_ < 8; ++m_) if (m_ < mlim) { const bf16x8 At_ = *(const LAS bf16x8*)(s_ + T.a_r + m_ * 2048);
#pragma unroll
                    for (int n_ = 0; n_ < 4; ++n_) acc[m_][n_] = __builtin_amdgcn_mfma_f32_16x16x32_bf16(Bf_[n_], At_, acc[m_][n_], 0, 0, 0); } } }
        if (w1) { G_RETIRE(); G_WRITE_B(cur ^ 1); }
        if (i2) G_ISSUE_B(t + 2);
        G_BAR(); }
#undef G_DMA_A
#undef G_ISSUE_B
#undef G_RETIRE
#undef G_WRITE_B
}
__device__ __forceinline__ __amdgpu_buffer_rsrc_t mk_rsrc(const void* p) { return __builtin_amdgcn_make_buffer_rsrc((void*)p, 0, 0x7ffffff0, 0x00020000); }
__device__ __forceinline__ void acc_zero(f32x4 (&acc)[8][4]) {
#pragma unroll
    for (int m = 0; m < 8; ++m)
#pragma unroll
        for (int n = 0; n < 4; ++n) acc[m][n] = (f32x4){0.f, 0.f, 0.f, 0.f};
}
__device__ __forceinline__ f32x4 rot1(const f32x4 a) { return (f32x4){a[1], a[2], a[3], a[0]}; }
__device__ __forceinline__ f32x4 rotinv(const f32x4 a) { return (f32x4){a[3], a[0], a[1], a[2]}; }
__device__ __forceinline__ u32x4 pack8(const f32x4 a, const f32x4 b) { u32x4 w; w.x = cvtpk(a[0], a[1]); w.y = cvtpk(a[2], a[3]); w.z = cvtpk(b[0], b[1]); w.w = cvtpk(b[2], b[3]); return w; }
__device__ __forceinline__ int vwg_id() { const int G = gridDim.x; return (G % 8 == 0) ? (int)((blockIdx.x % 8) * (G / 8) + blockIdx.x / 8) : (int)blockIdx.x; }

__device__ __forceinline__ void g8_stage_rc(int b, int& R, int& C) { const int st = b / 1024, sb = b % 1024, swz = sb ^ (((sb >> 9) & 1) << 5); R = (st >> 1) * 16 + swz / 64; C = (st & 1) * 32 + (swz % 64) / 2; }
__device__ __forceinline__ int g8_lds_byte(int r, int c) { const int st = (r >> 4) * 2 + (c >> 5), rr = r & 15, cc = c & 31, ob = rr * 64 + cc * 2; return st * 1024 + (ob ^ (((ob >> 9) & 1) << 5)); }
__device__ __forceinline__ void gemm8_issue0(char* shm_, const bf16_t* A, long lda, const bf16_t* Bt, long ldb) {
    constexpr int HT = 128 * 64; bf16_t* shm = (bf16_t*)shm_; const int tid = tid_opaque();
#define G8I_STAGE(P, BASE, LD, br) do { const long g_ = (long)(br) * (LD); \
    for (int i_ = 0; i_ < 2; ++i_) { const int b_ = tid * 16 + i_ * 8192; int r_, c_; g8_stage_rc(b_, r_, c_); \
      __builtin_amdgcn_global_load_lds((const unsigned*)((BASE) + g_ + (long)r_ * (LD) + c_), (__attribute__((address_space(3))) unsigned*)((__attribute__((address_space(3))) char*)(P) + b_), 16, 0, 0); } } while (0)
    G8I_STAGE(shm + 4 * HT, Bt, ldb, 0); G8I_STAGE(shm, A, lda, 0); G8I_STAGE(shm + 5 * HT, Bt, ldb, 128); G8I_STAGE(shm + HT, A, lda, 128);
#undef G8I_STAGE
}
__device__ __forceinline__ void gemm8_kloop(f32x4 (&acc)[2][2][4][2], char* shm_, const bf16_t* A, long lda, const bf16_t* Bt, long ldb, int nt) {
    constexpr int HT = 128 * 64;
    bf16_t* shm = (bf16_t*)shm_;
#define G8_SA(b, h) (shm + ((b) * 2 + (h)) * HT)
#define G8_SB(b, h) (shm + (4 + (b) * 2 + (h)) * HT)
#define G8_STAGE_X(T_, P, BASE, LD, br, kt) do { const long g_ = (long)(br) * (LD) + (long)(kt) * 64; \
    for (int i_ = 0; i_ < 2; ++i_) { const int b_ = (T_) * 16 + i_ * 8192; int r_, c_; g8_stage_rc(b_, r_, c_); \
      __builtin_amdgcn_global_load_lds((const unsigned*)((BASE) + g_ + (long)r_ * (LD) + c_), (__attribute__((address_space(3))) unsigned*)((__attribute__((address_space(3))) char*)(P) + b_), 16, 0, 0); } } while (0)
#define G8_STAGE(P, BASE, LD, br, kt) G8_STAGE_X(tid, P, BASE, LD, br, kt)
#define G8_LDA(dst, b, h) for (int m = 0; m < 4; ++m) for (int k = 0; k < 2; ++k) dst[m][k] = *reinterpret_cast<const bf16x8*>((char*)G8_SA(b, h) + g8_lds_byte(wr * 64 + m * 16 + fr, k * 32 + fq * 8))
#define G8_LDB(dst, b, h) for (int n = 0; n < 2; ++n) for (int k = 0; k < 2; ++k) dst[n][k] = *reinterpret_cast<const bf16x8*>((char*)G8_SB(b, h) + g8_lds_byte(wc * 32 + n * 16 + fr, k * 32 + fq * 8))
#define G8_MMA(ai, bj, At, Bt_) do { __builtin_amdgcn_s_setprio(1); \
    for (int m = 0; m < 4; ++m) for (int n = 0; n < 2; ++n) for (int k = 0; k < 2; ++k) \
      acc[ai][bj][m][n] = __builtin_amdgcn_mfma_f32_16x16x32_bf16(Bt_[n][k], At[m][k], acc[ai][bj][m][n], 0, 0, 0); \
    __builtin_amdgcn_s_setprio(0); } while (0)
#define G8_WAIT_V(n) asm volatile("s_waitcnt vmcnt(" #n ")" ::: "memory")
#define G8_WAIT_L(n) asm volatile("s_waitcnt lgkmcnt(" #n ")" ::: "memory")
#define G8_BAR __builtin_amdgcn_s_barrier()
#define G8_SCHED __builtin_amdgcn_sched_barrier(0)
    const int tid = tid_opaque(); int wid = tid >> 6, lane = tid & 63, wr = wid >> 2, wc = wid & 3, fr = lane & 15, fq = lane >> 4;
    bf16x8 At[4][2], B0[2][2], B1[2][2];
    if (wr == 1) G8_BAR;
    G8_WAIT_V(4); G8_BAR;
    G8_STAGE(G8_SB(1, 0), Bt, ldb, 0, 1); G8_STAGE(G8_SA(1, 0), A, lda, 0, 1); G8_STAGE(G8_SB(1, 1), Bt, ldb, 128, 1);
    G8_WAIT_V(6); G8_BAR;
    for (int t = 0; t < nt - 2; t += 2) {
        G8_LDB(B0, 0, 0); G8_SCHED; G8_LDA(At, 0, 0); G8_STAGE(G8_SA(1, 1), A, lda, 128, t + 1);
        G8_WAIT_L(8); G8_BAR; G8_WAIT_L(0); G8_MMA(0, 0, At, B0); G8_BAR; G8_SCHED;
        G8_LDB(B1, 0, 1); G8_STAGE(G8_SB(0, 0), Bt, ldb, 0, t + 2);
        G8_BAR; G8_WAIT_L(0); G8_MMA(0, 1, At, B1); G8_BAR;
        G8_LDA(At, 0, 1); G8_STAGE(G8_SA(0, 0), A, lda, 0, t + 2);
        G8_BAR; G8_WAIT_L(0); G8_MMA(1, 0, At, B0); G8_BAR; G8_SCHED;
        G8_STAGE(G8_SB(0, 1), Bt, ldb, 128, t + 2);
        G8_WAIT_V(6); G8_BAR; G8_MMA(1, 1, At, B1); G8_BAR;
        G8_LDB(B0, 1, 0); G8_SCHED; G8_LDA(At, 1, 0); G8_STAGE(G8_SA(0, 1), A, lda, 128, t + 2);
        G8_WAIT_L(8); G8_BAR; G8_WAIT_L(0); G8_MMA(0, 0, At, B0); G8_BAR; G8_SCHED;
        G8_LDB(B1, 1, 1); G8_STAGE(G8_SB(1, 0), Bt, ldb, 0, t + 3);
        G8_BAR; G8_WAIT_L(0); G8_MMA(0, 1, At, B1); G8_BAR;
        G8_LDA(At, 1, 1); G8_STAGE(G8_SA(1, 0), A, lda, 0, t + 3);
        G8_BAR; G8_WAIT_L(0); G8_MMA(1, 0, At, B0); G8_BAR; G8_SCHED;
        G8_STAGE(G8_SB(1, 1), Bt, ldb, 128, t + 3);
        G8_WAIT_V(6); G8_BAR; G8_MMA(1, 1, At, B1); G8_BAR;
    }
    int tz = tid_opaque(); wid = tz >> 6; lane = tz & 63; wr = wid >> 2; wc = wid & 3; fr = lane & 15; fq = lane >> 4;
    { G8_LDB(B0, 0, 0); G8_WAIT_V(0); G8_LDA(At, 0, 0); G8_STAGE_X(tz, G8_SA(1, 1), A, lda, 128, nt - 1);
      G8_BAR; G8_WAIT_L(0); G8_MMA(0, 0, At, B0); G8_BAR;
      G8_LDB(B1, 0, 1); G8_BAR; G8_WAIT_L(0); G8_MMA(0, 1, At, B1); G8_BAR;
      G8_LDA(At, 0, 1); G8_WAIT_V(4); G8_BAR; G8_WAIT_L(0); G8_MMA(1, 0, At, B0); G8_MMA(1, 1, At, B1); G8_BAR; }
    { G8_LDB(B0, 1, 0); G8_LDA(At, 1, 0); G8_WAIT_V(2); G8_BAR; G8_WAIT_L(0); G8_MMA(0, 0, At, B0); G8_BAR;
      G8_LDB(B1, 1, 1); G8_WAIT_V(0); G8_BAR; G8_WAIT_L(0); G8_MMA(0, 1, At, B1); G8_BAR;
      G8_LDA(At, 1, 1); G8_BAR; G8_WAIT_L(0); G8_MMA(1, 0, At, B0); G8_MMA(1, 1, At, B1); G8_BAR; }
    if (wr == 0) G8_BAR;
}
#define G8_ZERO(acc) do { _Pragma("unroll") for (int a_ = 0; a_ < 2; ++a_) _Pragma("unroll") for (int b_ = 0; b_ < 2; ++b_) _Pragma("unroll") for (int m_ = 0; m_ < 4; ++m_) _Pragma("unroll") for (int n_ = 0; n_ < 2; ++n_) acc[a_][b_][m_][n_] = (f32x4){0.f, 0.f, 0.f, 0.f}; } while (0)
__device__ __forceinline__ void prep_tile(const float* W, size_t ldw, int k0, int nsrc0, bf16_t* WT, size_t ldt, int ndst0, LAS unsigned char* lds) {
    LAS unsigned* T = (LAS unsigned*)lds;
    const int tid = tid_opaque();
#pragma unroll
    for (int i = 0; i < 4; ++i) { const int it = tid + 512 * i, nq = (it & 15) + 16 * ((it >> 6) & 3), kp = ((it >> 4) & 3) + 4 * (it >> 8);
        const float* w = W + (size_t)(k0 + 2 * kp) * ldw + nsrc0 + 4 * nq; const f32x4 w0 = __builtin_nontemporal_load((const f32x4*)w), w1 = __builtin_nontemporal_load((const f32x4*)(w + ldw));
#pragma unroll
        for (int j = 0; j < 4; ++j) T[(4 * nq + j) * 33 + kp] = cvtpk(w0[j], w1[j]); }
    __syncthreads();
    { const int n = tid >> 1, hh = tid & 1; u32x4 o[4];
#pragma unroll
      for (int q = 0; q < 4; ++q)
#pragma unroll
          for (int j = 0; j < 4; ++j) o[q][j] = T[n * 33 + hh * 16 + q * 4 + j];
      bf16_t* d = WT + (size_t)(ndst0 + n) * ldt + k0 + hh * 32;
#pragma unroll
      for (int q = 0; q < 4; ++q) *(u32x4*)(d + q * 8) = o[q]; }
    __syncthreads();
}
__device__ __forceinline__ void phase_prep(const Ptrs& p, LAS unsigned char* lds) {
    bf16_t* wtin = (bf16_t*)(p.ws + OFF_WTIN); bf16_t* wtco = (bf16_t*)(p.ws + OFF_WTCO); bf16_t* wtao = (bf16_t*)(p.ws + OFF_WTAO); bf16_t* wto = (bf16_t*)(p.ws + OFF_WTO);
    for (int t = vwg_id(); t < 1792; t += gridDim.x) {
        if (t < 1280) { const int kb = t & 31, nb = t >> 5, pc = nb * 256; prep_tile(p.w_in, NIN, kb * 64, pc < C_GC ? pc : pc + (W_GC - C_GC), wtin, WTP2, pc, lds); }
        else if (t < 1408) { const int q = t - 1280, kb = q & 15, nb = q >> 4; prep_tile(p.w_conv_out, D, kb * 64, nb * 256, wtco, WTP1, nb * 256, lds); }
        else if (t < 1536) { const int q = t - 1408, kb = q & 15, nb = q >> 4; prep_tile(p.w_attn_out, D, kb * 64, nb * 256, wtao, WTP1, nb * 256, lds); }
        else { const int q = t - 1536, kb = q & 31, nb = q >> 5; prep_tile(p.w_out, D, kb * 64, nb * 256, wto, WTP2, nb * 256, lds); }
    }
}
__device__ __forceinline__ void phase_gemm1(const Ptrs& p, LAS unsigned char* lds) {
    const bf16_t* ha = (const bf16_t*)(p.ws + OFF_HA); bf16_t* pr = (bf16_t*)(p.ws + OFF_PROJ); const bf16_t* wtin = (const bf16_t*)(p.ws + OFF_WTIN);
#define G1_A(u_) (ha + (size_t)((((u_) >> 3) & 31) * 256) * D)
#define G1_B(u_) (wtin + (size_t)((((u_) & 7) + 8 * ((u_) >> 8)) * 256) * WTP2)
    { const int u0 = vwg_id(); if (u0 < 32 * 40) gemm8_issue0((char*)lds, G1_A(u0), D, G1_B(u0), WTP2); }
    for (int u = vwg_id(); u < 32 * 40; u += gridDim.x) {
        const int pm = (u >> 3) & 31, pn = (u & 7) + 8 * (u >> 8);
        const int row0 = pm * 256, pcol0 = pn * 256;
        f32x4 acc[2][2][4][2]; G8_ZERO(acc);
        gemm8_kloop(acc, (char*)lds, G1_A(u), D, G1_B(u), WTP2, D / 64);
        { const int un = u + (int)gridDim.x; if (un < 32 * 40) gemm8_issue0((char*)lds, G1_A(un), D, G1_B(un), WTP2); }
        const int tid = tid_opaque(), wid = tid >> 6, lane = tid & 63, wr = wid >> 2, wc = wid & 3, fr = lane & 15, fq = lane >> 4;
        const int mode = (pcol0 >= C_GC) ? 2 : ((pcol0 >= C_Q && pcol0 < C_K) ? 1 : 0);
        const int cst = (fq & 1) ? 16 + 4 * (fq - 1) : 4 * fq;
#pragma unroll
        for (int ai = 0; ai < 2; ++ai)
#pragma unroll
            for (int m = 0; m < 4; ++m) { bf16_t* prow = pr + (size_t)(row0 + ai * 128 + wr * 64 + m * 16 + fr) * PLD + pcol0 + wc * 32 + cst;
#pragma unroll
                for (int bj = 0; bj < 2; ++bj) { f32x4 v0 = acc[ai][bj][m][0], v1 = acc[ai][bj][m][1];
                    if (mode == 1) { v0 *= QSCALE; v1 *= QSCALE; }
                    else if (mode == 2) {
#pragma unroll
                        for (int j = 0; j < 4; ++j) { v0[j] = sigmoidf_(v0[j]); v1[j] = sigmoidf_(v1[j]); } }
#pragma unroll
                    for (int j = 0; j < 4; ++j) { const auto r = __builtin_amdgcn_permlane16_swap(__float_as_uint(v0[j]), __float_as_uint(v1[j]), false, false); v0[j] = __uint_as_float(r[0]); v1[j] = __uint_as_float(r[1]); }
                    *(u32x4*)(prow + bj * 128) = pack8(v0, v1); } }
    }
#undef G1_A
#undef G1_B
}
__device__ __forceinline__ void phase_merge(const Ptrs& p, LAS unsigned char* lds) {
    const bf16_t* ua = (const bf16_t*)(p.ws + OFF_UA); const bf16_t* pr = (const bf16_t*)(p.ws + OFF_PROJ); bf16_t* mg = (bf16_t*)(p.ws + OFF_MRG);
    const bf16_t* wtco = (const bf16_t*)(p.ws + OFF_WTCO); const bf16_t* wtao = (const bf16_t*)(p.ws + OFF_WTAO);
    for (int u = vwg_id(); u < 32 * 8; u += gridDim.x) {
        const int pm = u >> 3, pn = u & 7, row0 = pm * 256, col0 = pn * 256;
        f32x4 acc[2][2][4][2]; G8_ZERO(acc);
        gemm8_issue0((char*)lds, ua + (size_t)row0 * 2048, 2048, wtco + (size_t)col0 * WTP1, WTP1);
#pragma unroll 1
        for (int seg = 0; seg < 2; ++seg) {
            gemm8_kloop(acc, (char*)lds, ua + (size_t)row0 * 2048 + seg * 1024, 2048, (seg ? wtao : wtco) + (size_t)col0 * WTP1, WTP1, 1024 / 64);
            if (seg == 0) gemm8_issue0((char*)lds, ua + (size_t)row0 * 2048 + 1024, 2048, wtao + (size_t)col0 * WTP1, WTP1);
            else { const int un = u + (int)gridDim.x; if (un < 32 * 8) gemm8_issue0((char*)lds, ua + (size_t)((un >> 3) * 256) * 2048, 2048, wtco + (size_t)((un & 7) * 256) * WTP1, WTP1); }
            const int tid = tid_opaque(), wid = tid >> 6, lane = tid & 63, wr = wid >> 2, wc = wid & 3, fr = lane & 15, fq = lane >> 4;
#pragma unroll
            for (int ai = 0; ai < 2; ++ai)
#pragma unroll
                for (int m = 0; m < 4; ++m) { const int row = row0 + ai * 128 + wr * 64 + m * 16 + fr;
#pragma unroll
                    for (int bj = 0; bj < 2; ++bj)
#pragma unroll
                        for (int n = 0; n < 2; ++n) { const int c = col0 + bj * 128 + wc * 32 + n * 16 + fq * 4; const size_t o = (size_t)row * PLD + c;
                            const u32x2 sa = *(const u32x2*)(pr + o + C_GA); u32x2 sc = sa; if (seg == 0) sc = *(const u32x2*)(pr + o + C_GC);
                            f32x4 v = acc[ai][bj][m][n];
                            const float a0 = bflo(sa.x), a1 = bfhi(sa.x), a2 = bflo(sa.y), a3 = bfhi(sa.y);
                            if (seg == 0) { v[0] *= bflo(sc.x) * __builtin_amdgcn_rcpf(a0); v[1] *= bfhi(sc.x) * __builtin_amdgcn_rcpf(a1); v[2] *= bflo(sc.y) * __builtin_amdgcn_rcpf(a2); v[3] *= bfhi(sc.y) * __builtin_amdgcn_rcpf(a3); }
                            else { v[0] *= a0; v[1] *= a1; v[2] *= a2; v[3] *= a3; }
                            acc[ai][bj][m][n] = v;
                            if (seg == 1) { u32x2 w; w.x = cvtpk(v[0], v[1]); w.y = cvtpk(v[2], v[3]); *(u32x2*)(mg + (size_t)row * D + c) = w; } }
                    asm volatile("" ::: "memory"); }
        }
    }
}
__device__ __forceinline__ void phase_out(const Ptrs& p, LAS unsigned char* lds) {
    const bf16_t* mg = (const bf16_t*)(p.ws + OFF_MRG); float* x1 = (float*)(p.ws + OFF_X1); const float* mod = (const float*)(p.ws + OFF_MOD); const bf16_t* wto = (const bf16_t*)(p.ws + OFF_WTO);
    for (int u = vwg_id(); u < 32 * 8; u += gridDim.x) {
        const int pm = u >> 3, pn = u & 7, row0 = pm * 256, col0 = pn * 256;
        f32x4 acc[2][2][4][2]; G8_ZERO(acc);
        if (u == vwg_id()) gemm8_issue0((char*)lds, mg + (size_t)row0 * D, D, wto + (size_t)col0 * WTP2, WTP2);
        gemm8_kloop(acc, (char*)lds, mg + (size_t)row0 * D, D, wto + (size_t)col0 * WTP2, WTP2, D / 64);
        { const int un = u + (int)gridDim.x; if (un < 32 * 8) gemm8_issue0((char*)lds, mg + (size_t)((un >> 3) * 256) * D, D, wto + (size_t)((un & 7) * 256) * WTP2, WTP2); }
        const int tid = tid_opaque(), wid = tid >> 6, lane = tid & 63, wr = wid >> 2, wc = wid & 3, fr = lane & 15, fq = lane >> 4;
        const float* gm = mod + (size_t)(row0 / S) * NMOD + 2 * D;
#pragma unroll
        for (int ai = 0; ai < 2; ++ai)
#pragma unroll
            for (int m = 0; m < 4; ++m) { const int row = row0 + ai * 128 + wr * 64 + m * 16 + fr;
#pragma unroll
                for (int bj = 0; bj < 2; ++bj)
#pragma unroll
                    for (int n = 0; n < 2; ++n) { const int c = col0 + bj * 128 + wc * 32 + n * 16 + fq * 4; const size_t o = (size_t)row * D + c;
                        *(f32x4*)(x1 + o) = *(const f32x4*)(p.x + o) + *(const f32x4*)(gm + c) * acc[ai][bj][m][n]; } }
    }
}
constexpr size_t OFF_GUTOT = OFF_CTRL + 1024;
constexpr size_t OFF_GUDONE = OFF_CTRL + 2048;
struct MoeUnit { int e, mt, nt, cnt, base, light; };
__device__ __forceinline__ bool moe_unit(int cv, int u, int ntiles_n, MoeUnit& mu) {
    int base = 0;
#pragma unroll
    for (int e = 0; e < E; ++e) { const int c = __builtin_amdgcn_readlane(cv, e), tm = (c + 255) >> 8, nu = tm * ntiles_n;
        if (u < nu) { mu.e = e; mu.cnt = c; mu.base = base; mu.nt = u / tm; mu.mt = u - mu.nt * tm; mu.light = (mu.mt == tm - 1 && c - mu.mt * 256 <= 128) ? 1 : 0; return true; }
        u -= nu; base += tm * 256; }
    return false;
}
__device__ __forceinline__ void phase_moe_gu(const Ptrs& p, LAS unsigned char* lds) {
    const int* counts = (const int*)(p.ws + OFF_CTRL); const bf16_t* h2 = (const bf16_t*)(p.ws + OFF_HA); bf16_t* act = (bf16_t*)(p.ws + OFF_ACT);
    const __amdgpu_buffer_rsrc_t ract = __builtin_amdgcn_make_buffer_rsrc((void*)act, 0, 0x7ffffff0, 0x00020000);
    MoeUnit mu; const int cv = counts[tid_opaque() & 31];
    for (int u = vwg_id(); moe_unit(cv, u, 16, mu); u += gridDim.x) {
        GemmT T; T.init();
        const int* list = (const int*)(p.ws + OFF_LIST) + (size_t)mu.e * NTOK; const int i0 = mu.mt * 256, n0 = mu.nt * 128;
        unsigned ao[4];
#pragma unroll
        for (int i = 0; i < 4; ++i) { const int r = i0 + T.aR + 64 * i; const int tok = (r < mu.cnt) ? (list[r] >> 2) : 0; ao[i] = (unsigned)((tok * D + T.aC) * 2); }
        const float* wsel = ((__builtin_amdgcn_readfirstlane(T.b_p) & 1) ? p.w_up : p.w_gate) + (size_t)mu.e * D * D + n0;
        const unsigned bo = (unsigned)((T.b_k * D + T.b_gucol) * 4);
        f32x4 acc[8][4]; acc_zero(acc);
        const int mlim = __builtin_amdgcn_readfirstlane(T.wr) ? 0 : ((mu.cnt - i0 + 15) >> 4);
        if (mu.light) gemm_kloop_light(acc, lds, T, mk_rsrc(h2), ao[0], ao[1], ao[2], ao[3], mk_rsrc(wsel), bo, D * 4u, D / 64, mlim);
        else gemm_kloop(acc, lds, T, mk_rsrc(h2), ao[0], ao[1], ao[2], ao[3], mk_rsrc(wsel), bo, D * 4u, D / 64);
T.init_epi();
        const int c = n0 + T.wc * 32 + T.fq * 8;
        const float* bg = p.b_gate + (size_t)mu.e * D + c; const float* bu = p.b_up + (size_t)mu.e * D + c;
        const f32x4 bg0 = *(const f32x4*)bg, bg1 = *(const f32x4*)(bg + 4), bu0 = *(const f32x4*)bu, bu1 = *(const f32x4*)(bu + 4);
#pragma unroll
        for (int m = 0; m < 8; ++m) { const int r = i0 + T.wr * 128 + m * 16 + T.fr;
            f32x4 g0 = acc[m][0] + bg0, g1 = rot1(acc[m][1]) + bg1, u0 = acc[m][2] + bu0, u1 = rot1(acc[m][3]) + bu1;
#pragma unroll
            for (int j = 0; j < 4; ++j) { float g = fminf(g0[j], 7.0f), uu = fminf(fmaxf(u0[j], -7.0f), 7.0f); g0[j] = (uu + 1.0f) * g * sigmoidf_(1.702f * g);
                g = fminf(g1[j], 7.0f); uu = fminf(fmaxf(u1[j], -7.0f), 7.0f); g1[j] = (uu + 1.0f) * g * sigmoidf_(1.702f * g); }
            if (r < mu.cnt) __builtin_amdgcn_raw_buffer_store_b128(pack8(g0, g1), ract, (unsigned)(((mu.base + r) * D + c) * 2), 0, 16); }
        asm volatile("s_waitcnt vmcnt(0)" ::: "memory");
        __syncthreads();
        if (threadIdx.x == 0) { __hip_atomic_fetch_add((unsigned*)(p.ws + OFF_GUDONE) + mu.e * 16, 1u, __ATOMIC_RELAXED, __HIP_MEMORY_SCOPE_AGENT);
                                __hip_atomic_fetch_add((unsigned*)(p.ws + OFF_GUTOT), 1u, __ATOMIC_RELAXED, __HIP_MEMORY_SCOPE_AGENT); }
    }
}
__device__ __forceinline__ void phase_moe_down(const Ptrs& p, LAS unsigned char* lds) {
    const int* counts = (const int*)(p.ws + OFF_CTRL); const bf16_t* act = (const bf16_t*)(p.ws + OFF_ACT); bf16_t* y = (bf16_t*)(p.ws + OFF_Y); const float* gate = (const float*)(p.ws + OFF_GATE);
    MoeUnit mu; const int cv = counts[tid_opaque() & 31];
    int Ttot = 0;
#pragma unroll
    for (int e = 0; e < E; ++e) Ttot += (__builtin_amdgcn_readlane(cv, e) + 255) >> 8;
    const int G = (int)gridDim.x, Ugu = Ttot * 16, u0 = ((vwg_id() - Ugu % G) % G + G) % G;
    LAS int* wslot = (LAS int*)(lds + GEMM_LDS + 4096);
    int all_done = 0;
    for (int u = u0; moe_unit(cv, u, 8, mu); u += G) {
        if (!all_done) {
            if (threadIdx.x == 0) {
                unsigned* tot = (unsigned*)(p.ws + OFF_GUTOT); unsigned* de = (unsigned*)(p.ws + OFF_GUDONE) + mu.e * 16;
                const unsigned need = (unsigned)(((mu.cnt + 255) >> 8) * 16); int all = 0;
                for (unsigned sp = 0; sp < (1u << 22); ++sp) {
                    if (__hip_atomic_load(tot, __ATOMIC_RELAXED, __HIP_MEMORY_SCOPE_AGENT) >= (unsigned)Ugu) { all = 1; break; }
                    if (__hip_atomic_load(de, __ATOMIC_RELAXED, __HIP_MEMORY_SCOPE_AGENT) >= need) break;
                    __builtin_amdgcn_s_sleep(8); }
                __builtin_amdgcn_fence(__ATOMIC_ACQUIRE, "agent");
                *wslot = all; }
            asm volatile("s_waitcnt vmcnt(0)" ::: "memory");
            __syncthreads();
            all_done = __builtin_amdgcn_readfirstlane(*wslot);
            __syncthreads(); }
        GemmT T; T.init();
        const int* list = (const int*)(p.ws + OFF_LIST) + (size_t)mu.e * NTOK; const int i0 = mu.mt * 256, col0 = mu.nt * 256;
        const unsigned ao = (unsigned)((T.aR * D + T.aC) * 2), bo = (unsigned)((T.b_k * D + T.b_col) * 4);
        int pa = -1; float pg = 0.f;
        { const int t_ = tid_opaque(); if (t_ < 256 && i0 + t_ < mu.cnt) { pa = list[i0 + t_]; pg = gate[pa]; } }
        f32x4 acc[8][4]; acc_zero(acc);
        const int mlim = __builtin_amdgcn_readfirstlane(T.wr) ? 0 : ((mu.cnt - i0 + 15) >> 4);
        if (mu.light) gemm_kloop_light(acc, lds, T, mk_rsrc(act + (size_t)(mu.base + i0) * D), ao, ao + 64u * 4096, ao + 128u * 4096, ao + 192u * 4096,
                                       mk_rsrc(p.w_down + (size_t)mu.e * D * D + col0), bo, D * 4u, D / 64, mlim);
        else gemm_kloop(acc, lds, T, mk_rsrc(act + (size_t)(mu.base + i0) * D), ao, ao + 64u * 4096, ao + 128u * 4096, ao + 192u * 4096,
                        mk_rsrc(p.w_down + (size_t)mu.e * D * D + col0), bo, D * 4u, D / 64);
T.init_epi();
        LAS int* tab = (LAS int*)(lds + GEMM_LDS);
        { const int t_ = tid_opaque(); if (t_ < 256) { tab[2 * t_] = pa; tab[2 * t_ + 1] = __float_as_int(pg); } }
        __syncthreads();
        const float* bd = p.b_down + (size_t)mu.e * D;
#pragma unroll
        for (int m = 0; m < 8; ++m) { const int rl = T.wr * 128 + m * 16 + T.fr, r = i0 + rl;
            if (r < mu.cnt) { const int a = tab[2 * rl]; const float gt = __int_as_float(tab[2 * rl + 1]);
#pragma unroll
                for (int pp = 0; pp < 2; ++pp) { const int c = col0 + T.wc * 64 + pp * 32 + T.fq * 8;
                    const f32x4 v0 = (acc[m][2 * pp] + *(const f32x4*)(bd + c)) * gt, v1 = (rot1(acc[m][2 * pp + 1]) + *(const f32x4*)(bd + c + 4)) * gt;
                    *(u32x4*)(y + (size_t)a * D + c) = pack8(v0, v1); } } }
        __syncthreads();
    }
}
extern __shared__ __attribute__((aligned(1024))) unsigned char dyn_lds[];
typedef float f32x16 __attribute__((ext_vector_type(16)));
typedef short v4i16_t __attribute__((ext_vector_type(4)));
__device__ __forceinline__ float xhalf_max(float v) { const auto rr = __builtin_amdgcn_permlane32_swap(__float_as_uint(v), __float_as_uint(v), false, false); return fmaxf(__uint_as_float(rr[0]), __uint_as_float(rr[1])); }
__device__ __forceinline__ float xhalf_sum(float v) { const auto rr = __builtin_amdgcn_permlane32_swap(__float_as_uint(v), __float_as_uint(v), false, false); return __uint_as_float(rr[0]) + __uint_as_float(rr[1]); }
template <int CTRL> __device__ __forceinline__ float dppf(float x) { return __builtin_bit_cast(float, __builtin_amdgcn_mov_dpp(__builtin_bit_cast(int, x), CTRL, 0xf, 0xf, true)); }
constexpr int DPP_XOR1 = 0xB1, DPP_XOR2 = 0x4E, DPP_XOR7 = 0x141, DPP_XOR8 = 0x128;
__device__ __forceinline__ float xrow_sum(float x) { const auto s = __builtin_amdgcn_permlane16_swap(__float_as_uint(x), __float_as_uint(x), false, false); x = __uint_as_float(s[0]) + __uint_as_float(s[1]); return xhalf_sum(x); }
__device__ __forceinline__ float xrow_max(float x) { const auto s = __builtin_amdgcn_permlane16_swap(__float_as_uint(x), __float_as_uint(x), false, false); x = fmaxf(__uint_as_float(s[0]), __uint_as_float(s[1])); return xhalf_max(x); }
__device__ __forceinline__ float wave_sum(float v) { v += dppf<DPP_XOR1>(v); v += dppf<DPP_XOR2>(v); v += dppf<DPP_XOR7>(v); v += dppf<DPP_XOR8>(v); return xrow_sum(v); }
__device__ __forceinline__ float wave_max(float v) { v = fmaxf(v, dppf<DPP_XOR1>(v)); v = fmaxf(v, dppf<DPP_XOR2>(v)); v = fmaxf(v, dppf<DPP_XOR7>(v)); v = fmaxf(v, dppf<DPP_XOR8>(v)); return xrow_max(v); }
__device__ __forceinline__ float reduce16(float (&v)[16], int lane) {
    float a[8], b[4], c[2];
#pragma unroll
    for (int i = 0; i < 8; ++i) { const auto r = __builtin_amdgcn_permlane32_swap(__float_as_uint(v[i]), __float_as_uint(v[i + 8]), false, false); a[i] = __uint_as_float(r[0]) + __uint_as_float(r[1]); }
#pragma unroll
    for (int i = 0; i < 4; ++i) { const auto r = __builtin_amdgcn_permlane16_swap(__float_as_uint(a[i]), __float_as_uint(a[i + 4]), false, false); b[i] = __uint_as_float(r[0]) + __uint_as_float(r[1]); }
#pragma unroll
    for (int i = 0; i < 2; ++i) { const float t1 = b[i] + dppf<DPP_XOR8>(b[i]), t2 = b[i + 2] + dppf<DPP_XOR8>(b[i + 2]); c[i] = (lane & 8) ? t2 : t1; }
    float d; { const float t1 = c[0] + dppf<DPP_XOR7>(c[0]), t2 = c[1] + dppf<DPP_XOR7>(c[1]); d = (lane & 4) ? t2 : t1; }
    d += dppf<DPP_XOR1>(d); d += dppf<DPP_XOR2>(d);
    return d;
}
constexpr int WT_LDS = 16 * 2048 * 4;
constexpr int AUX_LDS = 160 * 1024 - 64;

__device__ __forceinline__ void phase_mod(const Ptrs& p, LAS unsigned char* lds) {
    LAS float* sc = (LAS float*)lds;
    LAS float* red = (LAS float*)(lds + 16384);
    const int tid = tid_opaque();
    for (int i = tid; i < B * D; i += 512) { const float v = p.c[i]; sc[i] = v / (1.0f + __expf(-v)); }
    __syncthreads();
    float* mod = (float*)(p.ws + OFF_MOD);
    for (int ch = vwg_id(); ch < NMOD / 48; ch += gridDim.x) {
        const int cq = tid % 12, kg = tid / 12;
        if (kg < 42) {
            f32x4 a0 = {0.f, 0.f, 0.f, 0.f}, a1 = {0.f, 0.f, 0.f, 0.f};
            const float* wp = p.ada_w + (size_t)ch * 48 + cq * 4;
#pragma unroll 7
            for (int k = kg; k < D; k += 42) { const f32x4 w = __builtin_nontemporal_load((const f32x4*)(wp + (size_t)k * NMOD)); a0 += w * sc[k]; a1 += w * sc[D + k]; }
#pragma unroll
            for (int j = 0; j < 4; ++j) { red[kg * 96 + cq * 4 + j] = a0[j]; red[kg * 96 + 48 + cq * 4 + j] = a1[j]; }
        }
        __syncthreads();
        if (tid < 96) { float s = 0.f; for (int g = 0; g < 42; ++g) s += red[g * 96 + tid]; const int b = tid / 48, c = ch * 48 + tid % 48; mod[(size_t)b * NMOD + c] = s + p.ada_b[c]; }
        __syncthreads();
    }
}
__device__ __forceinline__ void stage_wt16(LAS float* wt, const float* w, size_t ldw) {
    const int tid = tid_opaque();
    for (int i = tid; i < 2048 * 4; i += 512) { const int k = i >> 2, q = i & 3; const f32x4 v = *(const f32x4*)(w + (size_t)k * ldw + q * 4);
#pragma unroll
        for (int j = 0; j < 4; ++j) wt[(q * 4 + j) * 2048 + k] = v[j]; }
}
constexpr int N1_PITCH = 2048 * 2 + 16;
constexpr int N1_WT = 0, N1_HS = 16 * N1_PITCH, N1_GS = 2 * 16 * N1_PITCH, N1_PS = N1_GS + 16384, N1_END = N1_PS + 8 * 256 * 4;
__device__ __forceinline__ void phase_norm1(const Ptrs& p, LAS unsigned char* lds) {
    LAS float* gs = (LAS float*)(lds + N1_GS); LAS float* sh = gs + 2048; LAS float* ps = (LAS float*)(lds + N1_PS);
    const int tid = tid_opaque(), lane = tid & 63, wid = tid >> 6;
    for (int i = tid; i < 1024 * 4; i += 512) { const int kp = i >> 2, q = i & 3; const float* w = p.w_in + (size_t)(2 * kp) * NIN + W_F + q * 4;
        const f32x4 v0 = *(const f32x4*)w, v1 = *(const f32x4*)(w + NIN);
#pragma unroll
        for (int j = 0; j < 4; ++j) *(LAS unsigned*)(lds + N1_WT + (q * 4 + j) * N1_PITCH + kp * 4) = cvtpk(v0[j], v1[j]); }
    bf16_t* ha = (bf16_t*)(p.ws + OFF_HA); float* logf = (float*)(p.ws + OFF_LOGF);
    for (int blk = vwg_id(); blk < NTOK / 32; blk += gridDim.x) {
        const int b = (blk * 32) / S; const float* mod = (const float*)(p.ws + OFF_MOD) + (size_t)b * NMOD;
        __syncthreads();
        for (int i = tid; i < 2048; i += 512) { gs[i] = p.norm_mix_g[i] * (1.0f + mod[D + i]); sh[i] = mod[i]; }
        __syncthreads();
#pragma unroll 1
        for (int half = 0; half < 2; ++half) {
#pragma unroll 1
            for (int rr = 0; rr < 2; ++rr) {
                const int r16 = wid * 2 + rr, row = blk * 32 + half * 16 + r16; const float* xr = p.x + (size_t)row * D;
                f32x4 v[8]; float ss = 0.f;
#pragma unroll
                for (int c = 0; c < 8; ++c) { v[c] = *(const f32x4*)(xr + c * 256 + lane * 4); ss += v[c][0] * v[c][0] + v[c][1] * v[c][1] + v[c][2] * v[c][2] + v[c][3] * v[c][3]; }
                ss = wave_sum(ss); const float r = rsqrtf(ss * (1.0f / D) + EPS);
#pragma unroll
                for (int c = 0; c < 8; ++c) { const int k = c * 256 + lane * 4; const f32x4 g4 = *(const LAS f32x4*)(gs + k), s4 = *(const LAS f32x4*)(sh + k);
                    const f32x4 h4 = (v[c] * r) * g4 + s4; u32x2 w; w.x = cvtpk(h4[0], h4[1]); w.y = cvtpk(h4[2], h4[3]);
                    *(u32x2*)(ha + (size_t)row * D + k) = w; *(LAS u32x2*)(lds + N1_HS + r16 * N1_PITCH + k * 2) = w; }
            }
            __syncthreads();
            {
                f32x4 acc = {0.f, 0.f, 0.f, 0.f};
                const LAS unsigned char* ap = lds + N1_HS + (lane & 15) * N1_PITCH + wid * 512 + (lane >> 4) * 16;
                const LAS unsigned char* bp = lds + N1_WT + (lane & 15) * N1_PITCH + wid * 512 + (lane >> 4) * 16;
#pragma unroll
                for (int ks = 0; ks < 8; ++ks) acc = __builtin_amdgcn_mfma_f32_16x16x32_bf16(*(const LAS bf16x8*)(ap + ks * 64), *(const LAS bf16x8*)(bp + ks * 64), acc, 0, 0, 0);
#pragma unroll
                for (int i = 0; i < 4; ++i) ps[wid * 256 + (4 * (lane >> 4) + i) * 16 + (lane & 15)] = acc[i];
            }
            __syncthreads();
            if (tid < 256) { float z = p.b_forget[tid & 15];
#pragma unroll
                for (int w = 0; w < 8; ++w) z += ps[w * 256 + tid];
                const int row = blk * 32 + half * 16 + (tid >> 4);
                logf[((size_t)b * H + (tid & 15)) * S + (row % S)] = fminf(z, 0.f) - log1pf(__expf(-fabsf(z))); }
        }
    }
}
__device__ __forceinline__ void phase_scan_conv(const Ptrs& p, LAS unsigned char* lds) {
    const int tid = tid_opaque();
    const bf16_t* pr = (const bf16_t*)(p.ws + OFF_PROJ); bf16_t* ua = (bf16_t*)(p.ws + OFF_UA);
    for (int item = vwg_id() * 512 + tid; item < (NTOK / 8) * (DC / 8); item += gridDim.x * 512) {
        const int cg = item & 127, rc = item >> 7, r0 = rc * 8, c = cg * 8;
        float w0[8], w1[8], w2[8], pm2[8], pm1[8];
#pragma unroll
        for (int j = 0; j < 8; ++j) { w0[j] = p.conv_w[c + j]; w1[j] = p.conv_w[DC + c + j]; w2[j] = p.conv_w[2 * DC + c + j]; pm2[j] = 0.f; pm1[j] = 0.f; }
        if ((r0 % S) != 0) {
#pragma unroll
            for (int d = 0; d < 2; ++d) { const bf16_t* q = pr + (size_t)(r0 - 2 + d) * PLD; const u32x4 xc = *(const u32x4*)(q + C_XC + c), cc = *(const u32x4*)(q + C_CC + c);
#pragma unroll
                for (int j = 0; j < 4; ++j) { const float e0 = bflo(xc[j]) * bflo(cc[j]), e1 = bfhi(xc[j]) * bfhi(cc[j]); if (d == 0) { pm2[2 * j] = e0; pm2[2 * j + 1] = e1; } else { pm1[2 * j] = e0; pm1[2 * j + 1] = e1; } } }
        }
#pragma unroll
        for (int i = 0; i < 8; ++i) { const bf16_t* q = pr + (size_t)(r0 + i) * PLD; const u32x4 xc = *(const u32x4*)(q + C_XC + c), cc = *(const u32x4*)(q + C_CC + c), cb = *(const u32x4*)(q + C_CB + c);
            float o[8];
#pragma unroll
            for (int j = 0; j < 4; ++j) { const float e0 = bflo(xc[j]) * bflo(cc[j]), e1 = bfhi(xc[j]) * bfhi(cc[j]);
                o[2 * j] = bflo(cb[j]) * (w0[2 * j] * pm2[2 * j] + w1[2 * j] * pm1[2 * j] + w2[2 * j] * e0); o[2 * j + 1] = bfhi(cb[j]) * (w0[2 * j + 1] * pm2[2 * j + 1] + w1[2 * j + 1] * pm1[2 * j + 1] + w2[2 * j + 1] * e1);
                pm2[2 * j] = pm1[2 * j]; pm2[2 * j + 1] = pm1[2 * j + 1]; pm1[2 * j] = e0; pm1[2 * j + 1] = e1; }
            u32x4 w; w.x = cvtpk(o[0], o[1]); w.y = cvtpk(o[2], o[3]); w.z = cvtpk(o[4], o[5]); w.w = cvtpk(o[6], o[7]);
            *(u32x4*)(ua + (size_t)(r0 + i) * 2048 + c) = w; }
    }
}
typedef short s16x4 __attribute__((ext_vector_type(4)));
constexpr int A_SLOTB = 8192, A_LDS_K = 0, A_LDS_V = 3 * A_SLOTB, A_LDS_WS = 6 * A_SLOTB, A_LDS_OST = A_LDS_WS + 8 * 256, A_LDS_F = A_LDS_OST + 8 * 4096, ATT_LDS = A_LDS_F + S * 4;
#define A_THR 32.0f
#define A_SBAR() __builtin_amdgcn_sched_barrier(0)
#define A_PIN(x) asm volatile("" : "+v"(x))
#define A_MFMA(a, b, c) __builtin_amdgcn_mfma_f32_32x32x16_bf16(a, b, c, 0, 0, 0)
#define A_WAIT_BAR(N) asm volatile("s_waitcnt vmcnt(" #N ") lgkmcnt(0)\n\ts_barrier" ::: "memory")
__device__ __forceinline__ int crow(int r, int hi) { return (r & 3) + 8 * (r >> 2) + 4 * hi; }
__device__ __forceinline__ unsigned a_cvtpk(float lo, float hi) { unsigned r; asm("v_cvt_pk_bf16_f32 %0, %1, %2" : "=v"(r) : "v"(lo), "v"(hi)); return r; }
__device__ __forceinline__ void a_glds16(const void* g, unsigned lds_base) {
    unsigned sv; asm volatile("s_mov_b32 %0, m0\n\ts_mov_b32 m0, %2\n\ts_nop 0\n\tglobal_load_lds_dwordx4 %1, off\n\ts_mov_b32 m0, %0" : "=&s"(sv) : "v"(g), "s"(lds_base) : "memory"); }
typedef __attribute__((address_space(3))) const char* a_lds_cptr;
__device__ __forceinline__ void a_kload2(bf16x8* kf, a_lds_cptr kp, int d0) { kf[2 * d0] = *(const __attribute__((address_space(3))) bf16x8*)(kp + d0 * 2048); kf[2 * d0 + 1] = *(const __attribute__((address_space(3))) bf16x8*)(kp + d0 * 2048 + 512); }
__device__ __forceinline__ s16x4 a_vtr(a_lds_cptr p) { return __builtin_bit_cast(s16x4, __builtin_amdgcn_ds_read_tr16_b64_v4i16((__attribute__((address_space(3))) v4i16_t*)p)); }
#define A_MX3(a, b, c) __builtin_fmaxf(__builtin_fmaxf((a), (b)), (c))
__device__ __forceinline__ float a_rowmax(const f32x16& p0, const f32x16& p1) {
    float a = A_MX3(p0[0], p0[1], p1[0]), b = A_MX3(p0[2], p0[3], p1[1]); a = A_MX3(a, p1[2], p1[3]);
#pragma unroll
    for (int r = 4; r < 16; r += 4) { a = A_MX3(a, p0[r], p0[r + 1]); b = A_MX3(b, p0[r + 2], p0[r + 3]); a = A_MX3(a, p1[r], p1[r + 1]); b = A_MX3(b, p1[r + 2], p1[r + 3]); }
    float m = __builtin_fmaxf(a, b); auto rr = __builtin_amdgcn_permlane32_swap(__float_as_uint(m), __float_as_uint(m), false, false);
    return __builtin_fmaxf(__uint_as_float(rr[0]), __uint_as_float(rr[1])); }
__device__ __forceinline__ void a_cmask(f32x16& p0, f32x16& p1, int jb, int qrel, int hi) {
    const int kb = 64 * jb + 4 * hi;
#pragma unroll
    for (int r = 0; r < 16; ++r) { const int kv = kb + (r & 3) + 8 * (r >> 2); if (kv > qrel) p0[r] = -INFINITY; if (kv + 32 > qrel) p1[r] = -INFINITY; } }
#define A_FLD(X0, X1, fp_) do { _Pragma("unroll") for (int g_ = 0; g_ < 4; ++g_) { const f32x4 fa_ = *(const __attribute__((address_space(3))) f32x4*)((fp_) + g_ * 32), fb_ = *(const __attribute__((address_space(3))) f32x4*)((fp_) + 128 + g_ * 32); \
        _Pragma("unroll") for (int i_ = 0; i_ < 4; ++i_) { X0[4 * g_ + i_] = fa_[i_]; X1[4 * g_ + i_] = fb_[i_]; } } } while (0)
#define A_FRD2(G, X, fp_, g_) do { if (G) { const f32x4 fa_ = *(const __attribute__((address_space(3))) f32x4*)((fp_) + (g_) * 32), fb_ = *(const __attribute__((address_space(3))) f32x4*)((fp_) + (g_) * 32 + 32); \
        _Pragma("unroll") for (int i_ = 0; i_ < 4; ++i_) { X[4 * (g_) + i_] = fa_[i_]; X[4 * (g_) + 4 + i_] = fb_[i_]; } A_SBAR(); } } while (0)

__device__ __forceinline__ void attn64_unit(int b, int h, int qb, const bf16_t* Q, const bf16_t* __restrict__ K, const bf16_t* __restrict__ V, bf16_t* O, char* lds) {
    const int tid = tid_opaque(), lane = tid & 63, r32 = lane & 31, hi = lane >> 5; const int wid = __builtin_amdgcn_readfirstlane(tid >> 6);
    const long rowbase = (long)b * S; const int q0 = qb * 256, NT = (q0 + 256) / 64;
    const bf16_t* Qw = Q + (rowbase + q0 + wid * 32) * PLD + h * 64;
    const unsigned lds0 = (unsigned)(size_t)lds; float* wsf = (float*)(lds + A_LDS_WS) + wid * 64;
    const bf16_t* ksrc = K + rowbase * PLD + h * 64 + (long)lane * PLD + wid * 8;
    const bf16_t* vsrc = V + rowbase * PLD + h * 64 + (long)(16 * (wid & 3) + (lane >> 2)) * PLD + (wid >> 2) * 32 + (lane & 3) * 8;
    const unsigned kdst = lds0 + A_LDS_K + wid * 1024, vdst = lds0 + A_LDS_V + wid * 1024;
#define DMA_K(t, slot) a_glds16(ksrc + (long)(t) * 64 * PLD, (unsigned)__builtin_amdgcn_readfirstlane(kdst + (slot)))
#define DMA_V(t, slot) a_glds16(vsrc + (long)(t) * 64 * PLD, (unsigned)__builtin_amdgcn_readfirstlane(vdst + (slot)))
    const a_lds_cptr vp0 = (a_lds_cptr)lds + A_LDS_V + ((lane >> 4) & 1) * 32 + (lane & 3) * 8 + (4 * hi + ((lane & 15) >> 2)) * 64;
    const a_lds_cptr kp0 = (a_lds_cptr)lds + A_LDS_K + hi * 1024 + r32 * 16;
    const a_lds_cptr fp0 = (a_lds_cptr)lds + A_LDS_F + hi * 16;
    DMA_K(0, 0); DMA_V(0, 0); DMA_K(1, A_SLOTB);
    bf16x8 qr[4];
#pragma unroll
    for (int d0 = 0; d0 < 4; ++d0) qr[d0] = *reinterpret_cast<const bf16x8*>(&Qw[(long)r32 * PLD + d0 * 16 + hi * 8]);
    float mhat = 0.f, l_reg = 0.f; f32x16 o[2];
#pragma unroll
    for (int r = 0; r < 16; ++r) { o[0][r] = 0.f; o[1][r] = 0.f; }
    const int qrel = wid * 32 + r32; bool resc = false;
    f32x16 pA0, pA1, pB0, pB1; bf16x8 kf[8]; s16x4 vlo[8], vhi[8]; u32x4 pw0, pw1, pw2, pw3;
    int sl_prev = 0, sl_cur = 0, sl_next = A_SLOTB;
#define ROT() do { sl_prev = sl_cur; sl_cur = sl_next; sl_next = (sl_next == 2 * A_SLOTB) ? 0 : sl_next + A_SLOTB; } while (0)
#define EX(v) __builtin_amdgcn_exp2f((v) + nmh)
#define RESC() do { if (resc) { _Pragma("unroll") for (int d_ = 0; d_ < 2; ++d_) _Pragma("unroll") for (int r = 0; r < 16; ++r) o[d_][r] *= wsf[crow(r, hi)]; } } while (0)
    DMA_K(2, 2 * A_SLOTB);
    A_WAIT_BAR(0);
    _Pragma("unroll") for (int d0 = 0; d0 < 4; ++d0) a_kload2(kf, kp0, d0);
    A_FLD(pA0, pA1, fp0);
    pA0 = A_MFMA(kf[0], qr[0], pA0); pA1 = A_MFMA(kf[1], qr[0], pA1); pA0 = A_MFMA(kf[2], qr[1], pA0); pA1 = A_MFMA(kf[3], qr[1], pA1);
    pA0 = A_MFMA(kf[4], qr[2], pA0); pA1 = A_MFMA(kf[5], qr[2], pA1); pA0 = A_MFMA(kf[6], qr[3], pA0); pA1 = A_MFMA(kf[7], qr[3], pA1);
    if (NT == 4) a_cmask(pA0, pA1, 0, qrel, hi);
    { const float rm = a_rowmax(pA0, pA1); mhat = rm; const float nmh = -mhat;
#pragma unroll
      for (int r = 0; r < 16; ++r) { pA0[r] = EX(pA0[r]); pA1[r] = EX(pA1[r]); } }
    A_FLD(pB0, pB1, fp0 + 256);
    A_WAIT_BAR(0);
    DMA_K(3, 0); DMA_V(1, A_SLOTB); ROT();
    _Pragma("unroll") for (int d0 = 0; d0 < 4; ++d0) a_kload2(kf, kp0 + sl_cur, d0);
    A_WAIT_BAR(2);
#define PKW(P, i) a_cvtpk(P[i], P[i + 1])
#define PAF(k) __builtin_bit_cast(bf16x8, pw##k)
#define VFR(i) (bf16x8){vlo[i][0], vlo[i][1], vlo[i][2], vlo[i][3], vhi[i][0], vhi[i][1], vhi[i][2], vhi[i][3]}
#define VRD(i) do { vlo[i] = a_vtr(vp_ + (((i) >> 2) * 4096 + ((i) & 3) * 1024)); vhi[i] = a_vtr(vp_ + (((i) >> 2) * 4096 + ((i) & 3) * 1024 + 512)); } while (0)
#define KRD(G, d0) do { if (G) { a_kload2(kf, kp0 + sl_next, d0); A_SBAR(); } } while (0)
#define GAPA(MF, a0, a1, a2, a3, W0, W1, PW) do { MF; sacc += a0; sacc += a1; sacc += a2; sacc += a3; W0; W1; A_PIN(PW); A_PIN(sacc); A_SBAR(); } while (0)
#define GAPB(MF, X, i) do { MF; X[i] = EX(X[i]); X[i + 1] = EX(X[i + 1]); X[i + 2] = EX(X[i + 2]); X[i + 3] = EX(X[i + 3]); A_PIN(X); A_SBAR(); } while (0)
#define STEP(C0, C1, P0, P1, t, MASK, GK, GV, GL) do { A_SBAR(); \
    const a_lds_cptr vp_ = vp0 + sl_prev; const a_lds_cptr fn_ = fp0 + ((t) + 1) * 256; \
    VRD(0); A_SBAR(); float sacc = P0[0] + P0[1]; \
                    GAPA(C0 = A_MFMA(kf[0], qr[0], C0), P0[2], P0[3], P0[4], P0[5],     pw0[0] = PKW(P0, 0),  pw0[1] = PKW(P0, 2),  pw0); \
    VRD(4); A_SBAR(); GAPA(C1 = A_MFMA(kf[1], qr[0], C1), P0[6], P0[7], P0[8], P0[9],     pw0[2] = PKW(P0, 4),  pw0[3] = PKW(P0, 6),  pw0); \
    VRD(1); A_SBAR(); GAPA(C0 = A_MFMA(kf[2], qr[1], C0),    P0[10], P0[11], P0[12], P0[13], pw1[0] = PKW(P0, 8),  pw1[1] = PKW(P0, 10), pw1); \
    VRD(5); A_SBAR(); GAPA(C1 = A_MFMA(kf[3], qr[1], C1),    P0[14], P0[15], P1[0], P1[1],   pw1[2] = PKW(P0, 12), pw1[3] = PKW(P0, 14), pw1); \
    VRD(2); A_SBAR(); GAPA(C0 = A_MFMA(kf[4], qr[2], C0),    P1[2], P1[3], P1[4], P1[5],     pw2[0] = PKW(P1, 0),  pw2[1] = PKW(P1, 2),  pw2); \
    VRD(6); A_SBAR(); GAPA(C1 = A_MFMA(kf[5], qr[2], C1),    P1[6], P1[7], P1[8], P1[9],     pw2[2] = PKW(P1, 4),  pw2[3] = PKW(P1, 6),  pw2); \
    VRD(3); A_SBAR(); GAPA(C0 = A_MFMA(kf[6], qr[3], C0),    P1[10], P1[11], P1[12], P1[13], pw3[0] = PKW(P1, 8),  pw3[1] = PKW(P1, 10), pw3); \
    VRD(7); A_SBAR(); GAPA(C1 = A_MFMA(kf[7], qr[3], C1),    P1[14], P1[15], 0.f, 0.f,       pw3[2] = PKW(P1, 12), pw3[3] = PKW(P1, 14), pw3); \
    l_reg += sacc; \
    if (GK) DMA_K((t) + 3, sl_cur); if (GV) DMA_V((t) + 1, sl_next); \
    if (MASK) a_cmask(C0, C1, (t) - (NT - 4), qrel, hi); \
    { const float rm = a_rowmax(C0, C1) - mhat; resc = false; \
      if (__builtin_expect(__any(rm > A_THR), 0)) { const float dl = __builtin_fmaxf(rm, 0.f); mhat += dl; \
          const float f = __builtin_amdgcn_exp2f(-dl); l_reg *= f; if (hi == 0) wsf[r32] = f; resc = true; } } \
    const float nmh = -mhat; A_SBAR(); \
    A_FRD2(GL, P0, fn_, 0); GAPB(o[0] = A_MFMA(PAF(0), VFR(0), o[0]), C0, 0);  A_FRD2(GL, P0, fn_, 2); GAPB(o[1] = A_MFMA(PAF(0), VFR(4), o[1]), C0, 4); \
    KRD(GL, 0); GAPB(o[0] = A_MFMA(PAF(1), VFR(1), o[0]), C0, 8);  KRD(GL, 1); GAPB(o[1] = A_MFMA(PAF(1), VFR(5), o[1]), C0, 12); \
    KRD(GL, 2); GAPB(o[0] = A_MFMA(PAF(2), VFR(2), o[0]), C1, 0);  KRD(GL, 3); GAPB(o[1] = A_MFMA(PAF(2), VFR(6), o[1]), C1, 4); \
    A_FRD2(GL, P1, fn_ + 128, 0); GAPB(o[0] = A_MFMA(PAF(3), VFR(3), o[0]), C1, 8);  A_FRD2(GL, P1, fn_ + 128, 2); GAPB(o[1] = A_MFMA(PAF(3), VFR(7), o[1]), C1, 12); \
    } while (0)
    int t = 1;
    for (; t + 5 < NT; t += 2) {
        STEP(pB0, pB1, pA0, pA1, t, false, true, true, true);     A_WAIT_BAR(2); RESC(); ROT();
        STEP(pA0, pA1, pB0, pB1, t + 1, false, true, true, true); A_WAIT_BAR(2); RESC(); ROT();
    }
#define ENDW(tt) do { if ((tt) + 3 < NT) { A_WAIT_BAR(2); } else if ((tt) + 2 < NT) { A_WAIT_BAR(1); } else { A_WAIT_BAR(0); } } while (0)
    for (; t + 1 < NT; t += 2) {
        STEP(pB0, pB1, pA0, pA1, t, true, (t + 3 < NT), (t + 1 < NT), (t + 1 < NT));         ENDW(t);     RESC(); ROT();
        STEP(pA0, pA1, pB0, pB1, t + 1, true, (t + 4 < NT), (t + 2 < NT), (t + 2 < NT));     ENDW(t + 1); RESC(); ROT();
    }
    STEP(pB0, pB1, pA0, pA1, NT - 1, true, false, false, false); RESC();
    { float sacc = pB0[0] + pB0[1];
#pragma unroll
      for (int r = 2; r < 16; ++r) sacc += pB0[r];
#pragma unroll
      for (int r = 0; r < 16; ++r) sacc += pB1[r];
      l_reg += sacc;
      pw0 = (u32x4){PKW(pB0, 0), PKW(pB0, 2), PKW(pB0, 4), PKW(pB0, 6)}; pw1 = (u32x4){PKW(pB0, 8), PKW(pB0, 10), PKW(pB0, 12), PKW(pB0, 14)};
      pw2 = (u32x4){PKW(pB1, 0), PKW(pB1, 2), PKW(pB1, 4), PKW(pB1, 6)}; pw3 = (u32x4){PKW(pB1, 8), PKW(pB1, 10), PKW(pB1, 12), PKW(pB1, 14)};
      const a_lds_cptr vp_ = vp0 + sl_cur; _Pragma("unroll") for (int i = 0; i < 8; ++i) VRD(i);
      o[0] = A_MFMA(PAF(0), VFR(0), o[0]); o[1] = A_MFMA(PAF(0), VFR(4), o[1]); o[0] = A_MFMA(PAF(1), VFR(1), o[0]); o[1] = A_MFMA(PAF(1), VFR(5), o[1]);
      o[0] = A_MFMA(PAF(2), VFR(2), o[0]); o[1] = A_MFMA(PAF(2), VFR(6), o[1]); o[0] = A_MFMA(PAF(3), VFR(3), o[0]); o[1] = A_MFMA(PAF(3), VFR(7), o[1]); }
    { auto rr = __builtin_amdgcn_permlane32_swap(__float_as_uint(l_reg), __float_as_uint(l_reg), false, false); l_reg = __uint_as_float(rr[0]) + __uint_as_float(rr[1]); }
    if (hi == 0) wsf[32 + r32] = l_reg; asm volatile("s_waitcnt lgkmcnt(0)" ::: "memory");
    float rli[16];
#pragma unroll
    for (int r = 0; r < 16; ++r) rli[r] = __builtin_amdgcn_rcpf(wsf[32 + crow(r, hi)]);
    bf16_t* Ow = O + (rowbase + q0 + wid * 32) * 2048 + h * 64; bf16_t* stg = (bf16_t*)(lds + A_LDS_OST) + wid * 2048;
#pragma unroll
    for (int r = 0; r < 16; ++r) { const int orow = crow(r, hi);
#pragma unroll
        for (int d0 = 0; d0 < 2; ++d0) stg[orow * 64 + d0 * 32 + r32] = (bf16_t)(a_cvtpk(o[d0][r] * rli[r], 0.f) & 0xffffu); }
    asm volatile("s_waitcnt lgkmcnt(0)" ::: "memory");
#pragma unroll
    for (int i = 0; i < 4; ++i) { const int row = i * 8 + (lane >> 3), ch = lane & 7; *(u32x4*)(Ow + (long)row * 2048 + ch * 8) = *(const u32x4*)(stg + row * 64 + ch * 8); }
    asm volatile("s_waitcnt lgkmcnt(0)\n\ts_barrier" ::: "memory");
#undef DMA_K
#undef DMA_V
#undef ROT
#undef EX
#undef RESC
#undef PKW
#undef PAF
#undef VFR
#undef VRD
#undef KRD
#undef ENDW
#undef GAPA
#undef GAPB
#undef STEP
}
__device__ __forceinline__ void phase_attn(const Ptrs& p, LAS unsigned char* lds) {
    const bf16_t* pr = (const bf16_t*)(p.ws + OFF_PROJ); bf16_t* ua = (bf16_t*)(p.ws + OFF_UA);
    for (int pi = vwg_id(); pi < 256; pi += gridDim.x) {
        const int s_ = pi & 7, bh = pi >> 3;
        {
            const int tid = tid_opaque(), lane = tid & 63, wid = tid >> 6; LAS float* wtot = (LAS float*)(lds + A_LDS_WS); LAS float* ft = (LAS float*)(lds + A_LDS_F);
            const float* lf = (const float*)(p.ws + OFF_LOGF) + (size_t)bh * S;
            f32x4 a = *(const f32x4*)(lf + tid * 8), b4 = *(const f32x4*)(lf + tid * 8 + 4);
            a[1] += a[0]; a[2] += a[1]; a[3] += a[2]; b4[0] += a[3]; b4[1] += b4[0]; b4[2] += b4[1]; b4[3] += b4[2];
            const float tot = b4[3]; float inc = tot;
#pragma unroll
            for (int o = 1; o < 64; o <<= 1) { const float n = __shfl_up(inc, o); if (lane >= o) inc += n; }
            __syncthreads();
            if (lane == 63) wtot[wid] = inc;
            __syncthreads();
            float off = inc - tot; for (int w = 0; w < wid; ++w) off += wtot[w];
            *(LAS f32x4*)(ft + tid * 8) = (a + off) * -LOG2E; *(LAS f32x4*)(ft + tid * 8 + 4) = (b4 + off) * -LOG2E;
            __syncthreads(); }
#pragma unroll 1
        for (int half = 0; half < 2; ++half)
            attn64_unit(bh >> 4, bh & 15, half ? 15 - s_ : s_, pr + C_Q, pr + C_K, pr + C_V, ua + 1024, (char*)lds);
    }
}
constexpr int R_PITCH = 512 * 2 + 16, R_WHI = 0, R_WLO = 32 * R_PITCH, R_HHI = 64 * R_PITCH, R_HLO = 96 * R_PITCH, R_GS = 128 * R_PITCH, R_LG = R_GS + 16384, R_TAB = R_LG + 4096, R_END = R_TAB + 2048;
__device__ __forceinline__ void phase_norm2_route(const Ptrs& p, LAS unsigned char* lds) {
    LAS float* gs = (LAS float*)(lds + R_GS); LAS float* sh = gs + 2048; LAS float* lg = (LAS float*)(lds + R_LG); LAS float* ps = (LAS float*)lds;
    const int tid = tid_opaque(), lane = tid & 63, wid = tid >> 6;
    bf16_t* ha = (bf16_t*)(p.ws + OFF_HA); const float* x1 = (const float*)(p.ws + OFF_X1);
    int* counts = (int*)(p.ws + OFF_CTRL); int* list = (int*)(p.ws + OFF_LIST); float* gate = (float*)(p.ws + OFF_GATE);
    for (int blk = vwg_id(); blk < NTOK / 32; blk += gridDim.x) {
        const int b = (blk * 32) / S; const float* mod = (const float*)(p.ws + OFF_MOD) + (size_t)b * NMOD;
        __syncthreads();
        for (int i = tid; i < 2048; i += 512) { gs[i] = p.norm_ffn_g[i] * (1.0f + mod[4 * D + i]); sh[i] = mod[3 * D + i]; }
        __syncthreads();
#pragma unroll 1
        for (int half = 0; half < 2; ++half) {
            f32x4 v[2][8];
#pragma unroll
            for (int q = 0; q < 2; ++q) { const int row = blk * 32 + half * 16 + wid * 2 + q; const float* xr = x1 + (size_t)row * D; float ss = 0.f;
#pragma unroll
                for (int c = 0; c < 8; ++c) { v[q][c] = *(const f32x4*)(xr + c * 256 + lane * 4); ss += v[q][c][0] * v[q][c][0] + v[q][c][1] * v[q][c][1] + v[q][c][2] * v[q][c][2] + v[q][c][3] * v[q][c][3]; }
                ss = wave_sum(ss); const float r = rsqrtf(ss * (1.0f / D) + EPS);
#pragma unroll
                for (int c = 0; c < 8; ++c) { const int k = c * 256 + lane * 4; const f32x4 g4 = *(const LAS f32x4*)(gs + k), s4 = *(const LAS f32x4*)(sh + k);
                    v[q][c] = (v[q][c] * r) * g4 + s4; u32x2 w; w.x = cvtpk(v[q][c][0], v[q][c][1]); w.y = cvtpk(v[q][c][2], v[q][c][3]); *(u32x2*)(ha + (size_t)row * D + k) = w; } }
            f32x4 acc[2];
            acc[0] = (f32x4){0.f, 0.f, 0.f, 0.f}; acc[1] = (f32x4){0.f, 0.f, 0.f, 0.f};
#pragma unroll
            for (int ch = 0; ch < 4; ++ch) {
                __syncthreads();
                for (int i = tid; i < 2048; i += 512) { const int kp = i >> 3, cq = i & 7; const float* w = p.router_w + (size_t)(512 * ch + 2 * kp) * E + cq * 4;
                    const f32x4 w0 = *(const f32x4*)w, w1 = *(const f32x4*)(w + E);
#pragma unroll
                    for (int j = 0; j < 4; ++j) { const unsigned hi = cvtpk(w0[j], w1[j]), lo = cvtpk(w0[j] - bflo(hi), w1[j] - bfhi(hi));
                        *(LAS unsigned*)(lds + R_WHI + (cq * 4 + j) * R_PITCH + kp * 4) = hi; *(LAS unsigned*)(lds + R_WLO + (cq * 4 + j) * R_PITCH + kp * 4) = lo; } }
#pragma unroll
                for (int q = 0; q < 2; ++q)
#pragma unroll
                    for (int cc = 0; cc < 2; ++cc) { const f32x4 h4 = v[q][2 * ch + cc]; u32x2 hi, lo; hi.x = cvtpk(h4[0], h4[1]); hi.y = cvtpk(h4[2], h4[3]);
                        lo.x = cvtpk(h4[0] - bflo(hi.x), h4[1] - bfhi(hi.x)); lo.y = cvtpk(h4[2] - bflo(hi.y), h4[3] - bfhi(hi.y));
                        const int o = (wid * 2 + q) * R_PITCH + (cc * 256 + lane * 4) * 2;
                        *(LAS u32x2*)(lds + R_HHI + o) = hi; *(LAS u32x2*)(lds + R_HLO + o) = lo; }
                __syncthreads();
#pragma unroll
                for (int s2 = 0; s2 < 2; ++s2) { const int off = (lane & 15) * R_PITCH + (2 * wid + s2) * 64 + (lane >> 4) * 16;
                    const bf16x8 ahi = *(const LAS bf16x8*)(lds + R_HHI + off), alo = *(const LAS bf16x8*)(lds + R_HLO + off);
#pragma unroll
                    for (int ct = 0; ct < 2; ++ct) { const bf16x8 bhi = *(const LAS bf16x8*)(lds + R_WHI + ct * 16 * R_PITCH + off), blo = *(const LAS bf16x8*)(lds + R_WLO + ct * 16 * R_PITCH + off);
                        acc[ct] = __builtin_amdgcn_mfma_f32_16x16x32_bf16(ahi, bhi, acc[ct], 0, 0, 0); acc[ct] = __builtin_amdgcn_mfma_f32_16x16x32_bf16(alo, bhi, acc[ct], 0, 0, 0);
                        acc[ct] = __builtin_amdgcn_mfma_f32_16x16x32_bf16(ahi, blo, acc[ct], 0, 0, 0); } }
            }
            __syncthreads();
#pragma unroll
            for (int ct = 0; ct < 2; ++ct)
#pragma unroll
                for (int i = 0; i < 4; ++i) ps[wid * 512 + (4 * (lane >> 4) + i) * 32 + ct * 16 + (lane & 15)] = acc[ct][i];
            __syncthreads();
            { const int o = tid; float z = p.router_b[o & 31];
#pragma unroll
              for (int w = 0; w < 8; ++w) z += ps[w * 512 + o];
              lg[half * 512 + o] = z; }
        }
        LAS int* lcnt = (LAS int*)(lds + R_TAB);
        LAS int* lbase = lcnt + 32;
        LAS int* asg_e = lbase + 32;
        LAS int* asg_r = asg_e + 128;
        if (tid < 32) lcnt[tid] = 0;
        __syncthreads();
#pragma unroll 1
        for (int rr = 0; rr < 4; ++rr) {
            const int rl = wid * 4 + rr, row = blk * 32 + rl;
            float val = (lane < 32) ? lg[rl * 32 + lane] : -INFINITY;
            float tv[4]; int ti[4];
#pragma unroll
            for (int k = 0; k < 4; ++k) { const float m = wave_max(val);
                const unsigned long long bal = __ballot(val == m); const int idx = __ffsll((long long)bal) - 1;
                tv[k] = m; ti[k] = idx; if (lane == idx) val = -INFINITY; }
            if (lane < 4) { float pe[4], sum = 0.f;
#pragma unroll
                for (int k = 0; k < 4; ++k) { pe[k] = __expf(tv[k] - tv[0]); sum += pe[k]; }
                const int e = lane == 0 ? ti[0] : lane == 1 ? ti[1] : lane == 2 ? ti[2] : ti[3]; const float pk = (lane == 0 ? pe[0] : lane == 1 ? pe[1] : lane == 2 ? pe[2] : pe[3]) / sum;
                const int lr = __hip_atomic_fetch_add((int*)(lcnt + e), 1, __ATOMIC_RELAXED, __HIP_MEMORY_SCOPE_WORKGROUP); asg_e[rl * 4 + lane] = e; asg_r[rl * 4 + lane] = lr; gate[row * 4 + lane] = pk; }
        }
        __syncthreads();
        if (tid < 32) lbase[tid] = atomicAdd(&counts[tid], lcnt[tid]);
        __syncthreads();
        if (tid < 128) { const int e = asg_e[tid]; list[(size_t)e * NTOK + lbase[e] + asg_r[tid]] = (blk * 32) * 4 + tid; }
    }
}
__device__ __forceinline__ void phase_final(const Ptrs& p, LAS unsigned char* lds) {
    const int tid = tid_opaque(), lane = tid & 63, wid = tid >> 6;
    const float* x1 = (const float*)(p.ws + OFF_X1); const bf16_t* y = (const bf16_t*)(p.ws + OFF_Y);
    for (int row = vwg_id() * 8 + wid; row < NTOK; row += gridDim.x * 8) {
        const int b = row / S; const float* gf = (const float*)(p.ws + OFF_MOD) + (size_t)b * NMOD + 5 * D; const float* xr = x1 + (size_t)row * D; const bf16_t* yr = y + (size_t)row * 4 * D;
        f32x4 v[8]; float ss = 0.f;
#pragma unroll
        for (int c = 0; c < 8; ++c) { const int k = c * 256 + lane * 4; f32x4 s = {0.f, 0.f, 0.f, 0.f};
#pragma unroll
            for (int q = 0; q < 4; ++q) { const u32x2 w = __builtin_nontemporal_load((const u32x2*)(yr + (size_t)q * D + k)); s[0] += bflo(w.x); s[1] += bfhi(w.x); s[2] += bflo(w.y); s[3] += bfhi(w.y); }
            v[c] = __builtin_nontemporal_load((const f32x4*)(xr + k)) + *(const f32x4*)(gf + k) * s; ss += v[c][0] * v[c][0] + v[c][1] * v[c][1] + v[c][2] * v[c][2] + v[c][3] * v[c][3]; }
        ss = wave_sum(ss); const float r = rsqrtf(ss * (1.0f / D) + EPS);
#pragma unroll
        for (int c = 0; c < 8; ++c) { const int k = c * 256 + lane * 4; __builtin_nontemporal_store((v[c] * r) * *(const f32x4*)(p.final_g + k), (f32x4*)(p.out + (size_t)row * D + k)); }
    }
}

#define XB_TMO      128
#define XB_XCNT(j)  (256  + 64 * (j))
#define XB_XSUB(j)  (1280 + 64 * (j))
#define XB_XGEN(j)  (2304 + 64 * (j))
#define XB_TOP      3328
#define XB_TOPGEN   3392
#define XCD_BAR_WORDS 3456
#define XB_SPIN_CAP (1u << 18)

__device__ __forceinline__ unsigned xb_ld(unsigned* p)              { return __hip_atomic_load(p, __ATOMIC_RELAXED, __HIP_MEMORY_SCOPE_AGENT); }
__device__ __forceinline__ unsigned xb_add(unsigned* p, unsigned v) { return __hip_atomic_fetch_add(p, v, __ATOMIC_RELAXED, __HIP_MEMORY_SCOPE_AGENT); }
__device__ __forceinline__ unsigned xb_xcc_id() { return (unsigned)__builtin_amdgcn_s_getreg((3 << 11) | 20) & 0xFu; }
#define XB_SPIN(cond, bar) do { unsigned _sp = 0; while (cond) { __builtin_amdgcn_s_sleep(1); \
    if ((++_sp & 255u) == 0u) { if (xb_ld(&(bar)[XB_TMO])) break; if (_sp > XB_SPIN_CAP) { atomicAdd(&(bar)[XB_TMO], 1u); break; } } } } while (0)

struct XcdBarrier {
    unsigned* bar; unsigned x;
    volatile LAS unsigned* st;
};

__device__ __forceinline__ XcdBarrier xcd_barrier_post(unsigned* bar, volatile LAS unsigned* st) {
    XcdBarrier b; b.bar = bar; b.x = xb_xcc_id(); b.st = st;
    if (threadIdx.x == 0) (void)xb_add(&bar[XB_XCNT(b.x)], 1u);
    return b;
}
__device__ __forceinline__ void xcd_barrier_complete(unsigned* bar, unsigned x, unsigned& nloc, unsigned& nx) {
    const unsigned G = gridDim.x * gridDim.y * gridDim.z;
    unsigned sum, cnt, mine, sp = 0u;
    for (;;) {
        sum = 0u; cnt = 0u; mine = 0u;
#pragma unroll
        for (unsigned j = 0; j < 16; ++j) { const unsigned c = xb_ld(&bar[XB_XCNT(j)]); sum += c; cnt += (c > 0u) ? 1u : 0u; mine = (j == x) ? c : mine; }
        if (sum == G) break;
        __builtin_amdgcn_s_sleep(1);
        if ((++sp & 255u) == 0u) { if (xb_ld(&bar[XB_TMO])) break; if (sp > XB_SPIN_CAP) { atomicAdd(&bar[XB_TMO], 1u); break; } }
    }
    nloc = mine > 0u ? mine : 1u; nx = cnt > 0u ? cnt : 1u;
}

__device__ __forceinline__ void xcd_barrier(const XcdBarrier& b) {
    asm volatile("s_waitcnt vmcnt(0)" ::: "memory");
    __syncthreads();
    if (threadIdx.x == 0) {
        unsigned* bar = b.bar;
        __builtin_amdgcn_s_waitcnt(0);
        unsigned nloc = b.st[0], nx = b.st[1];
        if (nloc == 0u) { xcd_barrier_complete(bar, b.x, nloc, nx); b.st[0] = nloc; b.st[1] = nx; }
        const unsigned old = xb_add(&bar[XB_XSUB(b.x)], 1u);
        const unsigned gen = old / nloc;
        if (old + 1u == (gen + 1u) * nloc) {
            __builtin_amdgcn_fence(__ATOMIC_RELEASE, "agent");
            asm volatile("s_waitcnt vmcnt(0)" ::: "memory");
            const unsigned og = xb_add(&bar[XB_TOP], 1u);
            const unsigned tg = og / nx;
            if (og + 1u == (tg + 1u) * nx) xb_add(&bar[XB_TOPGEN], 1u);
            else XB_SPIN(xb_ld(&bar[XB_TOPGEN]) == tg, bar);
            __builtin_amdgcn_fence(__ATOMIC_ACQUIRE, "agent");
            xb_add(&bar[XB_XGEN(b.x)], 1u);
            asm volatile("s_waitcnt vmcnt(0)" ::: "memory");
        } else {
            XB_SPIN(xb_ld(&bar[XB_XGEN(b.x)]) == gen, bar);
            __builtin_amdgcn_fence(__ATOMIC_ACQUIRE, "agent");
            asm volatile("s_waitcnt vmcnt(0)" ::: "memory");
        }
    }
    __syncthreads();
}


constexpr int LDS_TOTAL = AUX_LDS + 16;
constexpr size_t OFF_BAR = OFF_CTRL + 4096;
static_assert(GEMM_LDS <= AUX_LDS && ATT_LDS <= AUX_LDS && N1_END <= AUX_LDS && R_END <= AUX_LDS, "LDS");
static_assert(4096 + XCD_BAR_WORDS * 4 <= 65536, "ctrl");
__global__ void __launch_bounds__(512, 2) mega_fwd(Ptrs p) {
    LAS unsigned char* lds = (LAS unsigned char*)dyn_lds;
    volatile LAS unsigned* st = (volatile LAS unsigned*)(lds + AUX_LDS);
    if (threadIdx.x == 0) { st[0] = 0u; st[1] = 0u; st[2] = 0u; st[3] = 0u; }
    __syncthreads();
    XcdBarrier bar = xcd_barrier_post((unsigned*)(p.ws + OFF_BAR), st);
    phase_mod(p, lds);          phase_prep(p, lds);         xcd_barrier(bar);
    phase_norm1(p, lds);        xcd_barrier(bar);
    phase_gemm1(p, lds);        xcd_barrier(bar);
    phase_attn(p, lds);         phase_scan_conv(p, lds);    xcd_barrier(bar);
    phase_merge(p, lds);        xcd_barrier(bar);
    phase_out(p, lds);          xcd_barrier(bar);
    phase_norm2_route(p, lds);  xcd_barrier(bar);
    phase_moe_gu(p, lds);
    phase_moe_down(p, lds);     xcd_barrier(bar);
    phase_final(p, lds);
}

extern "C" void kernel_launch(void* const* d_in, const int* in_sizes, int n_in, void* d_out, int out_size, void* d_ws, size_t ws_size, hipStream_t stream) {
    Ptrs p{};
    const float** f = (const float**)&p;
    for (int i = 0; i < 21; ++i) f[i] = (const float*)d_in[i];
    p.out = (float*)d_out; p.ws = (unsigned char*)d_ws;
    static int grid = 0;
    if (!grid) {
        (void)hipFuncSetAttribute((const void*)mega_fwd, hipFuncAttributeMaxDynamicSharedMemorySize, LDS_TOTAL);
        int dev = 0, cus = 0, per_cu = 0;
        (void)hipGetDevice(&dev);
        (void)hipDeviceGetAttribute(&cus, hipDeviceAttributeMultiprocessorCount, dev);
        (void)hipOccupancyMaxActiveBlocksPerMultiprocessor(&per_cu, mega_fwd, 512, LDS_TOTAL);
        grid = cus * (per_cu < 1 ? per_cu : 1);
        if (grid <= 0) grid = cus > 0 ? cus : 256;
    }
    (void)hipMemsetAsync(p.ws + OFF_CTRL, 0, 65536, stream);
    mega_fwd<<<grid, 512, LDS_TOTAL, stream>>>(p);
}
```
